# Optimizing an MI355X kernel written in HIP

```python
import math
import numpy as np
import jax
import jax.numpy as jnp
from jax import lax

D_MODEL = 1024
BATCH = 2
SEQ = 8192
DEPTH = 2

DN_HEADS = 4
DN_HEAD_DIM = 128
DN_WIDTH = DN_HEADS * DN_HEAD_DIM
DN_CONV = 4
DN_CHUNK = 64
POOL_GROUPS = 4
POOL_GROUP_DIM = 128
POOL_WIDTH = POOL_GROUPS * POOL_GROUP_DIM
POOL_WINDOWS = (2, 4, 8, 16)
SG_GROUPS = 4
SG_GROUP_DIM = 128
SG_WIDTH = SG_GROUPS * SG_GROUP_DIM
SG_CHUNK = 128
RET_HEADS = 4
RET_HEAD_DIM = 128
RET_WIDTH = RET_HEADS * RET_HEAD_DIM
RET_CHUNK = 128
ROPE_BASE = 10000.0
N_BRANCH = 4
D_FF = 4 * D_MODEL
N_MOD = 6
EPS = 1e-6
SPLIT_SIZES = (DN_WIDTH, DN_WIDTH, DN_WIDTH, DN_WIDTH, DN_HEADS, DN_HEADS,
               POOL_WIDTH, SG_WIDTH, SG_WIDTH,
               RET_WIDTH, RET_WIDTH, RET_WIDTH, RET_WIDTH,
               N_BRANCH * D_MODEL)
IN_COLS = sum(SPLIT_SIZES)

kernel_name = 'hybrid_parallel_mixer_trunk'


def rmsnorm(x, g):
    xf = x.astype(jnp.float32)
    y = xf * lax.rsqrt(jnp.mean(xf * xf, axis=-1, keepdims=True) + EPS)
    return (y * g.astype(jnp.float32)).astype(x.dtype)


def layernorm(x, g, b):
    mu = jnp.mean(x, axis=-1, keepdims=True)
    var = jnp.mean(jnp.square(x - mu), axis=-1, keepdims=True)
    return (x - mu) * lax.rsqrt(var + EPS) * g + b


def head_groupnorm(x, g):
    mu = jnp.mean(x, axis=-1, keepdims=True)
    var = jnp.mean(jnp.square(x - mu), axis=-1, keepdims=True)
    return (x - mu) * lax.rsqrt(var + EPS) * g.reshape(x.shape[-2], x.shape[-1])


def l2norm(x):
    return x * lax.rsqrt(jnp.sum(x * x, axis=-1, keepdims=True) + EPS)


def causal_dwconv(x, w):
    k_size, ch = w.shape
    return lax.conv_general_dilated(x, w[:, None, :], window_strides=(1,),
                                    padding=[(k_size - 1, 0)],
                                    dimension_numbers=('NWC', 'WIO', 'NWC'),
                                    feature_group_count=ch)


def rope(x, positions):
    d = x.shape[-1]
    inv = ROPE_BASE ** (-jnp.arange(0, d, 2, dtype=jnp.float32) / d)
    ang = positions.astype(jnp.float32)[..., None] * inv
    cos = jnp.cos(ang)[:, :, None, :]
    sin = jnp.sin(ang)[:, :, None, :]
    x1, x2 = x[..., :d // 2], x[..., d // 2:]
    return jnp.concatenate([x1 * cos - x2 * sin, x1 * sin + x2 * cos], axis=-1)


def to_chunks(t, c):
    b, s, h, d = t.shape
    return t.reshape(b, s // c, c, h, d).transpose(0, 3, 1, 2, 4)


def from_chunks(t):
    b, h, n, c, d = t.shape
    return t.transpose(0, 2, 3, 1, 4).reshape(b, n * c, h, d)


def gated_delta_rule(q, k, v, g, beta):
    c = DN_CHUNK
    dk = q.shape[-1]
    q = to_chunks(q * dk ** -0.5, c)
    k = to_chunks(k, c)
    v = to_chunks(v, c)
    g = lax.cumsum(to_chunks(g[..., None], c)[..., 0], axis=3)
    beta = to_chunks(beta[..., None], c)[..., 0]
    k_beta = k * beta[..., None]
    causal = jnp.tril(jnp.ones((c, c), dtype=bool))
    decay = jnp.exp(jnp.where(causal, g[..., :, None] - g[..., None, :], -jnp.inf))
    kk = jnp.einsum('bhnid,bhnjd->bhnij', k_beta, k) * decay
    a_mat = jnp.eye(c, dtype=jnp.float32) + jnp.tril(kk, -1)
    u = lax.linalg.triangular_solve(a_mat, v * beta[..., None], left_side=True, lower=True)
    w = lax.linalg.triangular_solve(a_mat, k_beta * jnp.exp(g)[..., None], left_side=True, lower=True)
    qk = jnp.einsum('bhnid,bhnjd->bhnij', q, k) * decay
    g_last = g[..., -1:]
    k_state = k * jnp.exp(g_last - g)[..., None]
    q_state = q * jnp.exp(g)[..., None]

    def step(state, inp):
        qs, ks, u_i, w_i, qk_i, gl = inp
        v_new = u_i - jnp.einsum('bhcd,bhde->bhce', w_i, state)
        o = jnp.einsum('bhcd,bhde->bhce', qs, state) + jnp.einsum('bhij,bhje->bhie', qk_i, v_new)
        state = state * jnp.exp(gl)[..., None] + jnp.einsum('bhcd,bhce->bhde', ks, v_new)
        return state, o

    bsz, nh, _, _, dv = v.shape
    state0 = jnp.zeros((bsz, nh, dk, dv), jnp.float32)
    xs = tuple(jnp.moveaxis(t, 2, 0) for t in (q_state, k_state, u, w, qk, g_last))
    _, o = lax.scan(step, state0, xs)
    return from_chunks(jnp.moveaxis(o, 0, 2))


def retention(q, k, v):
    c = RET_CHUNK
    nh, dh = q.shape[2], q.shape[3]
    log_gamma = jnp.log1p(-jnp.exp2(-5.0 - jnp.arange(nh, dtype=jnp.float32)))
    q = to_chunks(q, c)
    k = to_chunks(k * dh ** -0.5, c)
    v = to_chunks(v, c)
    idx = jnp.arange(c, dtype=jnp.float32)
    rel = idx[:, None] - idx[None, :]
    decay = jnp.where(rel >= 0, jnp.exp(log_gamma[:, None, None] * jnp.maximum(rel, 0.0)), 0.0)
    scores = jnp.einsum('bhnid,bhnjd->bhnij', q, k) * decay[None, :, None]
    o_inner = jnp.einsum('bhnij,bhnje->bhnie', scores, v)
    zeta = jnp.exp(log_gamma[:, None] * (c - 1 - idx))
    kv = jnp.einsum('bhncd,bhnce->bhnde', k * zeta[None, :, None, :, None], v)
    gamma_c = jnp.exp(log_gamma * c)[None, :, None, None]

    def step(state, kv_i):
        return state * gamma_c + kv_i, state

    bsz = q.shape[0]
    _, prev = lax.scan(step, jnp.zeros((bsz, nh, dh, dh), jnp.float32), jnp.moveaxis(kv, 2, 0))
    prev = jnp.moveaxis(prev, 0, 2)
    xi = jnp.exp(log_gamma[:, None] * (idx + 1.0))
    o_cross = jnp.einsum('bhncd,bhnde->bhnce', q, prev) * xi[None, :, None, :, None]
    return from_chunks(o_inner + o_cross)


def multiscale_pool(p, pool_w, pool_scale):
    bsz, seq, _ = p.shape
    cs = lax.cumsum(p, axis=1)
    count_base = jnp.arange(1, seq + 1, dtype=jnp.float32)[:, None]
    outs = []
    for i, win in enumerate(POOL_WINDOWS):
        sl = slice(i * POOL_GROUP_DIM, (i + 1) * POOL_GROUP_DIM)
        cs_g = cs[..., sl]
        prev = jnp.pad(cs_g, ((0, 0), (win, 0), (0, 0)))[:, :seq]
        outs.append((cs_g - prev) / jnp.minimum(count_base, float(win)) - p[..., sl])
    pooled = jnp.stack(outs, axis=2)
    y = jnp.einsum('bsgc,gcd->bsgd', pooled, pool_w).reshape(bsz, seq, POOL_WIDTH)
    return y * pool_scale


def spatial_gating(su, sv, ln_g, ln_b, sg_w, sg_b):
    bsz, seq, _ = su.shape
    u = jax.nn.gelu(su, approximate=False)
    v = layernorm(jax.nn.gelu(sv, approximate=False), ln_g, ln_b)
    v = v.reshape(bsz, seq // SG_CHUNK, SG_CHUNK, SG_GROUPS, SG_GROUP_DIM)
    w_causal = jnp.tril(sg_w)
    mixed = jnp.einsum('gts,bnsgc->bntgc', w_causal, v) + sg_b.T[None, None, :, :, None]
    return u * mixed.reshape(bsz, seq, SG_WIDTH)


def hybrid_mixer(h, positions, w_in, dn_conv_w, dn_a_log, dn_dt_bias, dn_norm_g,
                 pool_w, pool_scale, sg_ln_g, sg_ln_b, sg_w, sg_b, ret_gn_g,
                 w_br_dn, w_br_pool, w_br_sg, w_br_ret, w_out):
    bsz, seq, _ = h.shape
    f32 = jnp.float32
    dt = h.dtype
    proj = h @ w_in
    cuts = np.cumsum(SPLIT_SIZES)[:-1].tolist()
    (dq, dk, dv, dz, db, da, pl, su, sv, rq, rk, rv, rg, gates) = jnp.split(proj, cuts, axis=-1)

    def heads(t, n, d):
        return t.astype(f32).reshape(bsz, seq, n, d)

    qkv = jax.nn.silu(causal_dwconv(jnp.concatenate([dq, dk, dv], axis=-1).astype(f32), dn_conv_w.astype(f32)))
    q_a, k_a, v_a = [heads(t, DN_HEADS, DN_HEAD_DIM) for t in jnp.split(qkv, 3, axis=-1)]
    beta = jax.nn.sigmoid(db.astype(f32))
    g_log = -jnp.exp(dn_a_log.astype(f32)) * jax.nn.softplus(da.astype(f32) + dn_dt_bias.astype(f32))
    o_a = gated_delta_rule(l2norm(q_a), l2norm(k_a), v_a, g_log, beta)
    o_a = rmsnorm(o_a, dn_norm_g) * jax.nn.silu(heads(dz, DN_HEADS, DN_HEAD_DIM))
    y_a = o_a.reshape(bsz, seq, DN_WIDTH)

    y_b = multiscale_pool(pl.astype(f32), pool_w.astype(f32), pool_scale.astype(f32))

    y_c = spatial_gating(su.astype(f32), sv.astype(f32), sg_ln_g.astype(f32), sg_ln_b.astype(f32),
                         sg_w.astype(f32), sg_b.astype(f32))

    q_r = rope(heads(rq, RET_HEADS, RET_HEAD_DIM), positions)
    k_r = rope(heads(rk, RET_HEADS, RET_HEAD_DIM), positions)
    o_r = head_groupnorm(retention(q_r, k_r, heads(rv, RET_HEADS, RET_HEAD_DIM)), ret_gn_g.astype(f32))
    y_d = jax.nn.silu(rg.astype(f32)) * o_r.reshape(bsz, seq, RET_WIDTH)

    gate = jax.nn.sigmoid(gates.astype(f32)).reshape(bsz, seq, N_BRANCH, D_MODEL).astype(dt)
    merged = (gate[:, :, 0] * (y_a.astype(dt) @ w_br_dn)
              + gate[:, :, 1] * (y_b.astype(dt) @ w_br_pool)
              + gate[:, :, 2] * (y_c.astype(dt) @ w_br_sg)
              + gate[:, :, 3] * (y_d.astype(dt) @ w_br_ret))
    return merged @ w_out


def setup_inputs(seed: int = 0) -> dict:
    key = jax.random.key(seed)
    keys = iter(jax.random.split(key, 32))
    f32 = jnp.float32
    L, D = DEPTH, D_MODEL

    def normal(shape, scale):
        return jax.random.normal(next(keys), shape, f32) * scale

    def gain(shape):
        return 1.0 + normal(shape, 0.02)

    x = normal((BATCH, SEQ, D), 1.0)
    c = normal((BATCH, D), 1.0)
    positions = (jnp.arange(SEQ, dtype=jnp.int32)[None, :]
                 + jax.random.randint(next(keys), (BATCH, 1), 0, 4096, dtype=jnp.int32))
    norm1_g = gain((L, D))
    norm2_g = gain((L, D))
    ada_w = normal((L, D, N_MOD * D), D ** -0.5)
    ada_b = normal((L, N_MOD * D), 0.02)
    w_in = normal((L, D, IN_COLS), D ** -0.5)
    dn_conv_w = normal((L, DN_CONV, 3 * DN_WIDTH), DN_CONV ** -0.5)
    dn_a_log = jnp.log(jax.random.uniform(next(keys), (L, DN_HEADS), f32, 1.0, 16.0))
    dt_init = jnp.exp(jax.random.uniform(next(keys), (L, DN_HEADS), f32, math.log(1e-3), math.log(1e-1)))
    dn_dt_bias = dt_init + jnp.log(-jnp.expm1(-dt_init))
    dn_norm_g = gain((L, DN_HEAD_DIM))
    pool_w = normal((L, POOL_GROUPS, POOL_GROUP_DIM, POOL_GROUP_DIM), POOL_GROUP_DIM ** -0.5)
    pool_scale = 1.0 + normal((L, POOL_WIDTH), 0.1)
    sg_ln_g = gain((L, SG_WIDTH))
    sg_ln_b = normal((L, SG_WIDTH), 0.02)
    sg_w = normal((L, SG_GROUPS, SG_CHUNK, SG_CHUNK), SG_CHUNK ** -0.5)
    sg_b = 1.0 + normal((L, SG_GROUPS, SG_CHUNK), 0.02)
    ret_gn_g = gain((L, RET_WIDTH))
    w_br_dn = normal((L, DN_WIDTH, D), DN_WIDTH ** -0.5)
    w_br_pool = normal((L, POOL_WIDTH, D), POOL_WIDTH ** -0.5)
    w_br_sg = normal((L, SG_WIDTH, D), SG_WIDTH ** -0.5)
    w_br_ret = normal((L, RET_WIDTH, D), RET_WIDTH ** -0.5)
    w_out = normal((L, D, D), D ** -0.5)
    mlp_w1 = normal((L, D, D_FF), D ** -0.5)
    mlp_w2 = normal((L, D_FF, D), D_FF ** -0.5)
    final_g = gain((D,))
    return {'x': x, 'c': c, 'positions': positions, 'norm1_g': norm1_g, 'norm2_g': norm2_g,
            'ada_w': ada_w, 'ada_b': ada_b, 'w_in': w_in, 'dn_conv_w': dn_conv_w,
            'dn_a_log': dn_a_log, 'dn_dt_bias': dn_dt_bias, 'dn_norm_g': dn_norm_g,
            'pool_w': pool_w, 'pool_scale': pool_scale, 'sg_ln_g': sg_ln_g, 'sg_ln_b': sg_ln_b,
            'sg_w': sg_w, 'sg_b': sg_b, 'ret_gn_g': ret_gn_g, 'w_br_dn': w_br_dn,
            'w_br_pool': w_br_pool, 'w_br_sg': w_br_sg, 'w_br_ret': w_br_ret, 'w_out': w_out,
            'mlp_w1': mlp_w1, 'mlp_w2': mlp_w2, 'final_g': final_g}


def reference(x, c, positions, norm1_g, norm2_g, ada_w, ada_b, w_in, dn_conv_w, dn_a_log,
              dn_dt_bias, dn_norm_g, pool_w, pool_scale, sg_ln_g, sg_ln_b, sg_w, sg_b, ret_gn_g,
              w_br_dn, w_br_pool, w_br_sg, w_br_ret, w_out, mlp_w1, mlp_w2, final_g):
    cond = jax.nn.silu(c)
    for l in range(DEPTH):
        mod = cond @ ada_w[l] + ada_b[l]
        shift1, scale1, gate1, shift2, scale2, gate2 = [m[:, None, :] for m in jnp.split(mod, N_MOD, axis=-1)]
        h = rmsnorm(x, norm1_g[l]) * (1.0 + scale1) + shift1
        x = x + gate1 * hybrid_mixer(h, positions, w_in[l], dn_conv_w[l], dn_a_log[l], dn_dt_bias[l],
                                     dn_norm_g[l], pool_w[l], pool_scale[l], sg_ln_g[l], sg_ln_b[l],
                                     sg_w[l], sg_b[l], ret_gn_g[l], w_br_dn[l], w_br_pool[l],
                                     w_br_sg[l], w_br_ret[l], w_out[l])
        h = rmsnorm(x, norm2_g[l]) * (1.0 + scale2) + shift2
        x = x + gate2 * (jnp.square(jax.nn.relu(h @ mlp_w1[l])) @ mlp_w2[l])
    return rmsnorm(x, final_g)
```

```cpp
#include <hip/hip_runtime.h>
#include <hip/hip_bf16.h>
#include <hip/hip_cooperative_groups.h>
#include <cstdio>
namespace cg = cooperative_groups;

#ifndef COOP
#define COOP 0
#endif

typedef unsigned short u16;
using bf16x8 = __attribute__((ext_vector_type(8))) short;
using f32x4 = __attribute__((ext_vector_type(4))) float;
using u4 = __attribute__((ext_vector_type(4))) unsigned;
using u2 = __attribute__((ext_vector_type(2))) unsigned;
#define DEVI __device__ __forceinline__

constexpr int NT = 512;
constexpr int SEQ = 8192;
constexpr size_t SECE = (size_t)16384 * 512;
constexpr int SMEM_BYTES = 156 * 1024;
constexpr int NPHASE = 22;

struct P {
  const float *x, *c;
  const int* pos;
  const float *norm1_g, *norm2_g, *ada_w, *ada_b, *w_in, *dn_conv_w, *dn_a_log, *dn_dt_bias, *dn_norm_g, *pool_w,
      *pool_scale, *sg_ln_g, *sg_ln_b, *sg_w, *sg_b, *ret_gn_g, *w_br[4], *w_out, *mlp_w1, *mlp_w2, *final_g;
  float* out;
  u16 *WinT, *WbrT, *WoutT, *W1T, *W2T, *PoolWT, *h, *sec, *TQ, *YB, *halo;
  float *modp, *beta, *glog, *gcum, *ropecs;
  int phase_lo, phase_hi;
};

DEVI int tid_l() { int t = threadIdx.x; asm volatile("" : "+v"(t)); return t; }
template <class T> DEVI void lnd(T*& q) { asm volatile("" : "+s"(q)); }
DEVI u16 f2bf(float f) {
  unsigned u = __float_as_uint(f);
  u += 0x7fffu + ((u >> 16) & 1u);
  return (u16)(u >> 16);
}
DEVI float bf2f(u16 h) { return __uint_as_float(((unsigned)h) << 16); }
DEVI unsigned pack2(float a, float b) { return (unsigned)f2bf(a) | ((unsigned)f2bf(b) << 16); }
DEVI float lo2f(unsigned u) { return __uint_as_float(u << 16); }
DEVI float hi2f(unsigned u) { return __uint_as_float(u & 0xffff0000u); }
DEVI void unpack8(u4 v, float* f) {
  f[0] = lo2f(v.x); f[1] = hi2f(v.x); f[2] = lo2f(v.y); f[3] = hi2f(v.y);
  f[4] = lo2f(v.z); f[5] = hi2f(v.z); f[6] = lo2f(v.w); f[7] = hi2f(v.w);
}
DEVI u4 pack8(const float* f) {
  u4 v; v.x = pack2(f[0], f[1]); v.y = pack2(f[2], f[3]); v.z = pack2(f[4], f[5]); v.w = pack2(f[6], f[7]);
  return v;
}
DEVI float wave_sum(float v) {
#pragma unroll
  for (int o = 32; o > 0; o >>= 1) v += __shfl_xor(v, o);
  return v;
}
DEVI float siluf(float x) { return x / (1.f + __expf(-x)); }
DEVI float sigmf(float x) { return 1.f / (1.f + __expf(-x)); }
DEVI float geluf(float x) { return 0.5f * x * (1.f + erff(x * 0.70710678118654752f)); }
DEVI f32x4 mfma16(bf16x8 a, bf16x8 b, f32x4 c) { return __builtin_amdgcn_mfma_f32_16x16x32_bf16(a, b, c, 0, 0, 0); }
DEVI bf16x8 frag(const u16* base, int ld, int r0, int k0, int lane) {
  return *(const bf16x8*)(base + (r0 + (lane & 15)) * ld + k0 + 8 * (lane >> 4));
}
DEVI u2 pack4v(f32x4 v) { u2 r; r.x = pack2(v[0], v[1]); r.y = pack2(v[2], v[3]); return r; }

DEVI float modval(const P& p, int l, int b, int j) {
  float s = p.ada_b[l * 6144 + j];
#pragma unroll
  for (int ks = 0; ks < 8; ++ks) s += p.modp[(size_t)((ks * 2 + l) * 2 + b) * 6144 + j];
  return s;
}

DEVI void gemm_kloop(const u16* __restrict__ A, int lda, const u16* __restrict__ Bt, int ldb, int K,
                     f32x4 (&acc)[4][4], u16* sm) {
  const int t = tid_l(), lane = t & 63, wid = t >> 6, wr = wid >> 1, wc = wid & 1;
  u16* As = sm;
  u16* Bs = sm + 2 * 256 * 64;
  const int lrow = t >> 3, lch = t & 7;
  const u16* ag = A + (size_t)lrow * lda + lch * 8;
  const u16* bg = Bt + (size_t)lrow * ldb + lch * 8;
  const int soff = lrow * 64 + ((lch ^ (lrow & 7)) * 8);
  u4 ra[4], rb[2];
#pragma unroll
  for (int i = 0; i < 4; ++i) ra[i] = *(const u4*)(ag + (size_t)i * 64 * lda);
#pragma unroll
  for (int i = 0; i < 2; ++i) rb[i] = *(const u4*)(bg + (size_t)i * 64 * ldb);
  __syncthreads();
#pragma unroll
  for (int i = 0; i < 4; ++i) *(u4*)(As + i * 64 * 64 + soff) = ra[i];
#pragma unroll
  for (int i = 0; i < 2; ++i) *(u4*)(Bs + i * 64 * 64 + soff) = rb[i];
  __syncthreads();
  const int nt = K >> 6;
  const int arow = (wr * 64 + (lane & 15)) * 64, brow = (wc * 64 + (lane & 15)) * 64;
  for (int kt = 0; kt < nt; ++kt) {
    const int cur = kt & 1;
    if (kt + 1 < nt) {
      const int ko = (kt + 1) * 64;
#pragma unroll
      for (int i = 0; i < 4; ++i) ra[i] = *(const u4*)(ag + (size_t)i * 64 * lda + ko);
#pragma unroll
      for (int i = 0; i < 2; ++i) rb[i] = *(const u4*)(bg + (size_t)i * 64 * ldb + ko);
    }
    const u16* Ac = As + cur * 256 * 64 + arow;
    const u16* Bc = Bs + cur * 128 * 64 + brow;
#pragma unroll
    for (int kk = 0; kk < 2; ++kk) {
      const int ch = (((kk * 4 + (lane >> 4)) ^ (lane & 7)) * 8);
      bf16x8 af[4], bfr[4];
#pragma unroll
      for (int mi = 0; mi < 4; ++mi) af[mi] = *(const bf16x8*)(Ac + mi * 16 * 64 + ch);
#pragma unroll
      for (int ni = 0; ni < 4; ++ni) bfr[ni] = *(const bf16x8*)(Bc + ni * 16 * 64 + ch);
#pragma unroll
      for (int mi = 0; mi < 4; ++mi)
#pragma unroll
        for (int ni = 0; ni < 4; ++ni) acc[mi][ni] = mfma16(af[mi], bfr[ni], acc[mi][ni]);
    }
    if (kt + 1 < nt) {
      const int nb = cur ^ 1;
#pragma unroll
      for (int i = 0; i < 4; ++i) *(u4*)(As + nb * 256 * 64 + i * 64 * 64 + soff) = ra[i];
#pragma unroll
      for (int i = 0; i < 2; ++i) *(u4*)(Bs + nb * 128 * 64 + i * 64 * 64 + soff) = rb[i];
    }
    __syncthreads();
  }
}
DEVI void zero_acc(f32x4 (&acc)[4][4]) {
#pragma unroll
  for (int i = 0; i < 4; ++i)
#pragma unroll
    for (int j = 0; j < 4; ++j) acc[i][j] = f32x4{0.f, 0.f, 0.f, 0.f};
}
template <class F>
DEVI void epi_foreach(f32x4 (&acc)[4][4], int row0, int col0, F f) {
  const int t = tid_l(), lane = t & 63, wid = t >> 6, wr = wid >> 1, wc = wid & 1;
#pragma unroll
  for (int mi = 0; mi < 4; ++mi)
#pragma unroll
    for (int ni = 0; ni < 4; ++ni)
#pragma unroll
      for (int r = 0; r < 4; ++r)
        f(row0 + wr * 64 + mi * 16 + (lane >> 4) * 4 + r, col0 + wc * 64 + ni * 16 + (lane & 15), acc[mi][ni][r]);
}

DEVI void mod_unit(const P& p, int u, unsigned char* smem) {
  const int t = tid_l();
  const int l = u / 96, rem = u % 96, jb = rem >> 3, ks = rem & 7;
  float* cond = (float*)smem;
  if (t < 256) {
    const int b = t >> 7, k = t & 127;
    cond[t] = siluf(p.c[b * 1024 + ks * 128 + k]);
  }
  __syncthreads();
  const int j = jb * 512 + t;
  const float* w = p.ada_w + ((size_t)l * 1024 + ks * 128) * 6144 + j;
  float a0 = 0.f, a1 = 0.f;
#pragma unroll 8
  for (int k = 0; k < 128; ++k) {
    const float wv = w[(size_t)k * 6144];
    a0 += cond[k] * wv;
    a1 += cond[128 + k] * wv;
  }
  p.modp[(size_t)((ks * 2 + l) * 2 + 0) * 6144 + j] = a0;
  p.modp[(size_t)((ks * 2 + l) * 2 + 1) * 6144 + j] = a1;
  __syncthreads();
}
DEVI void rope_unit(const P& p, int u) {
  const int idx = u * 512 + tid_l();
  const int tok = idx >> 6, j = idx & 63;
  const float inv = exp2f(-(float)j * (13.287712379549449f / 64.f));
  const float ang = (float)p.pos[tok] * inv;
  double rev = (double)ang * 0.15915494309189535;
  rev -= rint(rev);
  const float r = (float)(rev * 6.283185307179586);
  p.ropecs[(size_t)idx * 2] = __cosf(r);
  p.ropecs[(size_t)idx * 2 + 1] = __sinf(r);
}
DEVI void conv_tile(const float* __restrict__ src, int ld, int K, int kt, int nt, int col0, u16* __restrict__ dst,
                    unsigned char* smem) {
  float* ls = (float*)smem;
  const int t = tid_l();
#pragma unroll
  for (int ps = 0; ps < 2; ++ps) {
    const int kk = ps * 32 + (t >> 4), n4 = (t & 15) * 4;
    const float4 v = *(const float4*)(src + (size_t)(kt * 64 + kk) * ld + col0 + n4);
    ls[kk * 65 + n4] = v.x; ls[kk * 65 + n4 + 1] = v.y; ls[kk * 65 + n4 + 2] = v.z; ls[kk * 65 + n4 + 3] = v.w;
  }
  __syncthreads();
  const int n = t >> 3, kc = (t & 7) * 8;
  float f[8];
#pragma unroll
  for (int j = 0; j < 8; ++j) f[j] = ls[(kc + j) * 65 + n];
  *(u4*)(dst + (size_t)(nt * 64 + n) * K + kt * 64 + kc) = pack8(f);
  __syncthreads();
}
constexpr int NWCONV = 2432 + 512 + 256 + 1024 + 1024 + 16;
DEVI void wconv_unit(const P& p, int l, int w, unsigned char* smem) {
  if (w < 2432) {
    const int kt = w & 15, nt = w >> 4;
    conv_tile(p.w_in + (size_t)l * 1024 * 9736, 9736, 1024, kt, nt, nt * 64 + (nt * 64 >= 2048 ? 8 : 0), p.WinT, smem);
    return;
  }
  w -= 2432;
  if (w < 512) {
    const int b = w >> 7, r = w & 127, kt = r & 7, nt = r >> 3;
    conv_tile((b == 0 ? p.w_br[0] : b == 1 ? p.w_br[1] : b == 2 ? p.w_br[2] : p.w_br[3]) + (size_t)l * 512 * 1024, 1024, 512, kt, nt, nt * 64, p.WbrT + (size_t)b * 1024 * 512, smem);
    return;
  }
  w -= 512;
  if (w < 256) {
    conv_tile(p.w_out + (size_t)l * 1024 * 1024, 1024, 1024, w & 15, w >> 4, (w >> 4) * 64, p.WoutT, smem);
    return;
  }
  w -= 256;
  if (w < 1024) {
    conv_tile(p.mlp_w1 + (size_t)l * 1024 * 4096, 4096, 1024, w & 15, w >> 4, (w >> 4) * 64, p.W1T, smem);
    return;
  }
  w -= 1024;
  if (w < 1024) {
    conv_tile(p.mlp_w2 + (size_t)l * 4096 * 1024, 1024, 4096, w & 63, w >> 6, (w >> 6) * 64, p.W2T, smem);
    return;
  }
  w -= 1024;
  {
    const int g = w >> 2, r = w & 3;
    conv_tile(p.pool_w + (size_t)(l * 4 + g) * 16384, 128, 128, r & 1, r >> 1, (r >> 1) * 64, p.PoolWT + (size_t)g * 16384, smem);
  }
}

DEVI void norm_phase(const P& p, int l, int which, unsigned char* smem) {
  const int t = tid_l(), lane = t & 63, wid = t >> 6;
  float* ssh = (float*)smem;
  float* ssc = ssh + 2048;
  float* w8 = ssc + 2048;
  const float* gsrc = (which == 0 ? p.norm1_g : p.norm2_g) + l * 1024;
  const int ish = which == 0 ? 0 : 3;
  for (int i = t; i < 2048; i += NT) {
    const int b = i >> 10, c = i & 1023;
    ssh[i] = modval(p, l, b, ish * 1024 + c);
    ssc[i] = gsrc[c] * (1.f + modval(p, l, b, (ish + 1) * 1024 + c));
  }
  if (which == 0) {
    for (int i = t; i < 2048; i += NT) {
      const int k = i >> 1, hf = i & 1;
      *(float4*)(w8 + k * 8 + hf * 4) = *(const float4*)(p.w_in + ((size_t)l * 1024 + k) * 9736 + 2048 + hf * 4);
    }
  }
  __syncthreads();
  const float* xs = (l == 0 && which == 0) ? p.x : p.out;
  for (int u = blockIdx.x; u < 2048; u += gridDim.x) {
    const int row = u * 8 + wid, b = row >> 13;
    const float* xr = xs + (size_t)row * 1024;
    float4 xv[4];
    float ss = 0.f;
#pragma unroll
    for (int i = 0; i < 4; ++i) {
      xv[i] = *(const float4*)(xr + i * 256 + lane * 4);
      ss += xv[i].x * xv[i].x + xv[i].y * xv[i].y + xv[i].z * xv[i].z + xv[i].w * xv[i].w;
    }
    ss = wave_sum(ss);
    const float rstd = rsqrtf(ss * (1.f / 1024.f) + 1e-6f);
    float a8[8];
#pragma unroll
    for (int j = 0; j < 8; ++j) a8[j] = 0.f;
#pragma unroll
    for (int i = 0; i < 4; ++i) {
      const int c = i * 256 + lane * 4;
      const float4 sc = *(const float4*)(ssc + b * 1024 + c);
      const float4 sh = *(const float4*)(ssh + b * 1024 + c);
      float hv[4];
      hv[0] = xv[i].x * rstd * sc.x + sh.x;
      hv[1] = xv[i].y * rstd * sc.y + sh.y;
      hv[2] = xv[i].z * rstd * sc.z + sh.z;
      hv[3] = xv[i].w * rstd * sc.w + sh.w;
      u2 o; o.x = pack2(hv[0], hv[1]); o.y = pack2(hv[2], hv[3]);
      *(u2*)(p.h + (size_t)row * 1024 + c) = o;
      if (which == 0) {
#pragma unroll
        for (int e = 0; e < 4; ++e) {
          const float4 wa = *(const float4*)(w8 + (c + e) * 8);
          const float4 wb = *(const float4*)(w8 + (c + e) * 8 + 4);
          a8[0] += hv[e] * wa.x; a8[1] += hv[e] * wa.y; a8[2] += hv[e] * wa.z; a8[3] += hv[e] * wa.w;
          a8[4] += hv[e] * wb.x; a8[5] += hv[e] * wb.y; a8[6] += hv[e] * wb.z; a8[7] += hv[e] * wb.w;
        }
      }
    }
    if (which == 0) {
#pragma unroll
      for (int j = 0; j < 8; ++j) a8[j] = wave_sum(a8[j]);
      float mine = 0.f;
#pragma unroll
      for (int j = 0; j < 8; ++j) mine = (lane == j) ? a8[j] : mine;
      if (lane < 4) {
        p.beta[(size_t)row * 4 + lane] = sigmf(mine);
      } else if (lane < 8) {
        const int hh = lane - 4;
        const float xx = mine + p.dn_dt_bias[l * 4 + hh];
        const float sp = xx > 20.f ? xx : log1pf(expf(xx));
        p.glog[(size_t)row * 4 + hh] = -expf(p.dn_a_log[l * 4 + hh]) * sp;
      }
    }
  }
}

DEVI int gate_sec(int gs) { return gs < 3 ? gs : (gs == 3 ? 4 : (gs == 4 ? 6 : gs + 2)); }

DEVI void proj_phase(const P& p, unsigned char* smem) {
  for (int tl = blockIdx.x; tl < 64 * 44; tl += gridDim.x) {
    const int tm = tl / 44, tn = tl % 44;
    f32x4 acc[4][4];
    zero_acc(acc);
    gemm_kloop(p.h + (size_t)tm * 256 * 1024, 1024, p.WinT + (size_t)tn * 128 * 1024, 1024, 1024, acc, (u16*)smem);
    const int s = tn >> 2;
    u16* dst = p.sec + (size_t)s * SECE;
    const int cb = (tn & 3) * 128;
    u16* halo = p.halo;
    epi_foreach(acc, tm * 256, cb, [&](int row, int col, float v) __attribute__((always_inline)) {
      const u16 hv = f2bf(v);
      dst[(size_t)row * 512 + col] = hv;
      if (s < 3 && (row & 63) >= 61) halo[((size_t)(row >> 6) * 3 + ((row & 63) - 61)) * 1536 + s * 512 + col] = hv;
    });
  }
}
DEVI void gates_phase(const P& p, unsigned char* smem) {
  for (int tl = blockIdx.x; tl < 64 * 32; tl += gridDim.x) {
    const int tm = tl >> 5, tn = tl & 31;
    f32x4 acc[4][4];
    zero_acc(acc);
    gemm_kloop(p.h + (size_t)tm * 256 * 1024, 1024, p.WinT + (size_t)(5632 + tn * 128) * 1024, 1024, 1024, acc, (u16*)smem);
    u16* dst = p.sec + (size_t)gate_sec(tn >> 2) * SECE;
    const int cb = (tn & 3) * 128;
    epi_foreach(acc, tm * 256, cb, [&](int row, int col, float v) __attribute__((always_inline)) { dst[(size_t)row * 512 + col] = f2bf(sigmf(v)); });
  }
}
DEVI void merge_phase(const P& p, unsigned char* smem) {
  for (int tl = blockIdx.x; tl < 64 * 8; tl += gridDim.x) {
    const int tm = tl >> 3, tn = tl & 7;
    f32x4 macc[4][4];
    zero_acc(macc);
#pragma unroll 1
    for (int b = 0; b < 4; ++b) {
      const u16* ysec = (b == 0) ? p.sec + 3 * SECE : (b == 1) ? p.YB : (b == 2) ? p.sec + 5 * SECE : p.sec + 10 * SECE;
      f32x4 acc[4][4];
      zero_acc(acc);
      gemm_kloop(ysec + (size_t)tm * 256 * 512, 512, p.WbrT + ((size_t)b * 1024 + tn * 128) * 512, 512, 512, acc, (u16*)smem);
      const u16* gsec = p.sec + (size_t)gate_sec(b * 2 + (tn >> 2)) * SECE;
      const int cb = (tn & 3) * 128;
      const int t = tid_l(), lane = t & 63, wid = t >> 6, wr = wid >> 1, wc = wid & 1;
#pragma unroll
      for (int mi = 0; mi < 4; ++mi)
#pragma unroll
        for (int ni = 0; ni < 4; ++ni)
#pragma unroll
          for (int r = 0; r < 4; ++r) {
            const int row = tm * 256 + wr * 64 + mi * 16 + (lane >> 4) * 4 + r;
            const int col = cb + wc * 64 + ni * 16 + (lane & 15);
            macc[mi][ni][r] += bf2f(gsec[(size_t)row * 512 + col]) * acc[mi][ni][r];
          }
    }
    u16* dst = p.h;
    epi_foreach(macc, tm * 256, tn * 128, [&](int row, int col, float v) __attribute__((always_inline)) { dst[(size_t)row * 1024 + col] = f2bf(v); });
  }
}
DEVI void resid_gemm_phase(const P& p, int l, int which, unsigned char* smem) {
  const u16* A = which == 0 ? p.h : p.sec;
  const int K = which == 0 ? 1024 : 4096;
  const u16* W = which == 0 ? p.WoutT : p.W2T;
  const float* xin = (which == 0 && l == 0) ? p.x : p.out;
  float* gl = (float*)smem;
  for (int tl = blockIdx.x; tl < 64 * 8; tl += gridDim.x) {
    const int tm = tl >> 3, tn = tl & 7;
    f32x4 acc[4][4];
    zero_acc(acc);
    gemm_kloop(A + (size_t)tm * 256 * K, K, W + (size_t)tn * 128 * K, K, K, acc, (u16*)smem);
    const int b = (tm * 256) >> 13;
    { const int tt = tid_l(); if (tt < 128) gl[tt] = modval(p, l, b, (which == 0 ? 2 : 5) * 1024 + tn * 128 + tt); }
    __syncthreads();
    float* out = p.out;
    const int c0 = tn * 128;
    epi_foreach(acc, tm * 256, c0, [&](int row, int col, float v) __attribute__((always_inline)) {
      const size_t o = (size_t)row * 1024 + col;
      out[o] = xin[o] + gl[col - c0] * v;
    });
  }
}
DEVI void mlp1_phase(const P& p, unsigned char* smem) {
  for (int tl = blockIdx.x; tl < 64 * 32; tl += gridDim.x) {
    const int tm = tl >> 5, tn = tl & 31;
    f32x4 acc[4][4];
    zero_acc(acc);
    gemm_kloop(p.h + (size_t)tm * 256 * 1024, 1024, p.W1T + (size_t)tn * 128 * 1024, 1024, 1024, acc, (u16*)smem);
    u16* dst = p.sec;
    epi_foreach(acc, tm * 256, tn * 128, [&](int row, int col, float v) __attribute__((always_inline)) {
      const float r = fmaxf(v, 0.f);
      dst[(size_t)row * 4096 + col] = f2bf(r * r);
    });
  }
}

DEVI void dn_prep_unit(const P& p, int l, int u, unsigned char* smem) {
  const int t = tid_l(), lane = t & 63, wid = t >> 6;
  const int h = u & 3, n = (u >> 2) & 127, b = u >> 9;
  const int r0 = b * SEQ + n * 64;
  u16* Qs = (u16*)smem;
  u16* Ks = Qs + 64 * 136;
  float* Lm = (float*)(Ks + 64 * 136);
  float* cw = Lm + 64 * 64;
  float* gcs = cw + 1536;
  float* bs = gcs + 64;
  for (int i = t; i < 1536; i += NT) {
    const int s = i >> 9, j = (i >> 7) & 3, c = i & 127;
    cw[i] = p.dn_conv_w[(size_t)(l * 4 + j) * 1536 + s * 512 + h * 128 + c];
  }
  if (wid == 0) {
    float g = p.glog[(size_t)(r0 + lane) * 4 + h];
#pragma unroll
    for (int o = 1; o < 64; o <<= 1) {
      const float v = __shfl_up(g, o);
      if (lane >= o) g += v;
    }
    gcs[lane] = g;
    p.gcum[(size_t)(r0 + lane) * 4 + h] = g;
    bs[lane] = p.beta[(size_t)(r0 + lane) * 4 + h];
  }
  __syncthreads();
  const int row = t >> 3, c0 = (t & 7) * 16;
#pragma unroll
  for (int s = 0; s < 3; ++s) {
    u16* sp = p.sec + (size_t)s * SECE;
    float y[16];
#pragma unroll
    for (int c = 0; c < 16; ++c) y[c] = 0.f;
#pragma unroll
    for (int j = 0; j < 4; ++j) {
      const int tt = row - 3 + j;
      u4 v0 = {0, 0, 0, 0}, v1 = {0, 0, 0, 0};
      if (tt >= 0) {
        const u16* src = sp + (size_t)(r0 + tt) * 512 + h * 128 + c0;
        v0 = *(const u4*)src; v1 = *(const u4*)(src + 8);
      } else if (n > 0) {
        const u16* src = p.halo + ((size_t)((r0 >> 6) - 1) * 3 + (tt + 3)) * 1536 + s * 512 + h * 128 + c0;
        v0 = *(const u4*)src; v1 = *(const u4*)(src + 8);
      }
      float f[16];
      unpack8(v0, f); unpack8(v1, f + 8);
#pragma unroll
      for (int c = 0; c < 16; ++c) y[c] += cw[(s * 4 + j) * 128 + c0 + c] * f[c];
    }
    float ss = 0.f;
#pragma unroll
    for (int c = 0; c < 16; ++c) { y[c] = siluf(y[c]); ss += y[c] * y[c]; }
    if (s < 2) {
      ss += __shfl_xor(ss, 1); ss += __shfl_xor(ss, 2); ss += __shfl_xor(ss, 4);
      const float sc = rsqrtf(ss + 1e-6f) * (s == 0 ? 0.08838834764831845f : 1.f);
#pragma unroll
      for (int c = 0; c < 16; ++c) y[c] *= sc;
    }
    const u4 o0 = pack8(y), o1 = pack8(y + 8);
    __syncthreads();
    u16* dstg = sp + (size_t)(r0 + row) * 512 + h * 128 + c0;
    *(u4*)dstg = o0; *(u4*)(dstg + 8) = o1;
    if (s < 2) {
      u16* dl = (s == 0 ? Qs : Ks) + row * 136 + c0;
      *(u4*)dl = o0; *(u4*)(dl + 8) = o1;
    }
  }
  __syncthreads();
  u16* tq = p.TQ + (size_t)u * 8192;
#pragma unroll
  for (int rep = 0; rep < 2; ++rep) {
    const int id = wid + rep * 8, ti = id >> 2, tj = id & 3;
    f32x4 akk = {0.f, 0.f, 0.f, 0.f}, aqk = {0.f, 0.f, 0.f, 0.f};
    if (tj <= ti) {
#pragma unroll
      for (int k0 = 0; k0 < 128; k0 += 32) {
        const bf16x8 bk = frag(Ks, 136, tj * 16, k0, lane);
        akk = mfma16(frag(Ks, 136, ti * 16, k0, lane), bk, akk);
        aqk = mfma16(frag(Qs, 136, ti * 16, k0, lane), bk, aqk);
      }
    }
    const int j = tj * 16 + (lane & 15);
#pragma unroll
    for (int r = 0; r < 4; ++r) {
      const int i = ti * 16 + (lane >> 4) * 4 + r;
      const float dec = (i >= j) ? __expf(gcs[i] - gcs[j]) : 0.f;
      Lm[i * 64 + j] = (i > j) ? bs[i] * akk[r] * dec : 0.f;
      tq[4096 + i * 64 + j] = f2bf(aqk[r] * dec);
    }
  }
  __syncthreads();
  if (wid == 0) {
    float T[64];
#pragma unroll
    for (int i = 0; i < 64; ++i) {
      float s = (i == lane) ? 1.f : 0.f;
#pragma unroll
      for (int j = 0; j < i; ++j) s -= Lm[i * 64 + j] * T[j];
      T[i] = s;
    }
    const float bl = bs[lane];
#pragma unroll
    for (int i = 0; i < 64; ++i) tq[i * 64 + lane] = f2bf(T[i] * bl);
  }
  __syncthreads();
}

DEVI void dn_chain(const P& p, int l, int bh, unsigned char* smem) {
  const int t = tid_l(), lane = t & 63, wid = t >> 6;
  const int h = bh & 3, b = bh >> 2;
  u16* Kh = (u16*)smem;
  u16* Qh = Kh + 64 * 136;
  u16* KT = Qh + 64 * 136;
  u16* TB = KT + 128 * 80;
  u16* QKm = TB + 64 * 80;
  u16* VV = QKm + 64 * 80;
  u16* ST = VV + 128 * 80;
  u16* RT = ST + 128 * 136;
  float* egs = (float*)(RT + 128 * 80);
  float* part = egs + 64;
  const u16* sq = p.sec + h * 128;
  const u16* sk = p.sec + SECE + h * 128;
  const u16* sv = p.sec + 2 * SECE + h * 128;
  u16* sz = p.sec + 3 * SECE + h * 128;
  const int prow = t >> 3, pc0 = (t & 7) * 16;
  const int pt = wid & 3, eh = wid >> 2;
  f32x4 Sacc[8];
#pragma unroll
  for (int j = 0; j < 8; ++j) Sacc[j] = f32x4{0.f, 0.f, 0.f, 0.f};
  for (int i = t; i < 128 * 136 / 8; i += NT) *(u4*)(ST + i * 8) = u4{0, 0, 0, 0};
  u4 rk[2], rq[2], rv[2], rt[2];
  float gr, gG, gme;
  auto prefetch = [&](int n) __attribute__((always_inline)) {
    const size_t r0 = (size_t)b * SEQ + (size_t)n * 64;
    const size_t o = (r0 + prow) * 512 + pc0;
    rk[0] = *(const u4*)(sk + o); rk[1] = *(const u4*)(sk + o + 8);
    rq[0] = *(const u4*)(sq + o); rq[1] = *(const u4*)(sq + o + 8);
    rv[0] = *(const u4*)(sv + o); rv[1] = *(const u4*)(sv + o + 8);
    const u16* tq = p.TQ + (size_t)(((size_t)b * 128 + n) * 4 + h) * 8192;
    rt[0] = *(const u4*)(tq + (size_t)t * 8);
    rt[1] = *(const u4*)(tq + 4096 + (size_t)t * 8);
    gr = p.gcum[(r0 + prow) * 4 + h];
    gG = p.gcum[(r0 + 63) * 4 + h];
    gme = p.gcum[(r0 + (t & 63)) * 4 + h];
  };
  auto stash = [&]() __attribute__((always_inline)) {
    *(u4*)(Kh + prow * 136 + pc0) = rk[0]; *(u4*)(Kh + prow * 136 + pc0 + 8) = rk[1];
    *(u4*)(Qh + prow * 136 + pc0) = rq[0]; *(u4*)(Qh + prow * 136 + pc0 + 8) = rq[1];
    *(u4*)(VV + prow * 136 + pc0) = rv[0]; *(u4*)(VV + prow * 136 + pc0 + 8) = rv[1];
    *(u4*)(TB + (t >> 3) * 80 + (t & 7) * 8) = rt[0];
    *(u4*)(QKm + (t >> 3) * 80 + (t & 7) * 8) = rt[1];
    float f[16];
    unpack8(rk[0], f); unpack8(rk[1], f + 8);
    const float ek = __expf(gG - gr);
#pragma unroll
    for (int c = 0; c < 16; ++c) KT[(pc0 + c) * 80 + prow] = f2bf(f[c] * ek);
    if (t < 64) egs[t] = __expf(gme);
  };
  prefetch(0);
  __syncthreads();
  stash();
  __syncthreads();
  for (int n = 0; n < 128; ++n) {
    const size_t r0 = (size_t)b * SEQ + (size_t)n * 64;
    if (n + 1 < 128) prefetch(n + 1);
    f32x4 accR[4], accO[4];
#pragma unroll
    for (int ni = 0; ni < 4; ++ni) { accR[ni] = f32x4{0.f, 0.f, 0.f, 0.f}; accO[ni] = f32x4{0.f, 0.f, 0.f, 0.f}; }
#pragma unroll
    for (int k0 = 0; k0 < 128; k0 += 32) {
      const bf16x8 ak = frag(Kh, 136, pt * 16, k0, lane), aq = frag(Qh, 136, pt * 16, k0, lane);
#pragma unroll
      for (int ni = 0; ni < 4; ++ni) {
        const bf16x8 bb = frag(ST, 136, (eh * 4 + ni) * 16, k0, lane);
        accR[ni] = mfma16(ak, bb, accR[ni]);
        accO[ni] = mfma16(aq, bb, accO[ni]);
      }
    }
    const int pos0 = pt * 16 + (lane >> 4) * 4;
    float eg4[4];
#pragma unroll
    for (int r = 0; r < 4; ++r) eg4[r] = egs[pos0 + r];
#pragma unroll
    for (int ni = 0; ni < 4; ++ni) {
      const int e = (eh * 4 + ni) * 16 + (lane & 15);
      f32x4 R;
#pragma unroll
      for (int r = 0; r < 4; ++r) {
        R[r] = bf2f(VV[(pos0 + r) * 136 + e]) - eg4[r] * accR[ni][r];
        accO[ni][r] *= eg4[r];
      }
      *(u2*)(RT + e * 80 + pos0) = pack4v(R);
    }
    __syncthreads();
    f32x4 accV[4];
#pragma unroll
    for (int ni = 0; ni < 4; ++ni) accV[ni] = f32x4{0.f, 0.f, 0.f, 0.f};
#pragma unroll
    for (int k0 = 0; k0 < 64; k0 += 32) {
      const bf16x8 a = frag(TB, 80, pt * 16, k0, lane);
#pragma unroll
      for (int ni = 0; ni < 4; ++ni) accV[ni] = mfma16(a, frag(RT, 80, (eh * 4 + ni) * 16, k0, lane), accV[ni]);
    }
#pragma unroll
    for (int ni = 0; ni < 4; ++ni) {
      const int e = (eh * 4 + ni) * 16 + (lane & 15);
      *(u2*)(VV + e * 80 + pos0) = pack4v(accV[ni]);
    }
    __syncthreads();
#pragma unroll
    for (int k0 = 0; k0 < 64; k0 += 32) {
      const bf16x8 a = frag(QKm, 80, pt * 16, k0, lane);
#pragma unroll
      for (int ni = 0; ni < 4; ++ni) accO[ni] = mfma16(a, frag(VV, 80, (eh * 4 + ni) * 16, k0, lane), accO[ni]);
    }
    const float eG = egs[63];
#pragma unroll
    for (int j = 0; j < 8; ++j) Sacc[j] *= eG;
#pragma unroll
    for (int k0 = 0; k0 < 64; k0 += 32) {
      const bf16x8 a = frag(KT, 80, wid * 16, k0, lane);
#pragma unroll
      for (int j = 0; j < 8; ++j) Sacc[j] = mfma16(a, frag(VV, 80, j * 16, k0, lane), Sacc[j]);
    }
    {
      float s4[4];
#pragma unroll
      for (int r = 0; r < 4; ++r) {
        float s = 0.f;
#pragma unroll
        for (int ni = 0; ni < 4; ++ni) s += accO[ni][r] * accO[ni][r];
        s += __shfl_xor(s, 1); s += __shfl_xor(s, 2); s += __shfl_xor(s, 4); s += __shfl_xor(s, 8);
        s4[r] = s;
      }
      if ((lane & 15) == 0) {
#pragma unroll
        for (int r = 0; r < 4; ++r) part[eh * 64 + pos0 + r] = s4[r];
      }
    }
    __syncthreads();
#pragma unroll
    for (int j = 0; j < 8; ++j) {
      const int e = j * 16 + (lane & 15);
      *(u2*)(ST + e * 136 + wid * 16 + (lane >> 4) * 4) = pack4v(Sacc[j]);
    }
    {
      float rs[4];
#pragma unroll
      for (int r = 0; r < 4; ++r) rs[r] = rsqrtf((part[pos0 + r] + part[64 + pos0 + r]) * (1.f / 128.f) + 1e-6f);
#pragma unroll
      for (int ni = 0; ni < 4; ++ni) {
        const int e = (eh * 4 + ni) * 16 + (lane & 15);
        const float ng = p.dn_norm_g[l * 128 + e];
#pragma unroll
        for (int r = 0; r < 4; ++r) {
          u16* zp = sz + (r0 + pos0 + r) * 512 + e;
          const float z = bf2f(*zp);
          *zp = f2bf(accO[ni][r] * rs[r] * ng * siluf(z));
        }
      }
    }
    if (n + 1 < 128) stash();
    __syncthreads();
  }
}

DEVI float ret_log2gamma(int h) { return log2f(1.f - exp2f(-5.f - (float)h)); }
DEVI void load_rope_tile(const P& p, const u16* secp, int r0, int h, float scale, u16* dst, u16* dstT, float l2g) {
  const int t = tid_l();
  const int row = t >> 2, j0 = (t & 3) * 16;
  const u16* src = secp + (size_t)(r0 + row) * 512 + h * 128;
  float x1[16], x2[16];
  unpack8(*(const u4*)(src + j0), x1); unpack8(*(const u4*)(src + j0 + 8), x1 + 8);
  unpack8(*(const u4*)(src + 64 + j0), x2); unpack8(*(const u4*)(src + 64 + j0 + 8), x2 + 8);
  const float* cs = p.ropecs + ((size_t)(r0 + row) * 64 + j0) * 2;
  float o1[16], o2[16];
#pragma unroll
  for (int j = 0; j < 16; j += 2) {
    const float4 c4 = *(const float4*)(cs + j * 2);
    o1[j] = (x1[j] * c4.x - x2[j] * c4.y) * scale;
    o2[j] = (x1[j] * c4.y + x2[j] * c4.x) * scale;
    o1[j + 1] = (x1[j + 1] * c4.z - x2[j + 1] * c4.w) * scale;
    o2[j + 1] = (x1[j + 1] * c4.w + x2[j + 1] * c4.z) * scale;
  }
  *(u4*)(dst + row * 136 + j0) = pack8(o1); *(u4*)(dst + row * 136 + j0 + 8) = pack8(o1 + 8);
  *(u4*)(dst + row * 136 + 64 + j0) = pack8(o2); *(u4*)(dst + row * 136 + 64 + j0 + 8) = pack8(o2 + 8);
  if (dstT) {
    const float z = exp2f(l2g * (float)(127 - row));
#pragma unroll
    for (int j = 0; j < 16; ++j) {
      dstT[(j0 + j) * 136 + row] = f2bf(o1[j] * z);
      dstT[(64 + j0 + j) * 136 + row] = f2bf(o2[j] * z);
    }
  }
}
DEVI void ret_d1_unit(const P& p, int u, unsigned char* smem) {
  const int t = tid_l(), lane = t & 63, wid = t >> 6;
  const int h = u & 3, n = (u >> 2) & 63, b = u >> 8;
  const int r0 = b * SEQ + n * 128;
  const float l2g = ret_log2gamma(h);
  u16* Qs = (u16*)smem;
  u16* Ks = Qs + 128 * 136;
  u16* KTz = Ks + 128 * 136;
  u16* VT = KTz + 128 * 136;
  load_rope_tile(p, p.sec + 7 * SECE, r0, h, 1.f, Qs, nullptr, 0.f);
  load_rope_tile(p, p.sec + 8 * SECE, r0, h, 0.08838834764831845f, Ks, KTz, l2g);
  {
    const int row = t >> 2, c0 = (t & 3) * 32;
    const u16* src = p.sec + 9 * SECE + (size_t)(r0 + row) * 512 + h * 128 + c0;
#pragma unroll
    for (int q = 0; q < 4; ++q) {
      const u4 v = *(const u4*)(src + q * 8);
      const u16* e = (const u16*)&v;
#pragma unroll
      for (int j = 0; j < 8; ++j) VT[(c0 + q * 8 + j) * 136 + row] = e[j];
    }
  }
  __syncthreads();
  f32x4 sacc[8];
#pragma unroll
  for (int ii = 0; ii < 8; ++ii) sacc[ii] = f32x4{0.f, 0.f, 0.f, 0.f};
#pragma unroll
  for (int k0 = 0; k0 < 128; k0 += 32) {
    const bf16x8 a = frag(Ks, 136, wid * 16, k0, lane);
#pragma unroll
    for (int ii = 0; ii < 8; ++ii) sacc[ii] = mfma16(a, frag(Qs, 136, ii * 16, k0, lane), sacc[ii]);
  }
  __syncthreads();
#pragma unroll
  for (int ii = 0; ii < 8; ++ii) {
    const int i = ii * 16 + (lane & 15), j0 = wid * 16 + (lane >> 4) * 4;
    f32x4 v;
#pragma unroll
    for (int r = 0; r < 4; ++r) v[r] = (i >= j0 + r) ? sacc[ii][r] * exp2f(l2g * (float)(i - j0 - r)) : 0.f;
    *(u2*)(Qs + i * 136 + j0) = pack4v(v);
  }
  __syncthreads();
  f32x4 oacc[8], kacc[8];
#pragma unroll
  for (int ii = 0; ii < 8; ++ii) { oacc[ii] = f32x4{0.f, 0.f, 0.f, 0.f}; kacc[ii] = f32x4{0.f, 0.f, 0.f, 0.f}; }
#pragma unroll
  for (int k0 = 0; k0 < 128; k0 += 32) {
    const bf16x8 a1 = frag(Qs, 136, wid * 16, k0, lane), a2 = frag(KTz, 136, wid * 16, k0, lane);
#pragma unroll
    for (int ii = 0; ii < 8; ++ii) {
      const bf16x8 bb = frag(VT, 136, ii * 16, k0, lane);
      oacc[ii] = mfma16(a1, bb, oacc[ii]);
      kacc[ii] = mfma16(a2, bb, kacc[ii]);
    }
  }
  u16* od = p.sec + 8 * SECE;
  u16* kd = p.sec + 9 * SECE;
#pragma unroll
  for (int ii = 0; ii < 8; ++ii) {
    const int e = ii * 16 + (lane & 15);
#pragma unroll
    for (int r = 0; r < 4; ++r) {
      const size_t o = (size_t)(r0 + wid * 16 + (lane >> 4) * 4 + r) * 512 + h * 128 + e;
      od[o] = f2bf(oacc[ii][r]);
      kd[o] = f2bf(kacc[ii][r]);
    }
  }
  __syncthreads();
}
DEVI void ret_d2_unit(const P& p, int l, int u, unsigned char* smem) {
  const int t = tid_l(), lane = t & 63, wid = t >> 6;
  const int h = u & 3, n = (u >> 2) & 63, b = u >> 8;
  const int r0 = b * SEQ + n * 128;
  const float l2g = ret_log2gamma(h);
  u16* Qs = (u16*)smem;
  u16* PT = Qs + 128 * 136;
  load_rope_tile(p, p.sec + 7 * SECE, r0, h, 1.f, Qs, nullptr, 0.f);
  {
    const int d = t >> 2, e0 = (t & 3) * 32;
    float acc[32];
#pragma unroll
    for (int j = 0; j < 32; ++j) acc[j] = 0.f;
    const float G = exp2f(l2g * 128.f);
    const u16* src = p.sec + 9 * SECE + ((size_t)b * SEQ + d) * 512 + h * 128 + e0;
    for (int m = 0; m < n; ++m) {
      const u16* s = src + (size_t)m * 128 * 512;
#pragma unroll
      for (int q = 0; q < 4; ++q) {
        float f[8];
        unpack8(*(const u4*)(s + q * 8), f);
#pragma unroll
        for (int j = 0; j < 8; ++j) acc[q * 8 + j] = acc[q * 8 + j] * G + f[j];
      }
    }
#pragma unroll
    for (int j = 0; j < 32; ++j) PT[(e0 + j) * 136 + d] = f2bf(acc[j]);
  }
  __syncthreads();
  f32x4 oacc[8];
#pragma unroll
  for (int ii = 0; ii < 8; ++ii) oacc[ii] = f32x4{0.f, 0.f, 0.f, 0.f};
#pragma unroll
  for (int k0 = 0; k0 < 128; k0 += 32) {
    const bf16x8 a = frag(Qs, 136, wid * 16, k0, lane);
#pragma unroll
    for (int ii = 0; ii < 8; ++ii) oacc[ii] = mfma16(a, frag(PT, 136, ii * 16, k0, lane), oacc[ii]);
  }
  const u16* oin = p.sec + 8 * SECE;
  u16* gd = p.sec + 10 * SECE;
  const int i0 = wid * 16 + (lane >> 4) * 4;
  float s1[4] = {0.f, 0.f, 0.f, 0.f}, s2[4] = {0.f, 0.f, 0.f, 0.f};
#pragma unroll
  for (int ii = 0; ii < 8; ++ii) {
    const int e = ii * 16 + (lane & 15);
#pragma unroll
    for (int r = 0; r < 4; ++r) {
      const float xi = exp2f(l2g * (float)(i0 + r + 1));
      const float o = bf2f(oin[(size_t)(r0 + i0 + r) * 512 + h * 128 + e]) + xi * oacc[ii][r];
      oacc[ii][r] = o;
      s1[r] += o; s2[r] += o * o;
    }
  }
#pragma unroll
  for (int r = 0; r < 4; ++r) {
#pragma unroll
    for (int o = 1; o < 16; o <<= 1) { s1[r] += __shfl_xor(s1[r], o); s2[r] += __shfl_xor(s2[r], o); }
  }
#pragma unroll
  for (int ii = 0; ii < 8; ++ii) {
    const int e = ii * 16 + (lane & 15);
    const float gg = p.ret_gn_g[l * 512 + h * 128 + e];
#pragma unroll
    for (int r = 0; r < 4; ++r) {
      const float mu = s1[r] * (1.f / 128.f);
      const float var = fmaxf(s2[r] * (1.f / 128.f) - mu * mu, 0.f);
      u16* gp = gd + (size_t)(r0 + i0 + r) * 512 + h * 128 + e;
      const float g = bf2f(*gp);
      *gp = f2bf(siluf(g) * (oacc[ii][r] - mu) * rsqrtf(var + 1e-6f) * gg);
    }
  }
  __syncthreads();
}

DEVI void pool_unit(const P& p, int l, int u, unsigned char* smem) {
  const int t = tid_l(), lane = t & 63, wid = t >> 6;
  const int g = u & 3, rt = u >> 2;
  const int r0 = rt * 64, spos0 = r0 & (SEQ - 1);
  const int win = 2 << g;
  u16* Al = (u16*)smem;
  u16* Wl = Al + 64 * 136;
  {
    const int row = t >> 3, c0 = (t & 7) * 16;
    const u16* base = p.sec + 4 * SECE + g * 128 + c0;
    float sum[16], own[16];
#pragma unroll
    for (int c = 0; c < 16; ++c) sum[c] = 0.f;
    const int sp = spos0 + row;
    const int cnt = min(sp + 1, win);
    for (int j = 0; j < cnt; ++j) {
      const u16* src = base + (size_t)(r0 + row - j) * 512;
      float f[16];
      unpack8(*(const u4*)src, f); unpack8(*(const u4*)(src + 8), f + 8);
#pragma unroll
      for (int c = 0; c < 16; ++c) { sum[c] += f[c]; if (j == 0) own[c] = f[c]; }
    }
    const float ic = 1.f / (float)cnt;
#pragma unroll
    for (int c = 0; c < 16; ++c) sum[c] = sum[c] * ic - own[c];
    *(u4*)(Al + row * 136 + c0) = pack8(sum); *(u4*)(Al + row * 136 + c0 + 8) = pack8(sum + 8);
    const u16* wsrc = p.PoolWT + (size_t)g * 16384;
#pragma unroll
    for (int q = 0; q < 4; ++q) {
      const int idx = t + q * 512;
      const int d = idx >> 4, cc = (idx & 15) * 8;
      *(u4*)(Wl + d * 136 + cc) = *(const u4*)(wsrc + d * 128 + cc);
    }
  }
  __syncthreads();
  const int pt = wid & 3, dh = wid >> 2;
  f32x4 acc[4];
#pragma unroll
  for (int ni = 0; ni < 4; ++ni) acc[ni] = f32x4{0.f, 0.f, 0.f, 0.f};
#pragma unroll
  for (int k0 = 0; k0 < 128; k0 += 32) {
    const bf16x8 a = frag(Al, 136, pt * 16, k0, lane);
#pragma unroll
    for (int ni = 0; ni < 4; ++ni) acc[ni] = mfma16(a, frag(Wl, 136, (dh * 4 + ni) * 16, k0, lane), acc[ni]);
  }
#pragma unroll
  for (int ni = 0; ni < 4; ++ni) {
    const int d = (dh * 4 + ni) * 16 + (lane & 15);
    const float sc = p.pool_scale[l * 512 + g * 128 + d];
#pragma unroll
    for (int r = 0; r < 4; ++r)
      p.YB[(size_t)(r0 + pt * 16 + (lane >> 4) * 4 + r) * 512 + g * 128 + d] = f2bf(acc[ni][r] * sc);
  }
  __syncthreads();
}

DEVI void sg_unit(const P& p, int l, int u, unsigned char* smem) {
  const int t = tid_l(), lane = t & 63, wid = t >> 6;
  const int g = u & 3, ch = u >> 2;
  const int r0 = ch * 128;
  u16* VT = (u16*)smem;
  u16* Ul = VT + 128 * 136;
  u16* Wl = Ul + 128 * 136;
  {
    const int row = t >> 2, q = t & 3;
    const u16* svr = p.sec + 6 * SECE + (size_t)(r0 + row) * 512;
    float s1 = 0.f, s2 = 0.f;
#pragma unroll 4
    for (int i = 0; i < 16; ++i) {
      float f[8];
      unpack8(*(const u4*)(svr + q * 128 + i * 8), f);
#pragma unroll
      for (int j = 0; j < 8; ++j) { const float gv = geluf(f[j]); s1 += gv; s2 += gv * gv; }
    }
    s1 += __shfl_xor(s1, 1); s2 += __shfl_xor(s2, 1);
    s1 += __shfl_xor(s1, 2); s2 += __shfl_xor(s2, 2);
    const float mu = s1 * (1.f / 512.f);
    const float rstd = rsqrtf(fmaxf(s2 * (1.f / 512.f) - mu * mu, 0.f) + 1e-6f);
    const int c0 = q * 32;
    const u16* sur = p.sec + 5 * SECE + (size_t)(r0 + row) * 512 + g * 128 + c0;
#pragma unroll
    for (int i = 0; i < 4; ++i) {
      float f[8], uu[8];
      unpack8(*(const u4*)(svr + g * 128 + c0 + i * 8), f);
      unpack8(*(const u4*)(sur + i * 8), uu);
#pragma unroll
      for (int j = 0; j < 8; ++j) {
        const int c = g * 128 + c0 + i * 8 + j;
        const float vv = (geluf(f[j]) - mu) * rstd * p.sg_ln_g[l * 512 + c] + p.sg_ln_b[l * 512 + c];
        VT[(c0 + i * 8 + j) * 136 + row] = f2bf(vv);
        uu[j] = geluf(uu[j]);
      }
      *(u4*)(Ul + row * 136 + c0 + i * 8) = pack8(uu);
    }
    const float* wsrc = p.sg_w + ((size_t)(l * 4 + g) * 128 + row) * 128 + c0;
#pragma unroll
    for (int i = 0; i < 4; ++i) {
      const float4 a = *(const float4*)(wsrc + i * 8), bq = *(const float4*)(wsrc + i * 8 + 4);
      float f[8] = {a.x, a.y, a.z, a.w, bq.x, bq.y, bq.z, bq.w};
#pragma unroll
      for (int j = 0; j < 8; ++j) f[j] = (c0 + i * 8 + j <= row) ? f[j] : 0.f;
      *(u4*)(Wl + row * 136 + c0 + i * 8) = pack8(f);
    }
  }
  __syncthreads();
  f32x4 acc[8];
#pragma unroll
  for (int ii = 0; ii < 8; ++ii) acc[ii] = f32x4{0.f, 0.f, 0.f, 0.f};
#pragma unroll
  for (int k0 = 0; k0 < 128; k0 += 32) {
    if (k0 <= wid * 16 + 15) {
      const bf16x8 a = frag(Wl, 136, wid * 16, k0, lane);
#pragma unroll
      for (int ii = 0; ii < 8; ++ii) acc[ii] = mfma16(a, frag(VT, 136, ii * 16, k0, lane), acc[ii]);
    }
  }
  u16* dst = p.sec + 5 * SECE;
  const int t0 = wid * 16 + (lane >> 4) * 4;
#pragma unroll
  for (int r = 0; r < 4; ++r) {
    const float bias = p.sg_b[(l * 4 + g) * 128 + t0 + r];
#pragma unroll
    for (int ii = 0; ii < 8; ++ii) {
      const int c = ii * 16 + (lane & 15);
      dst[(size_t)(r0 + t0 + r) * 512 + g * 128 + c] = f2bf(bf2f(Ul[(t0 + r) * 136 + c]) * (acc[ii][r] + bias));
    }
  }
  __syncthreads();
}

DEVI void final_norm_phase(const P& p) {
  const int t = tid_l(), lane = t & 63, wid = t >> 6;
  for (int u = blockIdx.x; u < 2048; u += gridDim.x) {
    const int row = u * 8 + wid;
    float* xr = p.out + (size_t)row * 1024;
    float4 xv[4];
    float ss = 0.f;
#pragma unroll
    for (int i = 0; i < 4; ++i) {
      xv[i] = *(const float4*)(xr + i * 256 + lane * 4);
      ss += xv[i].x * xv[i].x + xv[i].y * xv[i].y + xv[i].z * xv[i].z + xv[i].w * xv[i].w;
    }
    ss = wave_sum(ss);
    const float rstd = rsqrtf(ss * (1.f / 1024.f) + 1e-6f);
#pragma unroll
    for (int i = 0; i < 4; ++i) {
      const float4 g = *(const float4*)(p.final_g + i * 256 + lane * 4);
      float4 o;
      o.x = xv[i].x * rstd * g.x; o.y = xv[i].y * rstd * g.y; o.z = xv[i].z * rstd * g.z; o.w = xv[i].w * rstd * g.w;
      *(float4*)(xr + i * 256 + lane * 4) = o;
    }
  }
}

#ifndef PHMASK
#define PHMASK 0xffffffffu
#endif
#define EN(x) (((PHMASK) >> (x)) & 1u)
DEVI void run_phase(const P& p, int ph, unsigned char* smem) {
  int bid = blockIdx.x; asm volatile("" : "+s"(bid));
  const int nb = gridDim.x;
  if (ph == 0) {
    for (int u = bid; u < 192 + 2048 + NWCONV; u += nb) {
      if (u < 192) { if (EN(0)) mod_unit(p, u, smem); }
      else if (u < 192 + 2048) { if (EN(1)) rope_unit(p, u - 192); }
      else { if (EN(2)) wconv_unit(p, 0, u - 192 - 2048, smem); }
    }
    return;
  }
  if (ph == NPHASE - 1) { if (EN(15)) final_norm_phase(p); return; }
  const int l = (ph - 1) / 10, s = (ph - 1) % 10;
  switch (s) {
    case 0:
      if (l == 1 && EN(2)) for (int u = bid; u < NWCONV; u += nb) wconv_unit(p, 1, u, smem);
      __syncthreads();
      if (EN(3)) norm_phase(p, l, 0, smem);
      break;
    case 1: if (EN(4)) proj_phase(p, smem); break;
    case 2:
      for (int u = bid; u < 1024 + 512 + 512 + 1024; u += nb) {
        if (u < 1024) { if (EN(5)) dn_prep_unit(p, l, u, smem); }
        else if (u < 1536) { if (EN(6)) ret_d1_unit(p, u - 1024, smem); }
        else if (u < 2048) { if (EN(7)) sg_unit(p, l, u - 1536, smem); }
        else { if (EN(8)) pool_unit(p, l, u - 2048, smem); }
      }
      break;
    case 3:
      if (bid < 8) { if (EN(9)) dn_chain(p, l, bid, smem); }
      else if (EN(10)) for (int u = bid - 8; u < 512; u += nb - 8) ret_d2_unit(p, l, u, smem);
      break;
    case 4: if (EN(11)) gates_phase(p, smem); break;
    case 5: if (EN(12)) merge_phase(p, smem); break;
    case 6: if (EN(13)) resid_gemm_phase(p, l, 0, smem); break;
    case 7: if (EN(3)) norm_phase(p, l, 1, smem); break;
    case 8: if (EN(14)) mlp1_phase(p, smem); break;
    case 9: if (EN(13)) resid_gemm_phase(p, l, 1, smem); break;
  }
}

__global__ void __launch_bounds__(NT) mega(P p) {
  extern __shared__ __attribute__((aligned(16))) unsigned char smem[];
  for (int ph = p.phase_lo; ph < p.phase_hi; ++ph) {
    run_phase(p, ph, smem);
    if (ph + 1 < p.phase_hi) cg::this_grid().sync();
  }
}

extern "C" void kernel_launch(void* const* d_in, const int* in_sizes, int n_in, void* d_out, int out_size, void* d_ws,
                              size_t ws_size, hipStream_t stream) {
  static int grid = 0;
  constexpr size_t MiB = 1024 * 1024;
  constexpr size_t WS_NEED = 298 * MiB;
  if (grid == 0) {
    if (ws_size < WS_NEED || n_in != 27) {
      fprintf(stderr, "kernel_launch: ws_size %zu < %zu or n_in %d != 27\n", ws_size, WS_NEED, n_in);
      grid = -1;
      return;
    }
    int dev = 0, cus = 0, per_cu = 0;
    hipGetDevice(&dev);
    hipDeviceGetAttribute(&cus, hipDeviceAttributeMultiprocessorCount, dev);
    hipFuncSetAttribute((const void*)mega, hipFuncAttributeMaxDynamicSharedMemorySize, SMEM_BYTES);
    hipOccupancyMaxActiveBlocksPerMultiprocessor(&per_cu, (const void*)mega, NT, SMEM_BYTES);
    if (per_cu < 1) per_cu = 1;
    grid = cus * per_cu;
    (void)hipGetLastError();
  }
  if (grid < 0) return;
  P p{};
  p.x = (const float*)d_in[0]; p.c = (const float*)d_in[1]; p.pos = (const int*)d_in[2];
  p.norm1_g = (const float*)d_in[3]; p.norm2_g = (const float*)d_in[4];
  p.ada_w = (const float*)d_in[5]; p.ada_b = (const float*)d_in[6]; p.w_in = (const float*)d_in[7];
  p.dn_conv_w = (const float*)d_in[8]; p.dn_a_log = (const float*)d_in[9]; p.dn_dt_bias = (const float*)d_in[10];
  p.dn_norm_g = (const float*)d_in[11]; p.pool_w = (const float*)d_in[12]; p.pool_scale = (const float*)d_in[13];
  p.sg_ln_g = (const float*)d_in[14]; p.sg_ln_b = (const float*)d_in[15]; p.sg_w = (const float*)d_in[16];
  p.sg_b = (const float*)d_in[17]; p.ret_gn_g = (const float*)d_in[18];
  p.w_br[0] = (const float*)d_in[19]; p.w_br[1] = (const float*)d_in[20]; p.w_br[2] = (const float*)d_in[21];
  p.w_br[3] = (const float*)d_in[22];
  p.w_out = (const float*)d_in[23]; p.mlp_w1 = (const float*)d_in[24]; p.mlp_w2 = (const float*)d_in[25];
  p.final_g = (const float*)d_in[26];
  p.out = (float*)d_out;
  unsigned char* ws = (unsigned char*)d_ws;
  size_t o = 0;
  p.WinT = (u16*)(ws + o); o += (size_t)9728 * 1024 * 2;
  p.WbrT = (u16*)(ws + o); o += (size_t)4 * 1024 * 512 * 2;
  p.WoutT = (u16*)(ws + o); o += (size_t)1024 * 1024 * 2;
  p.W1T = (u16*)(ws + o); o += (size_t)4096 * 1024 * 2;
  p.W2T = (u16*)(ws + o); o += (size_t)4096 * 1024 * 2;
  p.PoolWT = (u16*)(ws + o); o += (size_t)4 * 128 * 128 * 2;
  o = 44 * MiB;
  p.h = (u16*)(ws + o); o += 32 * MiB;
  p.sec = (u16*)(ws + o); o += 176 * MiB;
  p.TQ = (u16*)(ws + o); o += 16 * MiB;
  p.YB = (u16*)(ws + o); o += 16 * MiB;
  p.halo = (u16*)(ws + o); o += 3 * MiB;
  p.modp = (float*)(ws + o); o += 1 * MiB;
  p.beta = (float*)(ws + o); o += 262144;
  p.glog = (float*)(ws + o); o += 262144;
  p.gcum = (float*)(ws + o); o += 262144;
  p.ropecs = (float*)(ws + o); o += 8 * MiB;
#if COOP
  p.phase_lo = 0; p.phase_hi = NPHASE;
  void* args[] = {&p};
  hipError_t e = hipLaunchCooperativeKernel((const void*)mega, dim3(grid), dim3(NT), args, SMEM_BYTES, stream);
  if (e != hipSuccess) fprintf(stderr, "cooperative launch failed: %s (grid %d)\n", hipGetErrorString(e), grid);
#else
  for (int ph = 0; ph < NPHASE; ++ph) {
    p.phase_lo = ph; p.phase_hi = ph + 1;
    hipLaunchKernelGGL(mega, dim3(grid), dim3(NT), SMEM_BYTES, stream, p);
  }
#endif
}
```

```cpp
#include <hip/hip_runtime.h>
#include <hip/hip_bf16.h>
#include <hip/hip_cooperative_groups.h>
#include <cstdio>
namespace cg = cooperative_groups;

#ifndef COOP
#define COOP 1
#endif

typedef unsigned short u16;
using bf16x8 = __attribute__((ext_vector_type(8))) short;
using f32x4 = __attribute__((ext_vector_type(4))) float;
using u4 = __attribute__((ext_vector_type(4))) unsigned;
using u2 = __attribute__((ext_vector_type(2))) unsigned;
#define DEVI __device__ __forceinline__

constexpr int NT = 512;
constexpr int SEQ = 8192;
constexpr size_t SECE = (size_t)16384 * 512;
constexpr int SMEM_BYTES = 156 * 1024;
constexpr int NPHASE = 22;

struct P {
  const float *x, *c;
  const int* pos;
  const float *norm1_g, *norm2_g, *ada_w, *ada_b, *w_in, *dn_conv_w, *dn_a_log, *dn_dt_bias, *dn_norm_g, *pool_w,
      *pool_scale, *sg_ln_g, *sg_ln_b, *sg_w, *sg_b, *ret_gn_g, *w_br[4], *w_out, *mlp_w1, *mlp_w2, *final_g;
  float* out;
  u16 *WinT, *WbrT, *WoutT, *W1T, *W2T, *PoolWT, *h, *sec, *TQ, *YB, *halo;
  float *modp, *beta, *glog, *gcum, *ropecs;
  int phase_lo, phase_hi;
};

DEVI int tid_l() { int t = threadIdx.x; asm volatile("" : "+v"(t)); return t; }
template <class T> DEVI void lnd(T*& q) { asm volatile("" : "+s"(q)); }
DEVI u16 f2bf(float f) {
  unsigned u = __float_as_uint(f);
  u += 0x7fffu + ((u >> 16) & 1u);
  return (u16)(u >> 16);
}
DEVI float bf2f(u16 h) { return __uint_as_float(((unsigned)h) << 16); }
DEVI unsigned pack2(float a, float b) { return (unsigned)f2bf(a) | ((unsigned)f2bf(b) << 16); }
DEVI float lo2f(unsigned u) { return __uint_as_float(u << 16); }
DEVI float hi2f(unsigned u) { return __uint_as_float(u & 0xffff0000u); }
DEVI void unpack8(u4 v, float* f) {
  f[0] = lo2f(v.x); f[1] = hi2f(v.x); f[2] = lo2f(v.y); f[3] = hi2f(v.y);
  f[4] = lo2f(v.z); f[5] = hi2f(v.z); f[6] = lo2f(v.w); f[7] = hi2f(v.w);
}
DEVI u4 pack8(const float* f) {
  u4 v; v.x = pack2(f[0], f[1]); v.y = pack2(f[2], f[3]); v.z = pack2(f[4], f[5]); v.w = pack2(f[6], f[7]);
  return v;
}
DEVI float wave_sum(float v) {
#pragma unroll
  for (int o = 32; o > 0; o >>= 1) v += __shfl_xor(v, o);
  return v;
}
DEVI float siluf(float x) { return x / (1.f + __expf(-x)); }
DEVI float sigmf(float x) { return 1.f / (1.f + __expf(-x)); }
DEVI float geluf(float x) { return 0.5f * x * (1.f + erff(x * 0.70710678118654752f)); }
DEVI f32x4 mfma16(bf16x8 a, bf16x8 b, f32x4 c) { return __builtin_amdgcn_mfma_f32_16x16x32_bf16(a, b, c, 0, 0, 0); }
DEVI bf16x8 frag(const u16* base, int ld, int r0, int k0, int lane) {
  return *(const bf16x8*)(base + (r0 + (lane & 15)) * ld + k0 + 8 * (lane >> 4));
}
DEVI u2 pack4v(f32x4 v) { u2 r; r.x = pack2(v[0], v[1]); r.y = pack2(v[2], v[3]); return r; }

DEVI float modval(const P& p, int l, int b, int j) {
  float s = p.ada_b[l * 6144 + j];
#pragma unroll
  for (int ks = 0; ks < 8; ++ks) s += p.modp[(size_t)((ks * 2 + l) * 2 + b) * 6144 + j];
  return s;
}

DEVI void gemm_kloop(const u16* __restrict__ A, int lda, const u16* __restrict__ Bt, int ldb, int K,
                     f32x4 (&acc)[4][4], u16* sm) {
  const int t = tid_l(), lane = t & 63, wid = t >> 6, wr = wid >> 1, wc = wid & 1;
  u16* As = sm;
  u16* Bs = sm + 2 * 256 * 64;
  const int lrow = t >> 3, lch = t & 7;
  const u16* ag = A + (size_t)lrow * lda + lch * 8;
  const u16* bg = Bt + (size_t)lrow * ldb + lch * 8;
  const int soff = lrow * 64 + ((lch ^ (lrow & 7)) * 8);
  u4 ra[4], rb[2];
#pragma unroll
  for (int i = 0; i < 4; ++i) ra[i] = *(const u4*)(ag + (size_t)i * 64 * lda);
#pragma unroll
  for (int i = 0; i < 2; ++i) rb[i] = *(const u4*)(bg + (size_t)i * 64 * ldb);
  __syncthreads();
#pragma unroll
  for (int i = 0; i < 4; ++i) *(u4*)(As + i * 64 * 64 + soff) = ra[i];
#pragma unroll
  for (int i = 0; i < 2; ++i) *(u4*)(Bs + i * 64 * 64 + soff) = rb[i];
  __syncthreads();
  const int nt = K >> 6;
  const int arow = (wr * 64 + (lane & 15)) * 64, brow = (wc * 64 + (lane & 15)) * 64;
  for (int kt = 0; kt < nt; ++kt) {
    const int cur = kt & 1;
    if (kt + 1 < nt) {
      const int ko = (kt + 1) * 64;
#pragma unroll
      for (int i = 0; i < 4; ++i) ra[i] = *(const u4*)(ag + (size_t)i * 64 * lda + ko);
#pragma unroll
      for (int i = 0; i < 2; ++i) rb[i] = *(const u4*)(bg + (size_t)i * 64 * ldb + ko);
    }
    const u16* Ac = As + cur * 256 * 64 + arow;
    const u16* Bc = Bs + cur * 128 * 64 + brow;
#pragma unroll
    for (int kk = 0; kk < 2; ++kk) {
      const int ch = (((kk * 4 + (lane >> 4)) ^ (lane & 7)) * 8);
      bf16x8 af[4], bfr[4];
#pragma unroll
      for (int mi = 0; mi < 4; ++mi) af[mi] = *(const bf16x8*)(Ac + mi * 16 * 64 + ch);
#pragma unroll
      for (int ni = 0; ni < 4; ++ni) bfr[ni] = *(const bf16x8*)(Bc + ni * 16 * 64 + ch);
#pragma unroll
      for (int mi = 0; mi < 4; ++mi)
#pragma unroll
        for (int ni = 0; ni < 4; ++ni) acc[mi][ni] = mfma16(af[mi], bfr[ni], acc[mi][ni]);
    }
    if (kt + 1 < nt) {
      const int nb = cur ^ 1;
#pragma unroll
      for (int i = 0; i < 4; ++i) *(u4*)(As + nb * 256 * 64 + i * 64 * 64 + soff) = ra[i];
#pragma unroll
      for (int i = 0; i < 2; ++i) *(u4*)(Bs + nb * 128 * 64 + i * 64 * 64 + soff) = rb[i];
    }
    __syncthreads();
  }
}
DEVI void zero_acc(f32x4 (&acc)[4][4]) {
#pragma unroll
  for (int i = 0; i < 4; ++i)
#pragma unroll
    for (int j = 0; j < 4; ++j) acc[i][j] = f32x4{0.f, 0.f, 0.f, 0.f};
}
template <class F>
DEVI void epi_foreach(f32x4 (&acc)[4][4], int row0, int col0, F f) {
  const int t = tid_l(), lane = t & 63, wid = t >> 6, wr = wid >> 1, wc = wid & 1;
#pragma unroll
  for (int mi = 0; mi < 4; ++mi)
#pragma unroll
    for (int ni = 0; ni < 4; ++ni)
#pragma unroll
      for (int r = 0; r < 4; ++r)
        f(row0 + wr * 64 + mi * 16 + (lane >> 4) * 4 + r, col0 + wc * 64 + ni * 16 + (lane & 15), acc[mi][ni][r]);
}

DEVI void mod_unit(const P& p, int u, unsigned char* smem) {
  const int t = tid_l();
  const int l = u / 96, rem = u % 96, jb = rem >> 3, ks = rem & 7;
  float* cond = (float*)smem;
  if (t < 256) {
    const int b = t >> 7, k = t & 127;
    cond[t] = siluf(p.c[b * 1024 + ks * 128 + k]);
  }
  __syncthreads();
  const int j = jb * 512 + t;
  const float* w = p.ada_w + ((size_t)l * 1024 + ks * 128) * 6144 + j;
  float a0 = 0.f, a1 = 0.f;
#pragma unroll 8
  for (int k = 0; k < 128; ++k) {
    const float wv = w[(size_t)k * 6144];
    a0 += cond[k] * wv;
    a1 += cond[128 + k] * wv;
  }
  p.modp[(size_t)((ks * 2 + l) * 2 + 0) * 6144 + j] = a0;
  p.modp[(size_t)((ks * 2 + l) * 2 + 1) * 6144 + j] = a1;
  __syncthreads();
}
DEVI void rope_unit(const P& p, int u) {
  const int idx = u * 512 + tid_l();
  const int tok = idx >> 6, j = idx & 63;
  const float inv = exp2f(-(float)j * (13.287712379549449f / 64.f));
  const float ang = (float)p.pos[tok] * inv;
  double rev = (double)ang * 0.15915494309189535;
  rev -= rint(rev);
  const float r = (float)(rev * 6.283185307179586);
  p.ropecs[(size_t)idx * 2] = __cosf(r);
  p.ropecs[(size_t)idx * 2 + 1] = __sinf(r);
}
DEVI void conv_tile(const float* __restrict__ src, int ld, int K, int kt, int nt, int col0, u16* __restrict__ dst,
                    unsigned char* smem) {
  float* ls = (float*)smem;
  const int t = tid_l();
#pragma unroll
  for (int ps = 0; ps < 2; ++ps) {
    const int kk = ps * 32 + (t >> 4), n4 = (t & 15) * 4;
    const float4 v = *(const float4*)(src + (size_t)(kt * 64 + kk) * ld + col0 + n4);
    ls[kk * 65 + n4] = v.x; ls[kk * 65 + n4 + 1] = v.y; ls[kk * 65 + n4 + 2] = v.z; ls[kk * 65 + n4 + 3] = v.w;
  }
  __syncthreads();
  const int n = t >> 3, kc = (t & 7) * 8;
  float f[8];
#pragma unroll
  for (int j = 0; j < 8; ++j) f[j] = ls[(kc + j) * 65 + n];
  *(u4*)(dst + (size_t)(nt * 64 + n) * K + kt * 64 + kc) = pack8(f);
  __syncthreads();
}
constexpr int NWCONV = 2432 + 512 + 256 + 1024 + 1024 + 16;
DEVI void wconv_unit(const P& p, int l, int w, unsigned char* smem) {
  if (w < 2432) {
    const int kt = w & 15, nt = w >> 4;
    conv_tile(p.w_in + (size_t)l * 1024 * 9736, 9736, 1024, kt, nt, nt * 64 + (nt * 64 >= 2048 ? 8 : 0), p.WinT, smem);
    return;
  }
  w -= 2432;
  if (w < 512) {
    const int b = w >> 7, r = w & 127, kt = r & 7, nt = r >> 3;
    conv_tile((b == 0 ? p.w_br[0] : b == 1 ? p.w_br[1] : b == 2 ? p.w_br[2] : p.w_br[3]) + (size_t)l * 512 * 1024, 1024, 512, kt, nt, nt * 64, p.WbrT + (size_t)b * 1024 * 512, smem);
    return;
  }
  w -= 512;
  if (w < 256) {
    conv_tile(p.w_out + (size_t)l * 1024 * 1024, 1024, 1024, w & 15, w >> 4, (w >> 4) * 64, p.WoutT, smem);
    return;
  }
  w -= 256;
  if (w < 1024) {
    conv_tile(p.mlp_w1 + (size_t)l * 1024 * 4096, 4096, 1024, w & 15, w >> 4, (w >> 4) * 64, p.W1T, smem);
    return;
  }
  w -= 1024;
  if (w < 1024) {
    conv_tile(p.mlp_w2 + (size_t)l * 4096 * 1024, 1024, 4096, w & 63, w >> 6, (w >> 6) * 64, p.W2T, smem);
    return;
  }
  w -= 1024;
  {
    const int g = w >> 2, r = w & 3;
    conv_tile(p.pool_w + (size_t)(l * 4 + g) * 16384, 128, 128, r & 1, r >> 1, (r >> 1) * 64, p.PoolWT + (size_t)g * 16384, smem);
  }
}

DEVI void norm_phase(const P& p, int l, int which, unsigned char* smem) {
  const int t = tid_l(), lane = t & 63, wid = t >> 6;
  float* ssh = (float*)smem;
  float* ssc = ssh + 2048;
  float* w8 = ssc + 2048;
  const float* gsrc = (which == 0 ? p.norm1_g : p.norm2_g) + l * 1024;
  const int ish = which == 0 ? 0 : 3;
  for (int i = t; i < 2048; i += NT) {
    const int b = i >> 10, c = i & 1023;
    ssh[i] = modval(p, l, b, ish * 1024 + c);
    ssc[i] = gsrc[c] * (1.f + modval(p, l, b, (ish + 1) * 1024 + c));
  }
  if (which == 0) {
    for (int i = t; i < 2048; i += NT) {
      const int k = i >> 1, hf = i & 1;
      *(float4*)(w8 + k * 8 + hf * 4) = *(const float4*)(p.w_in + ((size_t)l * 1024 + k) * 9736 + 2048 + hf * 4);
    }
  }
  __syncthreads();
  const float* xs = (l == 0 && which == 0) ? p.x : p.out;
  for (int u = blockIdx.x; u < 2048; u += gridDim.x) {
    const int row = u * 8 + wid, b = row >> 13;
    const float* xr = xs + (size_t)row * 1024;
    float4 xv[4];
    float ss = 0.f;
#pragma unroll
    for (int i = 0; i < 4; ++i) {
      xv[i] = *(const float4*)(xr + i * 256 + lane * 4);
      ss += xv[i].x * xv[i].x + xv[i].y * xv[i].y + xv[i].z * xv[i].z + xv[i].w * xv[i].w;
    }
    ss = wave_sum(ss);
    const float rstd = rsqrtf(ss * (1.f / 1024.f) + 1e-6f);
    float a8[8];
#pragma unroll
    for (int j = 0; j < 8; ++j) a8[j] = 0.f;
#pragma unroll
    for (int i = 0; i < 4; ++i) {
      const int c = i * 256 + lane * 4;
      const float4 sc = *(const float4*)(ssc + b * 1024 + c);
      const float4 sh = *(const float4*)(ssh + b * 1024 + c);
      float hv[4];
      hv[0] = xv[i].x * rstd * sc.x + sh.x;
      hv[1] = xv[i].y * rstd * sc.y + sh.y;
      hv[2] = xv[i].z * rstd * sc.z + sh.z;
      hv[3] = xv[i].w * rstd * sc.w + sh.w;
      u2 o; o.x = pack2(hv[0], hv[1]); o.y = pack2(hv[2], hv[3]);
      *(u2*)(p.h + (size_t)row * 1024 + c) = o;
      if (which == 0) {
#pragma unroll
        for (int e = 0; e < 4; ++e) {
          const float4 wa = *(const float4*)(w8 + (c + e) * 8);
          const float4 wb = *(const float4*)(w8 + (c + e) * 8 + 4);
          a8[0] += hv[e] * wa.x; a8[1] += hv[e] * wa.y; a8[2] += hv[e] * wa.z; a8[3] += hv[e] * wa.w;
          a8[4] += hv[e] * wb.x; a8[5] += hv[e] * wb.y; a8[6] += hv[e] * wb.z; a8[7] += hv[e] * wb.w;
        }
      }
    }
    if (which == 0) {
#pragma unroll
      for (int j = 0; j < 8; ++j) a8[j] = wave_sum(a8[j]);
      float mine = 0.f;
#pragma unroll
      for (int j = 0; j < 8; ++j) mine = (lane == j) ? a8[j] : mine;
      if (lane < 4) {
        p.beta[(size_t)row * 4 + lane] = sigmf(mine);
      } else if (lane < 8) {
        const int hh = lane - 4;
        const float xx = mine + p.dn_dt_bias[l * 4 + hh];
        const float sp = xx > 20.f ? xx : log1pf(expf(xx));
        p.glog[(size_t)row * 4 + hh] = -expf(p.dn_a_log[l * 4 + hh]) * sp;
      }
    }
  }
}

DEVI int gate_sec(int gs) { return gs < 3 ? gs : (gs == 3 ? 4 : (gs == 4 ? 6 : gs + 2)); }

DEVI void proj_phase(const P& p, unsigned char* smem) {
  for (int tl = blockIdx.x; tl < 64 * 44; tl += gridDim.x) {
    const int tm = tl / 44, tn = tl % 44;
    f32x4 acc[4][4];
    zero_acc(acc);
    gemm_kloop(p.h + (size_t)tm * 256 * 1024, 1024, p.WinT + (size_t)tn * 128 * 1024, 1024, 1024, acc, (u16*)smem);
    const int s = tn >> 2;
    u16* dst = p.sec + (size_t)s * SECE;
    const int cb = (tn & 3) * 128;
    u16* halo = p.halo;
    epi_foreach(acc, tm * 256, cb, [&](int row, int col, float v) __attribute__((always_inline)) {
      const u16 hv = f2bf(v);
      dst[(size_t)row * 512 + col] = hv;
      if (s < 3 && (row & 63) >= 61) halo[((size_t)(row >> 6) * 3 + ((row & 63) - 61)) * 1536 + s * 512 + col] = hv;
    });
  }
}
DEVI void gates_phase(const P& p, unsigned char* smem) {
  for (int tl = blockIdx.x; tl < 64 * 32; tl += gridDim.x) {
    const int tm = tl >> 5, tn = tl & 31;
    f32x4 acc[4][4];
    zero_acc(acc);
    gemm_kloop(p.h + (size_t)tm * 256 * 1024, 1024, p.WinT + (size_t)(5632 + tn * 128) * 1024, 1024, 1024, acc, (u16*)smem);
    u16* dst = p.sec + (size_t)gate_sec(tn >> 2) * SECE;
    const int cb = (tn & 3) * 128;
    epi_foreach(acc, tm * 256, cb, [&](int row, int col, float v) __attribute__((always_inline)) { dst[(size_t)row * 512 + col] = f2bf(sigmf(v)); });
  }
}
DEVI void merge_phase(const P& p, unsigned char* smem) {
  for (int tl = blockIdx.x; tl < 64 * 8; tl += gridDim.x) {
    const int tm = tl >> 3, tn = tl & 7;
    f32x4 macc[4][4];
    zero_acc(macc);
#pragma unroll 1
    for (int b = 0; b < 4; ++b) {
      const u16* ysec = (b == 0) ? p.sec + 3 * SECE : (b == 1) ? p.YB : (b == 2) ? p.sec + 5 * SECE : p.sec + 10 * SECE;
      f32x4 acc[4][4];
      zero_acc(acc);
      gemm_kloop(ysec + (size_t)tm * 256 * 512, 512, p.WbrT + ((size_t)b * 1024 + tn * 128) * 512, 512, 512, acc, (u16*)smem);
      const u16* gsec = p.sec + (size_t)gate_sec(b * 2 + (tn >> 2)) * SECE;
      const int cb = (tn & 3) * 128;
      const int t = tid_l(), lane = t & 63, wid = t >> 6, wr = wid >> 1, wc = wid & 1;
#pragma unroll
      for (int mi = 0; mi < 4; ++mi)
#pragma unroll
        for (int ni = 0; ni < 4; ++ni)
#pragma unroll
          for (int r = 0; r < 4; ++r) {
            const int row = tm * 256 + wr * 64 + mi * 16 + (lane >> 4) * 4 + r;
            const int col = cb + wc * 64 + ni * 16 + (lane & 15);
            macc[mi][ni][r] += bf2f(gsec[(size_t)row * 512 + col]) * acc[mi][ni][r];
          }
    }
    u16* dst = p.h;
    epi_foreach(macc, tm * 256, tn * 128, [&](int row, int col, float v) __attribute__((always_inline)) { dst[(size_t)row * 1024 + col] = f2bf(v); });
  }
}
DEVI void resid_gemm_phase(const P& p, int l, int which, unsigned char* smem) {
  const u16* A = which == 0 ? p.h : p.sec;
  const int K = which == 0 ? 1024 : 4096;
  const u16* W = which == 0 ? p.WoutT : p.W2T;
  const float* xin = (which == 0 && l == 0) ? p.x : p.out;
  float* gl = (float*)smem;
  for (int tl = blockIdx.x; tl < 64 * 8; tl += gridDim.x) {
    const int tm = tl >> 3, tn = tl & 7;
    f32x4 acc[4][4];
    zero_acc(acc);
    gemm_kloop(A + (size_t)tm * 256 * K, K, W + (size_t)tn * 128 * K, K, K, acc, (u16*)smem);
    const int b = (tm * 256) >> 13;
    { const int tt = tid_l(); if (tt < 128) gl[tt] = modval(p, l, b, (which == 0 ? 2 : 5) * 1024 + tn * 128 + tt); }
    __syncthreads();
    float* out = p.out;
    const int c0 = tn * 128;
    epi_foreach(acc, tm * 256, c0, [&](int row, int col, float v) __attribute__((always_inline)) {
      const size_t o = (size_t)row * 1024 + col;
      out[o] = xin[o] + gl[col - c0] * v;
    });
  }
}
DEVI void mlp1_phase(const P& p, unsigned char* smem) {
  for (int tl = blockIdx.x; tl < 64 * 32; tl += gridDim.x) {
    const int tm = tl >> 5, tn = tl & 31;
    f32x4 acc[4][4];
    zero_acc(acc);
    gemm_kloop(p.h + (size_t)tm * 256 * 1024, 1024, p.W1T + (size_t)tn * 128 * 1024, 1024, 1024, acc, (u16*)smem);
    u16* dst = p.sec;
    epi_foreach(acc, tm * 256, tn * 128, [&](int row, int col, float v) __attribute__((always_inline)) {
      const float r = fmaxf(v, 0.f);
      dst[(size_t)row * 4096 + col] = f2bf(r * r);
    });
  }
}

DEVI void dn_prep_unit(const P& p, int l, int u, unsigned char* smem) {
  const int t = tid_l(), lane = t & 63, wid = t >> 6;
  const int h = u & 3, n = (u >> 2) & 127, b = u >> 9;
  const int r0 = b * SEQ + n * 64;
  u16* Qs = (u16*)smem;
  u16* Ks = Qs + 64 * 136;
  float* Lm = (float*)(Ks + 64 * 136);
  float* cw = Lm + 64 * 64;
  float* gcs = cw + 1536;
  float* bs = gcs + 64;
  for (int i = t; i < 1536; i += NT) {
    const int s = i >> 9, j = (i >> 7) & 3, c = i & 127;
    cw[i] = p.dn_conv_w[(size_t)(l * 4 + j) * 1536 + s * 512 + h * 128 + c];
  }
  if (wid == 0) {
    float g = p.glog[(size_t)(r0 + lane) * 4 + h];
#pragma unroll
    for (int o = 1; o < 64; o <<= 1) {
      const float v = __shfl_up(g, o);
      if (lane >= o) g += v;
    }
    gcs[lane] = g;
    p.gcum[(size_t)(r0 + lane) * 4 + h] = g;
    bs[lane] = p.beta[(size_t)(r0 + lane) * 4 + h];
  }
  __syncthreads();
  const int row = t >> 3, c0 = (t & 7) * 16;
#pragma unroll
  for (int s = 0; s < 3; ++s) {
    u16* sp = p.sec + (size_t)s * SECE;
    float y[16];
#pragma unroll
    for (int c = 0; c < 16; ++c) y[c] = 0.f;
#pragma unroll
    for (int j = 0; j < 4; ++j) {
      const int tt = row - 3 + j;
      u4 v0 = {0, 0, 0, 0}, v1 = {0, 0, 0, 0};
      if (tt >= 0) {
        const u16* src = sp + (size_t)(r0 + tt) * 512 + h * 128 + c0;
        v0 = *(const u4*)src; v1 = *(const u4*)(src + 8);
      } else if (n > 0) {
        const u16* src = p.halo + ((size_t)((r0 >> 6) - 1) * 3 + (tt + 3)) * 1536 + s * 512 + h * 128 + c0;
        v0 = *(const u4*)src; v1 = *(const u4*)(src + 8);
      }
      float f[16];
      unpack8(v0, f); unpack8(v1, f + 8);
#pragma unroll
      for (int c = 0; c < 16; ++c) y[c] += cw[(s * 4 + j) * 128 + c0 + c] * f[c];
    }
    float ss = 0.f;
#pragma unroll
    for (int c = 0; c < 16; ++c) { y[c] = siluf(y[c]); ss += y[c] * y[c]; }
    if (s < 2) {
      ss += __shfl_xor(ss, 1); ss += __shfl_xor(ss, 2); ss += __shfl_xor(ss, 4);
      const float sc = rsqrtf(ss + 1e-6f) * (s == 0 ? 0.08838834764831845f : 1.f);
#pragma unroll
      for (int c = 0; c < 16; ++c) y[c] *= sc;
    }
    const u4 o0 = pack8(y), o1 = pack8(y + 8);
    __syncthreads();
    u16* dstg = sp + (size_t)(r0 + row) * 512 + h * 128 + c0;
    *(u4*)dstg = o0; *(u4*)(dstg + 8) = o1;
    if (s < 2) {
      u16* dl = (s == 0 ? Qs : Ks) + row * 136 + c0;
      *(u4*)dl = o0; *(u4*)(dl + 8) = o1;
    }
  }
  __syncthreads();
  u16* tq = p.TQ + (size_t)u * 8192;
#pragma unroll
  for (int rep = 0; rep < 2; ++rep) {
    const int id = wid + rep * 8, ti = id >> 2, tj = id & 3;
    f32x4 akk = {0.f, 0.f, 0.f, 0.f}, aqk = {0.f, 0.f, 0.f, 0.f};
    if (tj <= ti) {
#pragma unroll
      for (int k0 = 0; k0 < 128; k0 += 32) {
        const bf16x8 bk = frag(Ks, 136, tj * 16, k0, lane);
        akk = mfma16(frag(Ks, 136, ti * 16, k0, lane), bk, akk);
        aqk = mfma16(frag(Qs, 136, ti * 16, k0, lane), bk, aqk);
      }
    }
    const int j = tj * 16 + (lane & 15);
#pragma unroll
    for (int r = 0; r < 4; ++r) {
      const int i = ti * 16 + (lane >> 4) * 4 + r;
      const float dec = (i >= j) ? __expf(gcs[i] - gcs[j]) : 0.f;
      Lm[i * 64 + j] = (i > j) ? bs[i] * akk[r] * dec : 0.f;
      tq[4096 + i * 64 + j] = f2bf(aqk[r] * dec);
    }
  }
  __syncthreads();
  if (wid == 0) {
    float T[64];
#pragma unroll
    for (int i = 0; i < 64; ++i) {
      float s = (i == lane) ? 1.f : 0.f;
#pragma unroll
      for (int j = 0; j < i; ++j) s -= Lm[i * 64 + j] * T[j];
      T[i] = s;
    }
    const float bl = bs[lane];
#pragma unroll
    for (int i = 0; i < 64; ++i) tq[i * 64 + lane] = f2bf(T[i] * bl);
  }
  __syncthreads();
}

DEVI void dn_chain(const P& p, int l, int bh, unsigned char* smem) {
  const int t = tid_l(), lane = t & 63, wid = t >> 6;
  const int h = bh & 3, b = bh >> 2;
  u16* Kh = (u16*)smem;
  u16* Qh = Kh + 64 * 136;
  u16* KT = Qh + 64 * 136;
  u16* TB = KT + 128 * 80;
  u16* QKm = TB + 64 * 80;
  u16* VV = QKm + 64 * 80;
  u16* ST = VV + 128 * 80;
  u16* RT = ST + 128 * 136;
  float* egs = (float*)(RT + 128 * 80);
  float* part = egs + 64;
  const u16* sq = p.sec + h * 128;
  const u16* sk = p.sec + SECE + h * 128;
  const u16* sv = p.sec + 2 * SECE + h * 128;
  u16* sz = p.sec + 3 * SECE + h * 128;
  const int prow = t >> 3, pc0 = (t & 7) * 16;
  const int pt = wid & 3, eh = wid >> 2;
  f32x4 Sacc[8];
#pragma unroll
  for (int j = 0; j < 8; ++j) Sacc[j] = f32x4{0.f, 0.f, 0.f, 0.f};
  for (int i = t; i < 128 * 136 / 8; i += NT) *(u4*)(ST + i * 8) = u4{0, 0, 0, 0};
  u4 rk[2], rq[2], rv[2], rt[2];
  float gr, gG, gme;
  auto prefetch = [&](int n) __attribute__((always_inline)) {
    const size_t r0 = (size_t)b * SEQ + (size_t)n * 64;
    const size_t o = (r0 + prow) * 512 + pc0;
    rk[0] = *(const u4*)(sk + o); rk[1] = *(const u4*)(sk + o + 8);
    rq[0] = *(const u4*)(sq + o); rq[1] = *(const u4*)(sq + o + 8);
    rv[0] = *(const u4*)(sv + o); rv[1] = *(const u4*)(sv + o + 8);
    const u16* tq = p.TQ + (size_t)(((size_t)b * 128 + n) * 4 + h) * 8192;
    rt[0] = *(const u4*)(tq + (size_t)t * 8);
    rt[1] = *(const u4*)(tq + 4096 + (size_t)t * 8);
    gr = p.gcum[(r0 + prow) * 4 + h];
    gG = p.gcum[(r0 + 63) * 4 + h];
    gme = p.gcum[(r0 + (t & 63)) * 4 + h];
  };
  auto stash = [&]() __attribute__((always_inline)) {
    *(u4*)(Kh + prow * 136 + pc0) = rk[0]; *(u4*)(Kh + prow * 136 + pc0 + 8) = rk[1];
    *(u4*)(Qh + prow * 136 + pc0) = rq[0]; *(u4*)(Qh + prow * 136 + pc0 + 8) = rq[1];
    *(u4*)(VV + prow * 136 + pc0) = rv[0]; *(u4*)(VV + prow * 136 + pc0 + 8) = rv[1];
    *(u4*)(TB + (t >> 3) * 80 + (t & 7) * 8) = rt[0];
    *(u4*)(QKm + (t >> 3) * 80 + (t & 7) * 8) = rt[1];
    float f[16];
    unpack8(rk[0], f); unpack8(rk[1], f + 8);
    const float ek = __expf(gG - gr);
#pragma unroll
    for (int c = 0; c < 16; ++c) KT[(pc0 + c) * 80 + prow] = f2bf(f[c] * ek);
    if (t < 64) egs[t] = __expf(gme);
  };
  prefetch(0);
  __syncthreads();
  stash();
  __syncthreads();
  for (int n = 0; n < 128; ++n) {
    const size_t r0 = (size_t)b * SEQ + (size_t)n * 64;
    if (n + 1 < 128) prefetch(n + 1);
    f32x4 accR[4], accO[4];
#pragma unroll
    for (int ni = 0; ni < 4; ++ni) { accR[ni] = f32x4{0.f, 0.f, 0.f, 0.f}; accO[ni] = f32x4{0.f, 0.f, 0.f, 0.f}; }
#pragma unroll
    for (int k0 = 0; k0 < 128; k0 += 32) {
      const bf16x8 ak = frag(Kh, 136, pt * 16, k0, lane), aq = frag(Qh, 136, pt * 16, k0, lane);
#pragma unroll
      for (int ni = 0; ni < 4; ++ni) {
        const bf16x8 bb = frag(ST, 136, (eh * 4 + ni) * 16, k0, lane);
        accR[ni] = mfma16(ak, bb, accR[ni]);
        accO[ni] = mfma16(aq, bb, accO[ni]);
      }
    }
    const int pos0 = pt * 16 + (lane >> 4) * 4;
    float eg4[4];
#pragma unroll
    for (int r = 0; r < 4; ++r) eg4[r] = egs[pos0 + r];
#pragma unroll
    for (int ni = 0; ni < 4; ++ni) {
      const int e = (eh * 4 + ni) * 16 + (lane & 15);
      f32x4 R;
#pragma unroll
      for (int r = 0; r < 4; ++r) {
        R[r] = bf2f(VV[(pos0 + r) * 136 + e]) - eg4[r] * accR[ni][r];
        accO[ni][r] *= eg4[r];
      }
      *(u2*)(RT + e * 80 + pos0) = pack4v(R);
    }
    __syncthreads();
    f32x4 accV[4];
#pragma unroll
    for (int ni = 0; ni < 4; ++ni) accV[ni] = f32x4{0.f, 0.f, 0.f, 0.f};
#pragma unroll
    for (int k0 = 0; k0 < 64; k0 += 32) {
      const bf16x8 a = frag(TB, 80, pt * 16, k0, lane);
#pragma unroll
      for (int ni = 0; ni < 4; ++ni) accV[ni] = mfma16(a, frag(RT, 80, (eh * 4 + ni) * 16, k0, lane), accV[ni]);
    }
#pragma unroll
    for (int ni = 0; ni < 4; ++ni) {
      const int e = (eh * 4 + ni) * 16 + (lane & 15);
      *(u2*)(VV + e * 80 + pos0) = pack4v(accV[ni]);
    }
    __syncthreads();
#pragma unroll
    for (int k0 = 0; k0 < 64; k0 += 32) {
      const bf16x8 a = frag(QKm, 80, pt * 16, k0, lane);
#pragma unroll
      for (int ni = 0; ni < 4; ++ni) accO[ni] = mfma16(a, frag(VV, 80, (eh * 4 + ni) * 16, k0, lane), accO[ni]);
    }
    const float eG = egs[63];
#pragma unroll
    for (int j = 0; j < 8; ++j) Sacc[j] *= eG;
#pragma unroll
    for (int k0 = 0; k0 < 64; k0 += 32) {
      const bf16x8 a = frag(KT, 80, wid * 16, k0, lane);
#pragma unroll
      for (int j = 0; j < 8; ++j) Sacc[j] = mfma16(a, frag(VV, 80, j * 16, k0, lane), Sacc[j]);
    }
    {
      float s4[4];
#pragma unroll
      for (int r = 0; r < 4; ++r) {
        float s = 0.f;
#pragma unroll
        for (int ni = 0; ni < 4; ++ni) s += accO[ni][r] * accO[ni][r];
        s += __shfl_xor(s, 1); s += __shfl_xor(s, 2); s += __shfl_xor(s, 4); s += __shfl_xor(s, 8);
        s4[r] = s;
      }
      if ((lane & 15) == 0) {
#pragma unroll
        for (int r = 0; r < 4; ++r) part[eh * 64 + pos0 + r] = s4[r];
      }
    }
    __syncthreads();
#pragma unroll
    for (int j = 0; j < 8; ++j) {
      const int e = j * 16 + (lane & 15);
      *(u2*)(ST + e * 136 + wid * 16 + (lane >> 4) * 4) = pack4v(Sacc[j]);
    }
    {
      float rs[4];
#pragma unroll
      for (int r = 0; r < 4; ++r) rs[r] = rsqrtf((part[pos0 + r] + part[64 + pos0 + r]) * (1.f / 128.f) + 1e-6f);
#pragma unroll
      for (int ni = 0; ni < 4; ++ni) {
        const int e = (eh * 4 + ni) * 16 + (lane & 15);
        const float ng = p.dn_norm_g[l * 128 + e];
#pragma unroll
        for (int r = 0; r < 4; ++r) {
          u16* zp = sz + (r0 + pos0 + r) * 512 + e;
          const float z = bf2f(*zp);
          *zp = f2bf(accO[ni][r] * rs[r] * ng * siluf(z));
        }
      }
    }
    if (n + 1 < 128) stash();
    __syncthreads();
  }
}

DEVI float ret_log2gamma(int h) { return log2f(1.f - exp2f(-5.f - (float)h)); }
DEVI void load_rope_tile(const P& p, const u16* secp, int r0, int h, float scale, u16* dst, u16* dstT, float l2g) {
  const int t = tid_l();
  const int row = t >> 2, j0 = (t & 3) * 16;
  const u16* src = secp + (size_t)(r0 + row) * 512 + h * 128;
  float x1[16], x2[16];
  unpack8(*(const u4*)(src + j0), x1); unpack8(*(const u4*)(src + j0 + 8), x1 + 8);
  unpack8(*(const u4*)(src + 64 + j0), x2); unpack8(*(const u4*)(src + 64 + j0 + 8), x2 + 8);
  const float* cs = p.ropecs + ((size_t)(r0 + row) * 64 + j0) * 2;
  float o1[16], o2[16];
#pragma unroll
  for (int j = 0; j < 16; j += 2) {
    const float4 c4 = *(const float4*)(cs + j * 2);
    o1[j] = (x1[j] * c4.x - x2[j] * c4.y) * scale;
    o2[j] = (x1[j] * c4.y + x2[j] * c4.x) * scale;
    o1[j + 1] = (x1[j + 1] * c4.z - x2[j + 1] * c4.w) * scale;
    o2[j + 1] = (x1[j + 1] * c4.w + x2[j + 1] * c4.z) * scale;
  }
  *(u4*)(dst + row * 136 + j0) = pack8(o1); *(u4*)(dst + row * 136 + j0 + 8) = pack8(o1 + 8);
  *(u4*)(dst + row * 136 + 64 + j0) = pack8(o2); *(u4*)(dst + row * 136 + 64 + j0 + 8) = pack8(o2 + 8);
  if (dstT) {
    const float z = exp2f(l2g * (float)(127 - row));
#pragma unroll
    for (int j = 0; j < 16; ++j) {
      dstT[(j0 + j) * 136 + row] = f2bf(o1[j] * z);
      dstT[(64 + j0 + j) * 136 + row] = f2bf(o2[j] * z);
    }
  }
}
DEVI void ret_d1_unit(const P& p, int u, unsigned char* smem) {
  const int t = tid_l(), lane = t & 63, wid = t >> 6;
  const int h = u & 3, n = (u >> 2) & 63, b = u >> 8;
  const int r0 = b * SEQ + n * 128;
  const float l2g = ret_log2gamma(h);
  u16* Qs = (u16*)smem;
  u16* Ks = Qs + 128 * 136;
  u16* KTz = Ks + 128 * 136;
  u16* VT = KTz + 128 * 136;
  load_rope_tile(p, p.sec + 7 * SECE, r0, h, 1.f, Qs, nullptr, 0.f);
  load_rope_tile(p, p.sec + 8 * SECE, r0, h, 0.08838834764831845f, Ks, KTz, l2g);
  {
    const int row = t >> 2, c0 = (t & 3) * 32;
    const u16* src = p.sec + 9 * SECE + (size_t)(r0 + row) * 512 + h * 128 + c0;
#pragma unroll
    for (int q = 0; q < 4; ++q) {
      const u4 v = *(const u4*)(src + q * 8);
      const u16* e = (const u16*)&v;
#pragma unroll
      for (int j = 0; j < 8; ++j) VT[(c0 + q * 8 + j) * 136 + row] = e[j];
    }
  }
  __syncthreads();
  f32x4 sacc[8];
#pragma unroll
  for (int ii = 0; ii < 8; ++ii) sacc[ii] = f32x4{0.f, 0.f, 0.f, 0.f};
#pragma unroll
  for (int k0 = 0; k0 < 128; k0 += 32) {
    const bf16x8 a = frag(Ks, 136, wid * 16, k0, lane);
#pragma unroll
    for (int ii = 0; ii < 8; ++ii) sacc[ii] = mfma16(a, frag(Qs, 136, ii * 16, k0, lane), sacc[ii]);
  }
  __syncthreads();
#pragma unroll
  for (int ii = 0; ii < 8; ++ii) {
    const int i = ii * 16 + (lane & 15), j0 = wid * 16 + (lane >> 4) * 4;
    f32x4 v;
#pragma unroll
    for (int r = 0; r < 4; ++r) v[r] = (i >= j0 + r) ? sacc[ii][r] * exp2f(l2g * (float)(i - j0 - r)) : 0.f;
    *(u2*)(Qs + i * 136 + j0) = pack4v(v);
  }
  __syncthreads();
  f32x4 oacc[8], kacc[8];
#pragma unroll
  for (int ii = 0; ii < 8; ++ii) { oacc[ii] = f32x4{0.f, 0.f, 0.f, 0.f}; kacc[ii] = f32x4{0.f, 0.f, 0.f, 0.f}; }
#pragma unroll
  for (int k0 = 0; k0 < 128; k0 += 32) {
    const bf16x8 a1 = frag(Qs, 136, wid * 16, k0, lane), a2 = frag(KTz, 136, wid * 16, k0, lane);
#pragma unroll
    for (int ii = 0; ii < 8; ++ii) {
      const bf16x8 bb = frag(VT, 136, ii * 16, k0, lane);
      oacc[ii] = mfma16(a1, bb, oacc[ii]);
      kacc[ii] = mfma16(a2, bb, kacc[ii]);
    }
  }
  u16* od = p.sec + 8 * SECE;
  u16* kd = p.sec + 9 * SECE;
#pragma unroll
  for (int ii = 0; ii < 8; ++ii) {
    const int e = ii * 16 + (lane & 15);
#pragma unroll
    for (int r = 0; r < 4; ++r) {
      const size_t o = (size_t)(r0 + wid * 16 + (lane >> 4) * 4 + r) * 512 + h * 128 + e;
      od[o] = f2bf(oacc[ii][r]);
      kd[o] = f2bf(kacc[ii][r]);
    }
  }
  __syncthreads();
}
DEVI void ret_d2_unit(const P& p, int l, int u, unsigned char* smem) {
  const int t = tid_l(), lane = t & 63, wid = t >> 6;
  const int h = u & 3, n = (u >> 2) & 63, b = u >> 8;
  const int r0 = b * SEQ + n * 128;
  const float l2g = ret_log2gamma(h);
  u16* Qs = (u16*)smem;
  u16* PT = Qs + 128 * 136;
  load_rope_tile(p, p.sec + 7 * SECE, r0, h, 1.f, Qs, nullptr, 0.f);
  {
    const int d = t >> 2, e0 = (t & 3) * 32;
    float acc[32];
#pragma unroll
    for (int j = 0; j < 32; ++j) acc[j] = 0.f;
    const float G = exp2f(l2g * 128.f);
    const u16* src = p.sec + 9 * SECE + ((size_t)b * SEQ + d) * 512 + h * 128 + e0;
    for (int m = 0; m < n; ++m) {
      const u16* s = src + (size_t)m * 128 * 512;
#pragma unroll
      for (int q = 0; q < 4; ++q) {
        float f[8];
        unpack8(*(const u4*)(s + q * 8), f);
#pragma unroll
        for (int j = 0; j < 8; ++j) acc[q * 8 + j] = acc[q * 8 + j] * G + f[j];
      }
    }
#pragma unroll
    for (int j = 0; j < 32; ++j) PT[(e0 + j) * 136 + d] = f2bf(acc[j]);
  }
  __syncthreads();
  f32x4 oacc[8];
#pragma unroll
  for (int ii = 0; ii < 8; ++ii) oacc[ii] = f32x4{0.f, 0.f, 0.f, 0.f};
#pragma unroll
  for (int k0 = 0; k0 < 128; k0 += 32) {
    const bf16x8 a = frag(Qs, 136, wid * 16, k0, lane);
#pragma unroll
    for (int ii = 0; ii < 8; ++ii) oacc[ii] = mfma16(a, frag(PT, 136, ii * 16, k0, lane), oacc[ii]);
  }
  const u16* oin = p.sec + 8 * SECE;
  u16* gd = p.sec + 10 * SECE;
  const int i0 = wid * 16 + (lane >> 4) * 4;
  float s1[4] = {0.f, 0.f, 0.f, 0.f}, s2[4] = {0.f, 0.f, 0.f, 0.f};
#pragma unroll
  for (int ii = 0; ii < 8; ++ii) {
    const int e = ii * 16 + (lane & 15);
#pragma unroll
    for (int r = 0; r < 4; ++r) {
      const float xi = exp2f(l2g * (float)(i0 + r + 1));
      const float o = bf2f(oin[(size_t)(r0 + i0 + r) * 512 + h * 128 + e]) + xi * oacc[ii][r];
      oacc[ii][r] = o;
      s1[r] += o; s2[r] += o * o;
    }
  }
#pragma unroll
  for (int r = 0; r < 4; ++r) {
#pragma unroll
    for (int o = 1; o < 16; o <<= 1) { s1[r] += __shfl_xor(s1[r], o); s2[r] += __shfl_xor(s2[r], o); }
  }
#pragma unroll
  for (int ii = 0; ii < 8; ++ii) {
    const int e = ii * 16 + (lane & 15);
    const float gg = p.ret_gn_g[l * 512 + h * 128 + e];
#pragma unroll
    for (int r = 0; r < 4; ++r) {
      const float mu = s1[r] * (1.f / 128.f);
      const float var = fmaxf(s2[r] * (1.f / 128.f) - mu * mu, 0.f);
      u16* gp = gd + (size_t)(r0 + i0 + r) * 512 + h * 128 + e;
      const float g = bf2f(*gp);
      *gp = f2bf(siluf(g) * (oacc[ii][r] - mu) * rsqrtf(var + 1e-6f) * gg);
    }
  }
  __syncthreads();
}

DEVI void pool_unit(const P& p, int l, int u, unsigned char* smem) {
  const int t = tid_l(), lane = t & 63, wid = t >> 6;
  const int g = u & 3, rt = u >> 2;
  const int r0 = rt * 64, spos0 = r0 & (SEQ - 1);
  const int win = 2 << g;
  u16* Al = (u16*)smem;
  u16* Wl = Al + 64 * 136;
  {
    const int row = t >> 3, c0 = (t & 7) * 16;
    const u16* base = p.sec + 4 * SECE + g * 128 + c0;
    float sum[16], own[16];
#pragma unroll
    for (int c = 0; c < 16; ++c) sum[c] = 0.f;
    const int sp = spos0 + row;
    const int cnt = min(sp + 1, win);
    for (int j = 0; j < cnt; ++j) {
      const u16* src = base + (size_t)(r0 + row - j) * 512;
      float f[16];
      unpack8(*(const u4*)src, f); unpack8(*(const u4*)(src + 8), f + 8);
#pragma unroll
      for (int c = 0; c < 16; ++c) { sum[c] += f[c]; if (j == 0) own[c] = f[c]; }
    }
    const float ic = 1.f / (float)cnt;
#pragma unroll
    for (int c = 0; c < 16; ++c) sum[c] = sum[c] * ic - own[c];
    *(u4*)(Al + row * 136 + c0) = pack8(sum); *(u4*)(Al + row * 136 + c0 + 8) = pack8(sum + 8);
    const u16* wsrc = p.PoolWT + (size_t)g * 16384;
#pragma unroll
    for (int q = 0; q < 4; ++q) {
      const int idx = t + q * 512;
      const int d = idx >> 4, cc = (idx & 15) * 8;
      *(u4*)(Wl + d * 136 + cc) = *(const u4*)(wsrc + d * 128 + cc);
    }
  }
  __syncthreads();
  const int pt = wid & 3, dh = wid >> 2;
  f32x4 acc[4];
#pragma unroll
  for (int ni = 0; ni < 4; ++ni) acc[ni] = f32x4{0.f, 0.f, 0.f, 0.f};
#pragma unroll
  for (int k0 = 0; k0 < 128; k0 += 32) {
    const bf16x8 a = frag(Al, 136, pt * 16, k0, lane);
#pragma unroll
    for (int ni = 0; ni < 4; ++ni) acc[ni] = mfma16(a, frag(Wl, 136, (dh * 4 + ni) * 16, k0, lane), acc[ni]);
  }
#pragma unroll
  for (int ni = 0; ni < 4; ++ni) {
    const int d = (dh * 4 + ni) * 16 + (lane & 15);
    const float sc = p.pool_scale[l * 512 + g * 128 + d];
#pragma unroll
    for (int r = 0; r < 4; ++r)
      p.YB[(size_t)(r0 + pt * 16 + (lane >> 4) * 4 + r) * 512 + g * 128 + d] = f2bf(acc[ni][r] * sc);
  }
  __syncthreads();
}

DEVI void sg_unit(const P& p, int l, int u, unsigned char* smem) {
  const int t = tid_l(), lane = t & 63, wid = t >> 6;
  const int g = u & 3, ch = u >> 2;
  const int r0 = ch * 128;
  u16* VT = (u16*)smem;
  u16* Ul = VT + 128 * 136;
  u16* Wl = Ul + 128 * 136;
  {
    const int row = t >> 2, q = t & 3;
    const u16* svr = p.sec + 6 * SECE + (size_t)(r0 + row) * 512;
    float s1 = 0.f, s2 = 0.f;
#pragma unroll 4
    for (int i = 0; i < 16; ++i) {
      float f[8];
      unpack8(*(const u4*)(svr + q * 128 + i * 8), f);
#pragma unroll
      for (int j = 0; j < 8; ++j) { const float gv = geluf(f[j]); s1 += gv; s2 += gv * gv; }
    }
    s1 += __shfl_xor(s1, 1); s2 += __shfl_xor(s2, 1);
    s1 += __shfl_xor(s1, 2); s2 += __shfl_xor(s2, 2);
    const float mu = s1 * (1.f / 512.f);
    const float rstd = rsqrtf(fmaxf(s2 * (1.f / 512.f) - mu * mu, 0.f) + 1e-6f);
    const int c0 = q * 32;
    const u16* sur = p.sec + 5 * SECE + (size_t)(r0 + row) * 512 + g * 128 + c0;
#pragma unroll
    for (int i = 0; i < 4; ++i) {
      float f[8], uu[8];
      unpack8(*(const u4*)(svr + g * 128 + c0 + i * 8), f);
      unpack8(*(const u4*)(sur + i * 8), uu);
#pragma unroll
      for (int j = 0; j < 8; ++j) {
        const int c = g * 128 + c0 + i * 8 + j;
        const float vv = (geluf(f[j]) - mu) * rstd * p.sg_ln_g[l * 512 + c] + p.sg_ln_b[l * 512 + c];
        VT[(c0 + i * 8 + j) * 136 + row] = f2bf(vv);
        uu[j] = geluf(uu[j]);
      }
      *(u4*)(Ul + row * 136 + c0 + i * 8) = pack8(uu);
    }
    const float* wsrc = p.sg_w + ((size_t)(l * 4 + g) * 128 + row) * 128 + c0;
#pragma unroll
    for (int i = 0; i < 4; ++i) {
      const float4 a = *(const float4*)(wsrc + i * 8), bq = *(const float4*)(wsrc + i * 8 + 4);
      float f[8] = {a.x, a.y, a.z, a.w, bq.x, bq.y, bq.z, bq.w};
#pragma unroll
      for (int j = 0; j < 8; ++j) f[j] = (c0 + i * 8 + j <= row) ? f[j] : 0.f;
      *(u4*)(Wl + row * 136 + c0 + i * 8) = pack8(f);
    }
  }
  __syncthreads();
  f32x4 acc[8];
#pragma unroll
  for (int ii = 0; ii < 8; ++ii) acc[ii] = f32x4{0.f, 0.f, 0.f, 0.f};
#pragma unroll
  for (int k0 = 0; k0 < 128; k0 += 32) {
    if (k0 <= wid * 16 + 15) {
      const bf16x8 a = frag(Wl, 136, wid * 16, k0, lane);
#pragma unroll
      for (int ii = 0; ii < 8; ++ii) acc[ii] = mfma16(a, frag(VT, 136, ii * 16, k0, lane), acc[ii]);
    }
  }
  u16* dst = p.sec + 5 * SECE;
  const int t0 = wid * 16 + (lane >> 4) * 4;
#pragma unroll
  for (int r = 0; r < 4; ++r) {
    const float bias = p.sg_b[(l * 4 + g) * 128 + t0 + r];
#pragma unroll
    for (int ii = 0; ii < 8; ++ii) {
      const int c = ii * 16 + (lane & 15);
      dst[(size_t)(r0 + t0 + r) * 512 + g * 128 + c] = f2bf(bf2f(Ul[(t0 + r) * 136 + c]) * (acc[ii][r] + bias));
    }
  }
  __syncthreads();
}

DEVI void final_norm_phase(const P& p) {
  const int t = tid_l(), lane = t & 63, wid = t >> 6;
  for (int u = blockIdx.x; u < 2048; u += gridDim.x) {
    const int row = u * 8 + wid;
    float* xr = p.out + (size_t)row * 1024;
    float4 xv[4];
    float ss = 0.f;
#pragma unroll
    for (int i = 0; i < 4; ++i) {
      xv[i] = *(const float4*)(xr + i * 256 + lane * 4);
      ss += xv[i].x * xv[i].x + xv[i].y * xv[i].y + xv[i].z * xv[i].z + xv[i].w * xv[i].w;
    }
    ss = wave_sum(ss);
    const float rstd = rsqrtf(ss * (1.f / 1024.f) + 1e-6f);
#pragma unroll
    for (int i = 0; i < 4; ++i) {
      const float4 g = *(const float4*)(p.final_g + i * 256 + lane * 4);
      float4 o;
      o.x = xv[i].x * rstd * g.x; o.y = xv[i].y * rstd * g.y; o.z = xv[i].z * rstd * g.z; o.w = xv[i].w * rstd * g.w;
      *(float4*)(xr + i * 256 + lane * 4) = o;
    }
  }
}

#ifndef PHMASK
#define PHMASK 0xffffffffu
#endif
#define EN(x) (((PHMASK) >> (x)) & 1u)
DEVI void run_phase(const P& p, int ph, unsigned char* smem) {
  int bid = blockIdx.x; asm volatile("" : "+s"(bid));
  const int nb = gridDim.x;
  if (ph == 0) {
    for (int u = bid; u < 192 + 2048 + NWCONV; u += nb) {
      if (u < 192) { if (EN(0)) mod_unit(p, u, smem); }
      else if (u < 192 + 2048) { if (EN(1)) rope_unit(p, u - 192); }
      else { if (EN(2)) wconv_unit(p, 0, u - 192 - 2048, smem); }
    }
    return;
  }
  if (ph == NPHASE - 1) { if (EN(15)) final_norm_phase(p); return; }
  const int l = (ph - 1) / 10, s = (ph - 1) % 10;
  switch (s) {
    case 0:
      if (l == 1 && EN(2)) for (int u = bid; u < NWCONV; u += nb) wconv_unit(p, 1, u, smem);
      __syncthreads();
      if (EN(3)) norm_phase(p, l, 0, smem);
      break;
    case 1: if (EN(4)) proj_phase(p, smem); break;
    case 2:
      for (int u = bid; u < 1024 + 512 + 512 + 1024; u += nb) {
        if (u < 1024) { if (EN(5)) dn_prep_unit(p, l, u, smem); }
        else if (u < 1536) { if (EN(6)) ret_d1_unit(p, u - 1024, smem); }
        else if (u < 2048) { if (EN(7)) sg_unit(p, l, u - 1536, smem); }
        else { if (EN(8)) pool_unit(p, l, u - 2048, smem); }
      }
      break;
    case 3:
      if (bid < 8) { if (EN(9)) dn_chain(p, l, bid, smem); }
      else if (EN(10)) for (int u = bid - 8; u < 512; u += nb - 8) ret_d2_unit(p, l, u, smem);
      break;
    case 4: if (EN(11)) gates_phase(p, smem); break;
    case 5: if (EN(12)) merge_phase(p, smem); break;
    case 6: if (EN(13)) resid_gemm_phase(p, l, 0, smem); break;
    case 7: if (EN(3)) norm_phase(p, l, 1, smem); break;
    case 8: if (EN(14)) mlp1_phase(p, smem); break;
    case 9: if (EN(13)) resid_gemm_phase(p, l, 1, smem); break;
  }
}

__global__ void __launch_bounds__(NT) mega(P p) {
  extern __shared__ __attribute__((aligned(16))) unsigned char smem[];
  for (int ph = p.phase_lo; ph < p.phase_hi; ++ph) {
    run_phase(p, ph, smem);
    if (ph + 1 < p.phase_hi) cg::this_grid().sync();
  }
}

extern "C" void kernel_launch(void* const* d_in, const int* in_sizes, int n_in, void* d_out, int out_size, void* d_ws,
                              size_t ws_size, hipStream_t stream) {
  static int grid = 0;
  constexpr size_t MiB = 1024 * 1024;
  constexpr size_t WS_NEED = 298 * MiB;
  if (grid == 0) {
    if (ws_size < WS_NEED || n_in != 27) {
      fprintf(stderr, "kernel_launch: ws_size %zu < %zu or n_in %d != 27\n", ws_size, WS_NEED, n_in);
      grid = -1;
      return;
    }
    int dev = 0, cus = 0, per_cu = 0;
    hipGetDevice(&dev);
    hipDeviceGetAttribute(&cus, hipDeviceAttributeMultiprocessorCount, dev);
    hipFuncSetAttribute((const void*)mega, hipFuncAttributeMaxDynamicSharedMemorySize, SMEM_BYTES);
    hipOccupancyMaxActiveBlocksPerMultiprocessor(&per_cu, (const void*)mega, NT, SMEM_BYTES);
    if (per_cu < 1) per_cu = 1;
    grid = cus * per_cu;
    (void)hipGetLastError();
  }
  if (grid < 0) return;
  P p{};
  p.x = (const float*)d_in[0]; p.c = (const float*)d_in[1]; p.pos = (const int*)d_in[2];
  p.norm1_g = (const float*)d_in[3]; p.norm2_g = (const float*)d_in[4];
  p.ada_w = (const float*)d_in[5]; p.ada_b = (const float*)d_in[6]; p.w_in = (const float*)d_in[7];
  p.dn_conv_w = (const float*)d_in[8]; p.dn_a_log = (const float*)d_in[9]; p.dn_dt_bias = (const float*)d_in[10];
  p.dn_norm_g = (const float*)d_in[11]; p.pool_w = (const float*)d_in[12]; p.pool_scale = (const float*)d_in[13];
  p.sg_ln_g = (const float*)d_in[14]; p.sg_ln_b = (const float*)d_in[15]; p.sg_w = (const float*)d_in[16];
  p.sg_b = (const float*)d_in[17]; p.ret_gn_g = (const float*)d_in[18];
  p.w_br[0] = (const float*)d_in[19]; p.w_br[1] = (const float*)d_in[20]; p.w_br[2] = (const float*)d_in[21];
  p.w_br[3] = (const float*)d_in[22];
  p.w_out = (const float*)d_in[23]; p.mlp_w1 = (const float*)d_in[24]; p.mlp_w2 = (const float*)d_in[25];
  p.final_g = (const float*)d_in[26];
  p.out = (float*)d_out;
  unsigned char* ws = (unsigned char*)d_ws;
  size_t o = 0;
  p.WinT = (u16*)(ws + o); o += (size_t)9728 * 1024 * 2;
  p.WbrT = (u16*)(ws + o); o += (size_t)4 * 1024 * 512 * 2;
  p.WoutT = (u16*)(ws + o); o += (size_t)1024 * 1024 * 2;
  p.W1T = (u16*)(ws + o); o += (size_t)4096 * 1024 * 2;
  p.W2T = (u16*)(ws + o); o += (size_t)4096 * 1024 * 2;
  p.PoolWT = (u16*)(ws + o); o += (size_t)4 * 128 * 128 * 2;
  o = 44 * MiB;
  p.h = (u16*)(ws + o); o += 32 * MiB;
  p.sec = (u16*)(ws + o); o += 176 * MiB;
  p.TQ = (u16*)(ws + o); o += 16 * MiB;
  p.YB = (u16*)(ws + o); o += 16 * MiB;
  p.halo = (u16*)(ws + o); o += 3 * MiB;
  p.modp = (float*)(ws + o); o += 1 * MiB;
  p.beta = (float*)(ws + o); o += 262144;
  p.glog = (float*)(ws + o); o += 262144;
  p.gcum = (float*)(ws + o); o += 262144;
  p.ropecs = (float*)(ws + o); o += 8 * MiB;
#if COOP
  p.phase_lo = 0; p.phase_hi = NPHASE;
  void* args[] = {&p};
  hipError_t e = hipLaunchCooperativeKernel((const void*)mega, dim3(grid), dim3(NT), args, SMEM_BYTES, stream);
  if (e != hipSuccess) fprintf(stderr, "cooperative launch failed: %s (grid %d)\n", hipGetErrorString(e), grid);
#else
  for (int ph = 0; ph < NPHASE; ++ph) {
    p.phase_lo = ph; p.phase_hi = ph + 1;
    hipLaunchKernelGGL(mega, dim3(grid), dim3(NT), SMEM_BYTES, stream, p);
  }
#endif
}
```

```cpp
#include <hip/hip_runtime.h>
#include <hip/hip_bf16.h>
#include <hip/hip_cooperative_groups.h>
#include <cstdio>
namespace cg = cooperative_groups;

#ifndef COOP
#define COOP 1
#endif

typedef unsigned short u16;
using bf16x8 = __attribute__((ext_vector_type(8))) short;
using f32x4 = __attribute__((ext_vector_type(4))) float;
using u4 = __attribute__((ext_vector_type(4))) unsigned;
using u2 = __attribute__((ext_vector_type(2))) unsigned;
#define DEVI __device__ __forceinline__

constexpr int NT = 512;
constexpr int SEQ = 8192;
constexpr size_t SECE = (size_t)16384 * 512;
constexpr int SMEM_BYTES = 156 * 1024;
constexpr int NPHASE = 22;

struct P {
  const float *x, *c;
  const int* pos;
  const float *norm1_g, *norm2_g, *ada_w, *ada_b, *w_in, *dn_conv_w, *dn_a_log, *dn_dt_bias, *dn_norm_g, *pool_w,
      *pool_scale, *sg_ln_g, *sg_ln_b, *sg_w, *sg_b, *ret_gn_g, *w_br0, *w_br1, *w_br2, *w_br3, *w_out, *mlp_w1, *mlp_w2, *final_g;
  float* out;
  u16 *WinT, *WbrT, *WoutT, *W1T, *W2T, *PoolWT, *h, *sec, *TQ, *YB, *halo;
  float *modp, *beta, *glog, *gcum, *ropecs;
  int phase_lo, phase_hi;
};

DEVI int tid_l() { int t = threadIdx.x; asm volatile("" : "+v"(t)); return t; }
template <class T> DEVI void lnd(T*& q) { asm volatile("" : "+s"(q)); }
DEVI u16 f2bf(float f) {
  unsigned u = __float_as_uint(f);
  u += 0x7fffu + ((u >> 16) & 1u);
  return (u16)(u >> 16);
}
DEVI float bf2f(u16 h) { return __uint_as_float(((unsigned)h) << 16); }
DEVI unsigned pack2(float a, float b) { return (unsigned)f2bf(a) | ((unsigned)f2bf(b) << 16); }
DEVI float lo2f(unsigned u) { return __uint_as_float(u << 16); }
DEVI float hi2f(unsigned u) { return __uint_as_float(u & 0xffff0000u); }
DEVI void unpack8(u4 v, float* f) {
  f[0] = lo2f(v.x); f[1] = hi2f(v.x); f[2] = lo2f(v.y); f[3] = hi2f(v.y);
  f[4] = lo2f(v.z); f[5] = hi2f(v.z); f[6] = lo2f(v.w); f[7] = hi2f(v.w);
}
DEVI u4 pack8(const float* f) {
  u4 v; v.x = pack2(f[0], f[1]); v.y = pack2(f[2], f[3]); v.z = pack2(f[4], f[5]); v.w = pack2(f[6], f[7]);
  return v;
}
DEVI float wave_sum(float v) {
#pragma unroll
  for (int o = 32; o > 0; o >>= 1) v += __shfl_xor(v, o);
  return v;
}
DEVI float siluf(float x) { return x / (1.f + __expf(-x)); }
DEVI float sigmf(float x) { return 1.f / (1.f + __expf(-x)); }
DEVI float geluf(float x) { return 0.5f * x * (1.f + erff(x * 0.70710678118654752f)); }
DEVI f32x4 mfma16(bf16x8 a, bf16x8 b, f32x4 c) { return __builtin_amdgcn_mfma_f32_16x16x32_bf16(a, b, c, 0, 0, 0); }
DEVI bf16x8 frag(const u16* base, int ld, int r0, int k0, int lane) {
  return *(const bf16x8*)(base + (r0 + (lane & 15)) * ld + k0 + 8 * (lane >> 4));
}
DEVI u2 pack4v(f32x4 v) { u2 r; r.x = pack2(v[0], v[1]); r.y = pack2(v[2], v[3]); return r; }

DEVI float modval(const P& p, int l, int b, int j) { return p.modp[(size_t)(l * 2 + b) * 6144 + j]; }

DEVI void gemm_kloop(const u16* __restrict__ A, int lda, const u16* __restrict__ Bt, int ldb, int K,
                     f32x4 (&acc)[4][4], u16* sm) {
  const int t = tid_l(), lane = t & 63, wid = t >> 6, wr = wid >> 1, wc = wid & 1;
  u16* As = sm;
  u16* Bs = sm + 2 * 256 * 64;
  const int lrow = t >> 3, lch = t & 7;
  const u16* ag = A + (size_t)lrow * lda + lch * 8;
  const u16* bg = Bt + (size_t)lrow * ldb + lch * 8;
  const int soff = lrow * 64 + ((lch ^ (lrow & 7)) * 8);
  u4 ra[4], rb[2];
#pragma unroll
  for (int i = 0; i < 4; ++i) ra[i] = *(const u4*)(ag + (size_t)i * 64 * lda);
#pragma unroll
  for (int i = 0; i < 2; ++i) rb[i] = *(const u4*)(bg + (size_t)i * 64 * ldb);
  __syncthreads();
#pragma unroll
  for (int i = 0; i < 4; ++i) *(u4*)(As + i * 64 * 64 + soff) = ra[i];
#pragma unroll
  for (int i = 0; i < 2; ++i) *(u4*)(Bs + i * 64 * 64 + soff) = rb[i];
  __syncthreads();
  const int nt = K >> 6;
  const int arow = (wr * 64 + (lane & 15)) * 64, brow = (wc * 64 + (lane & 15)) * 64;
  for (int kt = 0; kt < nt; ++kt) {
    const int cur = kt & 1;
    if (kt + 1 < nt) {
      const int ko = (kt + 1) * 64;
#pragma unroll
      for (int i = 0; i < 4; ++i) ra[i] = *(const u4*)(ag + (size_t)i * 64 * lda + ko);
#pragma unroll
      for (int i = 0; i < 2; ++i) rb[i] = *(const u4*)(bg + (size_t)i * 64 * ldb + ko);
    }
    const u16* Ac = As + cur * 256 * 64 + arow;
    const u16* Bc = Bs + cur * 128 * 64 + brow;
#pragma unroll
    for (int kk = 0; kk < 2; ++kk) {
      const int ch = (((kk * 4 + (lane >> 4)) ^ (lane & 7)) * 8);
      bf16x8 af[4], bfr[4];
#pragma unroll
      for (int mi = 0; mi < 4; ++mi) af[mi] = *(const bf16x8*)(Ac + mi * 16 * 64 + ch);
#pragma unroll
      for (int ni = 0; ni < 4; ++ni) bfr[ni] = *(const bf16x8*)(Bc + ni * 16 * 64 + ch);
#pragma unroll
      for (int mi = 0; mi < 4; ++mi)
#pragma unroll
        for (int ni = 0; ni < 4; ++ni) acc[mi][ni] = mfma16(af[mi], bfr[ni], acc[mi][ni]);
    }
    if (kt + 1 < nt) {
      const int nb = cur ^ 1;
#pragma unroll
      for (int i = 0; i < 4; ++i) *(u4*)(As + nb * 256 * 64 + i * 64 * 64 + soff) = ra[i];
#pragma unroll
      for (int i = 0; i < 2; ++i) *(u4*)(Bs + nb * 128 * 64 + i * 64 * 64 + soff) = rb[i];
    }
    __syncthreads();
  }
}
DEVI void zero_acc(f32x4 (&acc)[4][4]) {
#pragma unroll
  for (int i = 0; i < 4; ++i)
#pragma unroll
    for (int j = 0; j < 4; ++j) acc[i][j] = f32x4{0.f, 0.f, 0.f, 0.f};
}
template <class F>
DEVI void epi_foreach(f32x4 (&acc)[4][4], int row0, int col0, F f) {
  const int t = tid_l(), lane = t & 63, wid = t >> 6, wr = wid >> 1, wc = wid & 1;
#pragma unroll
  for (int mi = 0; mi < 4; ++mi)
#pragma unroll
    for (int ni = 0; ni < 4; ++ni)
#pragma unroll
      for (int r = 0; r < 4; ++r)
        f(row0 + wr * 64 + mi * 16 + (lane >> 4) * 4 + r, col0 + wc * 64 + ni * 16 + (lane & 15), acc[mi][ni][r]);
}

DEVI void mod_unit(const P& p, int u, unsigned char* smem) {
  const int t = tid_l();
  const int l = u / 48, jb = u % 48;
  float* cond = (float*)smem;
  float* red = cond + 2048;
  for (int i = t; i < 2048; i += NT) cond[i] = siluf(p.c[i]);
  __syncthreads();
  const int kq = t >> 7, jj = t & 127;
  const float* w = p.ada_w + ((size_t)l * 1024 + kq * 256) * 6144 + jb * 128 + jj;
  float a0 = 0.f, a1 = 0.f;
#pragma unroll 16
  for (int k = 0; k < 256; ++k) {
    const float wv = w[(size_t)k * 6144];
    a0 += cond[kq * 256 + k] * wv;
    a1 += cond[1024 + kq * 256 + k] * wv;
  }
  red[(kq * 2 + 0) * 128 + jj] = a0;
  red[(kq * 2 + 1) * 128 + jj] = a1;
  __syncthreads();
  if (t < 256) {
    const int bb = t >> 7;
    const int j = jb * 128 + jj;
    float sacc = p.ada_b[l * 6144 + j];
#pragma unroll
    for (int q = 0; q < 4; ++q) sacc += red[(q * 2 + bb) * 128 + jj];
    p.modp[(size_t)(l * 2 + bb) * 6144 + j] = sacc;
  }
  __syncthreads();
}
DEVI void rope_unit(const P& p, int u) {
  const int idx = u * 512 + tid_l();
  const int tok = idx >> 6, j = idx & 63;
  const float inv = exp2f(-(float)j * (13.287712379549449f / 64.f));
  const float ang = (float)p.pos[tok] * inv;
  double rev = (double)ang * 0.15915494309189535;
  rev -= rint(rev);
  const float r = (float)(rev * 6.283185307179586);
  p.ropecs[(size_t)idx * 2] = __cosf(r);
  p.ropecs[(size_t)idx * 2 + 1] = __sinf(r);
}
DEVI void conv_tile(const float* __restrict__ src, int ld, int K, int kt, int nt, int col0, u16* __restrict__ dst,
                    unsigned char* smem) {
  float* ls = (float*)smem;
  const int t = tid_l();
#pragma unroll
  for (int ps = 0; ps < 2; ++ps) {
    const int kk = ps * 32 + (t >> 4), n4 = (t & 15) * 4;
    const float4 v = *(const float4*)(src + (size_t)(kt * 64 + kk) * ld + col0 + n4);
    ls[kk * 65 + n4] = v.x; ls[kk * 65 + n4 + 1] = v.y; ls[kk * 65 + n4 + 2] = v.z; ls[kk * 65 + n4 + 3] = v.w;
  }
  __syncthreads();
  const int n = t >> 3, kc = (t & 7) * 8;
  float f[8];
#pragma unroll
  for (int j = 0; j < 8; ++j) f[j] = ls[(kc + j) * 65 + n];
  *(u4*)(dst + (size_t)(nt * 64 + n) * K + kt * 64 + kc) = pack8(f);
  __syncthreads();
}
constexpr int NWCONV = 2432 + 512 + 256 + 1024 + 1024 + 16;
DEVI void wconv_unit(const P& p, int l, int w, unsigned char* smem) {
  if (w < 2432) {
    const int kt = w & 15, nt = w >> 4;
    conv_tile(p.w_in + (size_t)l * 1024 * 9736, 9736, 1024, kt, nt, nt * 64 + (nt * 64 >= 2048 ? 8 : 0), p.WinT, smem);
    return;
  }
  w -= 2432;
  if (w < 512) {
    const int b = w >> 7, r = w & 127, kt = r & 7, nt = r >> 3;
    const float* b0 = p.w_br0; const float* b1 = p.w_br1; const float* b2 = p.w_br2; const float* b3 = p.w_br3;
    asm volatile("" : "+s"(b0)); asm volatile("" : "+s"(b1)); asm volatile("" : "+s"(b2)); asm volatile("" : "+s"(b3));
    conv_tile((b == 0 ? b0 : b == 1 ? b1 : b == 2 ? b2 : b3) + (size_t)l * 512 * 1024, 1024, 512, kt, nt, nt * 64, p.WbrT + (size_t)b * 1024 * 512, smem);
    return;
  }
  w -= 512;
  if (w < 256) {
    conv_tile(p.w_out + (size_t)l * 1024 * 1024, 1024, 1024, w & 15, w >> 4, (w >> 4) * 64, p.WoutT, smem);
    return;
  }
  w -= 256;
  if (w < 1024) {
    conv_tile(p.mlp_w1 + (size_t)l * 1024 * 4096, 4096, 1024, w & 15, w >> 4, (w >> 4) * 64, p.W1T, smem);
    return;
  }
  w -= 1024;
  if (w < 1024) {
    conv_tile(p.mlp_w2 + (size_t)l * 4096 * 1024, 1024, 4096, w & 63, w >> 6, (w >> 6) * 64, p.W2T, smem);
    return;
  }
  w -= 1024;
  {
    const int g = w >> 2, r = w & 3;
    conv_tile(p.pool_w + (size_t)(l * 4 + g) * 16384, 128, 128, r & 1, r >> 1, (r >> 1) * 64, p.PoolWT + (size_t)g * 16384, smem);
  }
}

DEVI void norm_phase(const P& p, int l, int which, unsigned char* smem) {
  const int t = tid_l(), lane = t & 63, wid = t >> 6;
  float* ssh = (float*)smem;
  float* ssc = ssh + 2048;
  float* w8 = ssc + 2048;
  const float* gsrc = (which == 0 ? p.norm1_g : p.norm2_g) + l * 1024;
  const int ish = which == 0 ? 0 : 3;
#pragma unroll 1
  for (int i = t; i < 2048; i += NT) {
    const int b = i >> 10, c = i & 1023;
    ssh[i] = modval(p, l, b, ish * 1024 + c);
    ssc[i] = gsrc[c] * (1.f + modval(p, l, b, (ish + 1) * 1024 + c));
  }
  if (which == 0) {
#pragma unroll 1
    for (int i = t; i < 2048; i += NT) {
      const int k = i >> 1, hf = i & 1;
      *(float4*)(w8 + k * 8 + hf * 4) = *(const float4*)(p.w_in + ((size_t)l * 1024 + k) * 9736 + 2048 + hf * 4);
    }
  }
  __syncthreads();
  const float* xs = (l == 0 && which == 0) ? p.x : p.out;
#pragma unroll 1
  for (int u = blockIdx.x; u < 2048; u += gridDim.x) {
    const int row = u * 8 + wid, b = row >> 13;
    const float* xr = xs + (size_t)row * 1024;
    float4 xv[4];
    float ss = 0.f;
#pragma unroll
    for (int i = 0; i < 4; ++i) {
      xv[i] = *(const float4*)(xr + i * 256 + lane * 4);
      ss += xv[i].x * xv[i].x + xv[i].y * xv[i].y + xv[i].z * xv[i].z + xv[i].w * xv[i].w;
    }
    ss = wave_sum(ss);
    const float rstd = rsqrtf(ss * (1.f / 1024.f) + 1e-6f);
    float a8[8];
#pragma unroll
    for (int j = 0; j < 8; ++j) a8[j] = 0.f;
#pragma unroll
    for (int i = 0; i < 4; ++i) {
      const int c = i * 256 + lane * 4;
      const float4 sc = *(const float4*)(ssc + b * 1024 + c);
      const float4 sh = *(const float4*)(ssh + b * 1024 + c);
      float hv[4];
      hv[0] = xv[i].x * rstd * sc.x + sh.x;
      hv[1] = xv[i].y * rstd * sc.y + sh.y;
      hv[2] = xv[i].z * rstd * sc.z + sh.z;
      hv[3] = xv[i].w * rstd * sc.w + sh.w;
      u2 o; o.x = pack2(hv[0], hv[1]); o.y = pack2(hv[2], hv[3]);
      *(u2*)(p.h + (size_t)row * 1024 + c) = o;
      if (which == 0) {
#pragma unroll
        for (int e = 0; e < 4; ++e) {
          const float4 wa = *(const float4*)(w8 + (c + e) * 8);
          const float4 wb = *(const float4*)(w8 + (c + e) * 8 + 4);
          a8[0] += hv[e] * wa.x; a8[1] += hv[e] * wa.y; a8[2] += hv[e] * wa.z; a8[3] += hv[e] * wa.w;
          a8[4] += hv[e] * wb.x; a8[5] += hv[e] * wb.y; a8[6] += hv[e] * wb.z; a8[7] += hv[e] * wb.w;
        }
      }
    }
    if (which == 0) {
#pragma unroll
      for (int j = 0; j < 8; ++j) a8[j] = wave_sum(a8[j]);
      float mine = 0.f;
#pragma unroll
      for (int j = 0; j < 8; ++j) mine = (lane == j) ? a8[j] : mine;
      if (lane < 4) {
        p.beta[(size_t)row * 4 + lane] = sigmf(mine);
      } else if (lane < 8) {
        const int hh = lane - 4;
        const float xx = mine + p.dn_dt_bias[l * 4 + hh];
        const float sp = xx > 20.f ? xx : log1pf(expf(xx));
        p.glog[(size_t)row * 4 + hh] = -expf(p.dn_a_log[l * 4 + hh]) * sp;
      }
    }
  }
}

DEVI int gate_sec(int gs) { return gs < 3 ? gs : (gs == 3 ? 4 : (gs == 4 ? 6 : gs + 2)); }


namespace pg8 {
#define PG8_LAS __attribute__((address_space(3)))
constexpr int BM = 256, BK = 64, HALF = 128, HTB = HALF * BK * 2, STAGE_BYTES = 8 * HTB, NXCD = 8, WGM = 8;
DEVI int lds_byte(int r, int c) { const int st = (r >> 4) * 2 + (c >> 5), rr = r & 15, cc = c & 31, ob = rr * 64 + cc * 2; return st * 1024 + (ob ^ (((ob >> 9) & 1) << 5)); }
DEVI void stage_rc(int b, int& R, int& C) { const int st = b / 1024, sb = b % 1024, swz = sb ^ (((sb >> 9) & 1) << 5); R = (st >> 1) * 16 + swz / 64; C = (st & 1) * 32 + (swz % 64) / 2; }
DEVI int perm32(int rho) { const int n = rho >> 4, i = rho & 15; return 8 * (i >> 2) + 4 * n + (i & 3); }
struct Unit { int pm, pn; };
struct Gemm { const u16* A; const u16* Bt; int M, N, K; };
struct StaticOrder {
  int nM, nN, nwg, G, c;
  DEVI void init(int M, int N, int G_, int c_) { nM = M / BM; nN = N / BM; nwg = nM * nN; G = G_; c = c_; }
  DEVI bool next(int i, Unit& u) const {
    const long L = (long)i * G + c; if (L >= nwg) return false;
    int wgid = (int)L; { const int q = nwg / NXCD, r = nwg % NXCD, xcd = wgid % NXCD, off = wgid / NXCD; wgid = (xcd < r ? xcd * (q + 1) : r * (q + 1) + (xcd - r) * q) + off; }
    const int nig = WGM * nN, gid = wgid / nig, fm = gid * WGM, gsz = (nM - fm) < WGM ? (nM - fm) : WGM;
    u.pm = fm + ((wgid % nig) % gsz); u.pn = (wgid % nig) / gsz; return true;
  }
};
DEVI unsigned cvt_pk_bf16(float lo, float hi) { unsigned r; asm volatile("v_cvt_pk_bf16_f32 %0, %1, %2" : "=v"(r) : "v"(lo), "v"(hi)); return r; }

template <class Epi>
DEVI void gemm_phase(PG8_LAS unsigned char* lds, const Gemm g, const StaticOrder& S, const Epi& E) {
  const int tid = tid_l(), wid = __builtin_amdgcn_readfirstlane(tid >> 6), lane = tid & 63, wr = wid >> 2, wc = wid & 3, fr = lane & 15, fq = lane >> 4;
  const int K = g.K, nt = K / BK;
  unsigned voffA[2], voffB[2];
#pragma unroll
  for (int i = 0; i < 2; ++i) { int R, C; stage_rc(tid * 16 + i * 8192, R, C); const int Rb = Epi::PERM ? ((R & ~31) + perm32(R & 31)) : R;
    voffA[i] = (unsigned)(R * K + C) * 2u; voffB[i] = (unsigned)(Rb * K + C) * 2u; }
  const size_t kstep = (size_t)(BK * 2);
  const size_t hstep = (size_t)HALF * K * 2;
  const size_t tstep = 2 * hstep;
  const unsigned ldsw = (unsigned)wid * 1024u;
  const int aoff = lds_byte(wr * 64 + fr, fq * 8), boff = lds_byte(wc * 32 + fr, fq * 8);
#define PG8_SA(b, h) (((b) * 2 + (h)) * HTB)
#define PG8_SB(b, h) ((4 + (b) * 2 + (h)) * HTB)
#define PG8_STAGE(bufoff, gbase, voff) do { _Pragma("unroll") for (int _i = 0; _i < 2; ++_i) \
    __builtin_amdgcn_global_load_lds((const unsigned*)((const char*)(gbase) + (voff)[_i]), (PG8_LAS unsigned*)(lds + (bufoff) + ldsw + _i * 8192), 16, 0, 0); } while (0)
#define PG8_LDA(dst, b, h) do { _Pragma("unroll") for (int m = 0; m < 4; ++m) _Pragma("unroll") for (int k = 0; k < 2; ++k) dst[m][k] = *(const PG8_LAS bf16x8*)(lds + PG8_SA(b, h) + aoff + m * 2048 + k * 1024); } while (0)
#define PG8_LDB(dst, b, h) do { _Pragma("unroll") for (int n = 0; n < 2; ++n) _Pragma("unroll") for (int k = 0; k < 2; ++k) dst[n][k] = *(const PG8_LAS bf16x8*)(lds + PG8_SB(b, h) + boff + n * 2048 + k * 1024); } while (0)
#define PG8_MMA(ai, bj, At, Bt) do { __builtin_amdgcn_s_setprio(1); _Pragma("unroll") for (int m = 0; m < 4; ++m) _Pragma("unroll") for (int n = 0; n < 2; ++n) _Pragma("unroll") for (int k = 0; k < 2; ++k) \
    acc[ai][bj][m][n] = __builtin_amdgcn_mfma_f32_16x16x32_bf16(Bt[n][k], At[m][k], acc[ai][bj][m][n], 0, 0, 0); __builtin_amdgcn_s_setprio(0); } while (0)
#define PG8_WAIT_V(n) asm volatile("s_waitcnt vmcnt(" #n ")" ::: "memory")
#define PG8_WAIT_L(n) asm volatile("s_waitcnt lgkmcnt(" #n ")" ::: "memory")
#define PG8_BAR __builtin_amdgcn_s_barrier()
#define PG8_SCHED __builtin_amdgcn_sched_barrier(0)
  Unit cur, nxt; int ui = 0;
  if (!S.next(0, cur)) return;
  f32x4 acc[2][2][4][2];
#pragma unroll
  for (int a = 0; a < 2; ++a)
#pragma unroll
    for (int b = 0; b < 2; ++b)
#pragma unroll
      for (int m = 0; m < 4; ++m)
#pragma unroll
        for (int n = 0; n < 2; ++n) acc[a][b][m][n] = (f32x4){0.f, 0.f, 0.f, 0.f};
  bf16x8 At[4][2], B0[2][2], B1[2][2];
  const char* cA = (const char*)g.A + (size_t)cur.pm * tstep; const char* cB = (const char*)g.Bt + (size_t)cur.pn * tstep;
  PG8_STAGE(PG8_SB(0, 0), cB, voffB); PG8_STAGE(PG8_SA(0, 0), cA, voffA); PG8_STAGE(PG8_SB(0, 1), cB + hstep, voffB); PG8_STAGE(PG8_SA(0, 1), cA + hstep, voffA);
  if (wr == 1) PG8_BAR;
  PG8_WAIT_V(4); PG8_BAR;
  PG8_STAGE(PG8_SB(1, 0), cB + kstep, voffB); PG8_STAGE(PG8_SA(1, 0), cA + kstep, voffA); PG8_STAGE(PG8_SB(1, 1), cB + hstep + kstep, voffB);
  PG8_WAIT_V(6); PG8_BAR;
  for (;;) {
    const bool has_next = S.next(ui + 1, nxt);
    const char* nA = has_next ? (const char*)g.A + (size_t)nxt.pm * tstep : cA; const char* nB = has_next ? (const char*)g.Bt + (size_t)nxt.pn * tstep : cB;
    for (int t = 0; t < nt; t += 2) {
      const bool last = (t == nt - 2);
      const char* a1 = cA + (size_t)(t + 1) * kstep;
      const char* a2 = last ? nA : cA + (size_t)(t + 2) * kstep; const char* b2 = last ? nB : cB + (size_t)(t + 2) * kstep;
      const char* a3 = a2 + kstep; const char* b3 = b2 + kstep;
      PG8_LDB(B0, 0, 0); PG8_SCHED; PG8_LDA(At, 0, 0); PG8_STAGE(PG8_SA(1, 1), a1 + hstep, voffA);
      PG8_WAIT_L(8); PG8_BAR; PG8_WAIT_L(0); PG8_MMA(0, 0, At, B0); PG8_BAR; PG8_SCHED;
      PG8_LDB(B1, 0, 1); PG8_STAGE(PG8_SB(0, 0), b2, voffB);
      PG8_BAR; PG8_WAIT_L(0); PG8_MMA(0, 1, At, B1); PG8_BAR;
      PG8_LDA(At, 0, 1); PG8_STAGE(PG8_SA(0, 0), a2, voffA);
      PG8_BAR; PG8_WAIT_L(0); PG8_MMA(1, 0, At, B0); PG8_BAR; PG8_SCHED;
      PG8_STAGE(PG8_SB(0, 1), b2 + hstep, voffB);
      PG8_WAIT_V(6); PG8_BAR; PG8_MMA(1, 1, At, B1); PG8_BAR;
      PG8_LDB(B0, 1, 0); PG8_SCHED; PG8_LDA(At, 1, 0); PG8_STAGE(PG8_SA(0, 1), a2 + hstep, voffA);
      PG8_WAIT_L(8); PG8_BAR; PG8_WAIT_L(0); PG8_MMA(0, 0, At, B0); PG8_BAR; PG8_SCHED;
      PG8_LDB(B1, 1, 1); PG8_STAGE(PG8_SB(1, 0), b3, voffB);
      PG8_BAR; PG8_WAIT_L(0); PG8_MMA(0, 1, At, B1); PG8_BAR;
      PG8_LDA(At, 1, 1); PG8_STAGE(PG8_SA(1, 0), a3, voffA);
      PG8_BAR; PG8_WAIT_L(0); PG8_MMA(1, 0, At, B0); PG8_BAR; PG8_SCHED;
      PG8_STAGE(PG8_SB(1, 1), b3 + hstep, voffB);
      PG8_WAIT_V(6); PG8_BAR; PG8_MMA(1, 1, At, B1); PG8_BAR;
    }
    E(acc, cur, wr, wc, fr, fq);
    if (!has_next) break;
#pragma unroll
    for (int a = 0; a < 2; ++a)
#pragma unroll
      for (int b = 0; b < 2; ++b)
#pragma unroll
        for (int m = 0; m < 4; ++m)
#pragma unroll
          for (int n = 0; n < 2; ++n) acc[a][b][m][n] = (f32x4){0.f, 0.f, 0.f, 0.f};
    cur = nxt; cA = nA; cB = nB; ++ui;
  }
  PG8_WAIT_V(0);
  if (wr == 0) PG8_BAR;
  PG8_BAR;
#undef PG8_SA
#undef PG8_SB
#undef PG8_STAGE
#undef PG8_LDA
#undef PG8_LDB
#undef PG8_MMA
#undef PG8_WAIT_V
#undef PG8_WAIT_L
#undef PG8_BAR
#undef PG8_SCHED
}

DEVI u4 pack8acc(f32x4 v0, f32x4 v1) { u4 o; o.x = cvt_pk_bf16(v0[0], v0[1]); o.y = cvt_pk_bf16(v0[2], v0[3]); o.z = cvt_pk_bf16(v1[0], v1[1]); o.w = cvt_pk_bf16(v1[2], v1[3]); return o; }
struct EpiProj {
  static constexpr bool PERM = true;
  u16* sec; u16* halo;
  DEVI void operator()(const f32x4 (&acc)[2][2][4][2], const Unit& u, int wr, int wc, int fr, int fq) const {
    const int s = u.pn >> 1, cb = (u.pn & 1) * 256 + wc * 32 + 8 * fq;
    u16* dst = sec + (size_t)s * SECE;
#pragma unroll
    for (int ai = 0; ai < 2; ++ai)
#pragma unroll
      for (int m = 0; m < 4; ++m) {
        const int row = u.pm * 256 + ai * 128 + wr * 64 + m * 16 + fr;
        const bool hl = (s < 3) && ((row & 63) >= 61);
#pragma unroll
        for (int bj = 0; bj < 2; ++bj) {
          const u4 o = pack8acc(acc[ai][bj][m][0], acc[ai][bj][m][1]);
          *(u4*)(dst + (size_t)row * 512 + cb + bj * 128) = o;
          if (hl) *(u4*)(halo + ((size_t)(row >> 6) * 3 + ((row & 63) - 61)) * 1536 + s * 512 + cb + bj * 128) = o;
        }
      }
  }
};
struct EpiGates {
  static constexpr bool PERM = true;
  u16* sec;
  DEVI void operator()(const f32x4 (&acc)[2][2][4][2], const Unit& u, int wr, int wc, int fr, int fq) const {
    const int cb = (u.pn & 1) * 256 + wc * 32 + 8 * fq;
    u16* dst = sec + (size_t)gate_sec(u.pn >> 1) * SECE;
#pragma unroll
    for (int ai = 0; ai < 2; ++ai)
#pragma unroll
      for (int m = 0; m < 4; ++m) {
        const int row = u.pm * 256 + ai * 128 + wr * 64 + m * 16 + fr;
#pragma unroll
        for (int bj = 0; bj < 2; ++bj) {
          f32x4 v0 = acc[ai][bj][m][0], v1 = acc[ai][bj][m][1];
#pragma unroll
          for (int e = 0; e < 4; ++e) { v0[e] = sigmf(v0[e]); v1[e] = sigmf(v1[e]); }
          *(u4*)(dst + (size_t)row * 512 + cb + bj * 128) = pack8acc(v0, v1);
        }
      }
  }
};
struct EpiMlp1 {
  static constexpr bool PERM = true;
  u16* hid;
  DEVI void operator()(const f32x4 (&acc)[2][2][4][2], const Unit& u, int wr, int wc, int fr, int fq) const {
    const int cb = u.pn * 256 + wc * 32 + 8 * fq;
#pragma unroll
    for (int ai = 0; ai < 2; ++ai)
#pragma unroll
      for (int m = 0; m < 4; ++m) {
        const int row = u.pm * 256 + ai * 128 + wr * 64 + m * 16 + fr;
#pragma unroll
        for (int bj = 0; bj < 2; ++bj) {
          f32x4 v0 = acc[ai][bj][m][0], v1 = acc[ai][bj][m][1];
#pragma unroll
          for (int e = 0; e < 4; ++e) { const float a = fmaxf(v0[e], 0.f), b = fmaxf(v1[e], 0.f); v0[e] = a * a; v1[e] = b * b; }
          *(u4*)(hid + (size_t)row * 4096 + cb + bj * 128) = pack8acc(v0, v1);
        }
      }
  }
};
struct EpiResid {
  static constexpr bool PERM = false;
  const float* xin; float* out; const float* gate;
  DEVI void operator()(const f32x4 (&acc)[2][2][4][2], const Unit& u, int wr, int wc, int fr, int fq) const {
    const int b = (u.pm * 256) >> 13;
    const int cb = u.pn * 256 + wc * 32 + 4 * fq;
    f32x4 gv[2][2];
#pragma unroll
    for (int bj = 0; bj < 2; ++bj)
#pragma unroll
      for (int n = 0; n < 2; ++n) gv[bj][n] = *(const f32x4*)(gate + (size_t)b * 6144 + cb + bj * 128 + n * 16);
#pragma unroll
    for (int ai = 0; ai < 2; ++ai)
#pragma unroll
      for (int m = 0; m < 4; ++m) {
        const size_t ro = (size_t)(u.pm * 256 + ai * 128 + wr * 64 + m * 16 + fr) * 1024 + cb;
#pragma unroll
        for (int bj = 0; bj < 2; ++bj)
#pragma unroll
          for (int n = 0; n < 2; ++n) {
            const f32x4 xv = *(const f32x4*)(xin + ro + bj * 128 + n * 16);
            *(f32x4*)(out + ro + bj * 128 + n * 16) = xv + gv[bj][n] * acc[ai][bj][m][n];
          }
      }
  }
};
}

DEVI void proj_phase(const P& p, unsigned char* smem) {
  pg8::StaticOrder S; S.init(16384, 5632, gridDim.x, blockIdx.x);
  const pg8::Gemm g{p.h, p.WinT, 16384, 5632, 1024};
  const pg8::EpiProj E{p.sec, p.halo};
  pg8::gemm_phase((PG8_LAS unsigned char*)smem, g, S, E);
}
DEVI void gates_phase(const P& p, unsigned char* smem) {
  pg8::StaticOrder S; S.init(16384, 4096, gridDim.x, blockIdx.x);
  const pg8::Gemm g{p.h, p.WinT + (size_t)5632 * 1024, 16384, 4096, 1024};
  const pg8::EpiGates E{p.sec};
  pg8::gemm_phase((PG8_LAS unsigned char*)smem, g, S, E);
}
DEVI void merge_phase(const P& p, unsigned char* smem) {
  for (int tl = blockIdx.x; tl < 64 * 8; tl += gridDim.x) {
    const int tm = tl >> 3, tn = tl & 7;
    f32x4 macc[4][4];
    zero_acc(macc);
#pragma unroll 1
    for (int b = 0; b < 4; ++b) {
      const u16* ysec = (b == 0) ? p.sec + 3 * SECE : (b == 1) ? p.YB : (b == 2) ? p.sec + 5 * SECE : p.sec + 10 * SECE;
      f32x4 acc[4][4];
      zero_acc(acc);
      gemm_kloop(ysec + (size_t)tm * 256 * 512, 512, p.WbrT + ((size_t)b * 1024 + tn * 128) * 512, 512, 512, acc, (u16*)smem);
      const u16* gsec = p.sec + (size_t)gate_sec(b * 2 + (tn >> 2)) * SECE;
      const int cb = (tn & 3) * 128;
      const int t = tid_l(), lane = t & 63, wid = t >> 6, wr = wid >> 1, wc = wid & 1;
#pragma unroll
      for (int mi = 0; mi < 4; ++mi)
#pragma unroll
        for (int ni = 0; ni < 4; ++ni)
#pragma unroll
          for (int r = 0; r < 4; ++r) {
            const int row = tm * 256 + wr * 64 + mi * 16 + (lane >> 4) * 4 + r;
            const int col = cb + wc * 64 + ni * 16 + (lane & 15);
            macc[mi][ni][r] += bf2f(gsec[(size_t)row * 512 + col]) * acc[mi][ni][r];
          }
    }
    u16* dst = p.h;
    epi_foreach(macc, tm * 256, tn * 128, [&](int row, int col, float v) __attribute__((always_inline)) { dst[(size_t)row * 1024 + col] = f2bf(v); });
  }
}
DEVI void resid_gemm_phase(const P& p, int l, int which, unsigned char* smem) {
  pg8::StaticOrder S; S.init(16384, 1024, gridDim.x, blockIdx.x);
  const pg8::Gemm g{which == 0 ? p.h : p.sec, which == 0 ? p.WoutT : p.W2T, 16384, 1024, which == 0 ? 1024 : 4096};
  const pg8::EpiResid E{(which == 0 && l == 0) ? p.x : p.out, p.out, p.modp + (size_t)l * 2 * 6144 + (which == 0 ? 2 : 5) * 1024};
  pg8::gemm_phase((PG8_LAS unsigned char*)smem, g, S, E);
}
DEVI void mlp1_phase(const P& p, unsigned char* smem) {
  pg8::StaticOrder S; S.init(16384, 4096, gridDim.x, blockIdx.x);
  const pg8::Gemm g{p.h, p.W1T, 16384, 4096, 1024};
  const pg8::EpiMlp1 E{p.sec};
  pg8::gemm_phase((PG8_LAS unsigned char*)smem, g, S, E);
}

DEVI void dn_prep_unit(const P& p, int l, int u, unsigned char* smem) {
  const int t = tid_l(), lane = t & 63, wid = t >> 6;
  const int h = u & 3, n = (u >> 2) & 127, b = u >> 9;
  const int r0 = b * SEQ + n * 64;
  u16* Qs = (u16*)smem;
  u16* Ks = Qs + 64 * 136;
  float* Lm = (float*)(Ks + 64 * 136);
  float* cw = Lm + 64 * 64;
  float* gcs = cw + 1536;
  float* bs = gcs + 64;
  for (int i = t; i < 1536; i += NT) {
    const int s = i >> 9, j = (i >> 7) & 3, c = i & 127;
    cw[i] = p.dn_conv_w[(size_t)(l * 4 + j) * 1536 + s * 512 + h * 128 + c];
  }
  if (wid == 0) {
    float g = p.glog[(size_t)(r0 + lane) * 4 + h];
#pragma unroll
    for (int o = 1; o < 64; o <<= 1) {
      const float v = __shfl_up(g, o);
      if (lane >= o) g += v;
    }
    gcs[lane] = g;
    p.gcum[(size_t)(r0 + lane) * 4 + h] = g;
    bs[lane] = p.beta[(size_t)(r0 + lane) * 4 + h];
  }
  __syncthreads();
  const int row = t >> 3, c0 = (t & 7) * 16;
#pragma unroll
  for (int s = 0; s < 3; ++s) {
    u16* sp = p.sec + (size_t)s * SECE;
    float y[16];
#pragma unroll
    for (int c = 0; c < 16; ++c) y[c] = 0.f;
#pragma unroll
    for (int j = 0; j < 4; ++j) {
      const int tt = row - 3 + j;
      u4 v0 = {0, 0, 0, 0}, v1 = {0, 0, 0, 0};
      if (tt >= 0) {
        const u16* src = sp + (size_t)(r0 + tt) * 512 + h * 128 + c0;
        v0 = *(const u4*)src; v1 = *(const u4*)(src + 8);
      } else if (n > 0) {
        const u16* src = p.halo + ((size_t)((r0 >> 6) - 1) * 3 + (tt + 3)) * 1536 + s * 512 + h * 128 + c0;
        v0 = *(const u4*)src; v1 = *(const u4*)(src + 8);
      }
      float f[16];
      unpack8(v0, f); unpack8(v1, f + 8);
#pragma unroll
      for (int c = 0; c < 16; ++c) y[c] += cw[(s * 4 + j) * 128 + c0 + c] * f[c];
    }
    float ss = 0.f;
#pragma unroll
    for (int c = 0; c < 16; ++c) { y[c] = siluf(y[c]); ss += y[c] * y[c]; }
    if (s < 2) {
      ss += __shfl_xor(ss, 1); ss += __shfl_xor(ss, 2); ss += __shfl_xor(ss, 4);
      const float sc = rsqrtf(ss + 1e-6f) * (s == 0 ? 0.08838834764831845f : 1.f);
#pragma unroll
      for (int c = 0; c < 16; ++c) y[c] *= sc;
    }
    const u4 o0 = pack8(y), o1 = pack8(y + 8);
    __syncthreads();
    u16* dstg = sp + (size_t)(r0 + row) * 512 + h * 128 + c0;
    *(u4*)dstg = o0; *(u4*)(dstg + 8) = o1;
    if (s < 2) {
      u16* dl = (s == 0 ? Qs : Ks) + row * 136 + c0;
      *(u4*)dl = o0; *(u4*)(dl + 8) = o1;
    }
  }
  __syncthreads();
  u16* tq = p.TQ + (size_t)u * 8192;
#pragma unroll
  for (int rep = 0; rep < 2; ++rep) {
    const int id = wid + rep * 8, ti = id >> 2, tj = id & 3;
    f32x4 akk = {0.f, 0.f, 0.f, 0.f}, aqk = {0.f, 0.f, 0.f, 0.f};
    if (tj <= ti) {
#pragma unroll
      for (int k0 = 0; k0 < 128; k0 += 32) {
        const bf16x8 bk = frag(Ks, 136, tj * 16, k0, lane);
        akk = mfma16(frag(Ks, 136, ti * 16, k0, lane), bk, akk);
        aqk = mfma16(frag(Qs, 136, ti * 16, k0, lane), bk, aqk);
      }
    }
    const int j = tj * 16 + (lane & 15);
#pragma unroll
    for (int r = 0; r < 4; ++r) {
      const int i = ti * 16 + (lane >> 4) * 4 + r;
      const float dec = (i >= j) ? __expf(gcs[i] - gcs[j]) : 0.f;
      Lm[i * 64 + j] = (i > j) ? bs[i] * akk[r] * dec : 0.f;
      tq[4096 + i * 64 + j] = f2bf(aqk[r] * dec);
    }
  }
  __syncthreads();
  if (wid == 0) {
    float T[64];
#pragma unroll
    for (int i = 0; i < 64; ++i) {
      float s = (i == lane) ? 1.f : 0.f;
#pragma unroll
      for (int j = 0; j < i; ++j) s -= Lm[i * 64 + j] * T[j];
      T[i] = s;
    }
    const float bl = bs[lane];
#pragma unroll
    for (int i = 0; i < 64; ++i) tq[i * 64 + lane] = f2bf(T[i] * bl);
  }
  __syncthreads();
}

DEVI void dn_chain(const P& p, int l, int bh, unsigned char* smem) {
  const int t = tid_l(), lane = t & 63, wid = t >> 6;
  const int h = bh & 3, b = bh >> 2;
  u16* Kh = (u16*)smem;
  u16* Qh = Kh + 64 * 136;
  u16* KT = Qh + 64 * 136;
  u16* TB = KT + 128 * 80;
  u16* QKm = TB + 64 * 80;
  u16* VV = QKm + 64 * 80;
  u16* ST = VV + 128 * 80;
  u16* RT = ST + 128 * 136;
  float* egs = (float*)(RT + 128 * 80);
  float* part = egs + 64;
  const u16* sq = p.sec + h * 128;
  const u16* sk = p.sec + SECE + h * 128;
  const u16* sv = p.sec + 2 * SECE + h * 128;
  u16* sz = p.sec + 3 * SECE + h * 128;
  const int prow = t >> 3, pc0 = (t & 7) * 16;
  const int pt = wid & 3, eh = wid >> 2;
  f32x4 Sacc[8];
#pragma unroll
  for (int j = 0; j < 8; ++j) Sacc[j] = f32x4{0.f, 0.f, 0.f, 0.f};
  for (int i = t; i < 128 * 136 / 8; i += NT) *(u4*)(ST + i * 8) = u4{0, 0, 0, 0};
  u4 rk[2], rq[2], rv[2], rt[2];
  float gr, gG, gme;
  auto prefetch = [&](int n) __attribute__((always_inline)) {
    const size_t r0 = (size_t)b * SEQ + (size_t)n * 64;
    const size_t o = (r0 + prow) * 512 + pc0;
    rk[0] = *(const u4*)(sk + o); rk[1] = *(const u4*)(sk + o + 8);
    rq[0] = *(const u4*)(sq + o); rq[1] = *(const u4*)(sq + o + 8);
    rv[0] = *(const u4*)(sv + o); rv[1] = *(const u4*)(sv + o + 8);
    const u16* tq = p.TQ + (size_t)(((size_t)b * 128 + n) * 4 + h) * 8192;
    rt[0] = *(const u4*)(tq + (size_t)t * 8);
    rt[1] = *(const u4*)(tq + 4096 + (size_t)t * 8);
    gr = p.gcum[(r0 + prow) * 4 + h];
    gG = p.gcum[(r0 + 63) * 4 + h];
    gme = p.gcum[(r0 + (t & 63)) * 4 + h];
  };
  auto stash = [&]() __attribute__((always_inline)) {
    *(u4*)(Kh + prow * 136 + pc0) = rk[0]; *(u4*)(Kh + prow * 136 + pc0 + 8) = rk[1];
    *(u4*)(Qh + prow * 136 + pc0) = rq[0]; *(u4*)(Qh + prow * 136 + pc0 + 8) = rq[1];
    *(u4*)(VV + prow * 136 + pc0) = rv[0]; *(u4*)(VV + prow * 136 + pc0 + 8) = rv[1];
    *(u4*)(TB + (t >> 3) * 80 + (t & 7) * 8) = rt[0];
    *(u4*)(QKm + (t >> 3) * 80 + (t & 7) * 8) = rt[1];
    float f[16];
    unpack8(rk[0], f); unpack8(rk[1], f + 8);
    const float ek = __expf(gG - gr);
#pragma unroll
    for (int c = 0; c < 16; ++c) KT[(pc0 + c) * 80 + prow] = f2bf(f[c] * ek);
    if (t < 64) egs[t] = __expf(gme);
  };
  prefetch(0);
  __syncthreads();
  stash();
  __syncthreads();
  for (int n = 0; n < 128; ++n) {
    const size_t r0 = (size_t)b * SEQ + (size_t)n * 64;
    if (n + 1 < 128) prefetch(n + 1);
    f32x4 accR[4], accO[4];
#pragma unroll
    for (int ni = 0; ni < 4; ++ni) { accR[ni] = f32x4{0.f, 0.f, 0.f, 0.f}; accO[ni] = f32x4{0.f, 0.f, 0.f, 0.f}; }
#pragma unroll
    for (int k0 = 0; k0 < 128; k0 += 32) {
      const bf16x8 ak = frag(Kh, 136, pt * 16, k0, lane), aq = frag(Qh, 136, pt * 16, k0, lane);
#pragma unroll
      for (int ni = 0; ni < 4; ++ni) {
        const bf16x8 bb = frag(ST, 136, (eh * 4 + ni) * 16, k0, lane);
        accR[ni] = mfma16(ak, bb, accR[ni]);
        accO[ni] = mfma16(aq, bb, accO[ni]);
      }
    }
    const int pos0 = pt * 16 + (lane >> 4) * 4;
    float eg4[4];
#pragma unroll
    for (int r = 0; r < 4; ++r) eg4[r] = egs[pos0 + r];
#pragma unroll
    for (int ni = 0; ni < 4; ++ni) {
      const int e = (eh * 4 + ni) * 16 + (lane & 15);
      f32x4 R;
#pragma unroll
      for (int r = 0; r < 4; ++r) {
        R[r] = bf2f(VV[(pos0 + r) * 136 + e]) - eg4[r] * accR[ni][r];
        accO[ni][r] *= eg4[r];
      }
      *(u2*)(RT + e * 80 + pos0) = pack4v(R);
    }
    __syncthreads();
    f32x4 accV[4];
#pragma unroll
    for (int ni = 0; ni < 4; ++ni) accV[ni] = f32x4{0.f, 0.f, 0.f, 0.f};
#pragma unroll
    for (int k0 = 0; k0 < 64; k0 += 32) {
      const bf16x8 a = frag(TB, 80, pt * 16, k0, lane);
#pragma unroll
      for (int ni = 0; ni < 4; ++ni) accV[ni] = mfma16(a, frag(RT, 80, (eh * 4 + ni) * 16, k0, lane), accV[ni]);
    }
#pragma unroll
    for (int ni = 0; ni < 4; ++ni) {
      const int e = (eh * 4 + ni) * 16 + (lane & 15);
      *(u2*)(VV + e * 80 + pos0) = pack4v(accV[ni]);
    }
    __syncthreads();
#pragma unroll
    for (int k0 = 0; k0 < 64; k0 += 32) {
      const bf16x8 a = frag(QKm, 80, pt * 16, k0, lane);
#pragma unroll
      for (int ni = 0; ni < 4; ++ni) accO[ni] = mfma16(a, frag(VV, 80, (eh * 4 + ni) * 16, k0, lane), accO[ni]);
    }
    const float eG = egs[63];
#pragma unroll
    for (int j = 0; j < 8; ++j) Sacc[j] *= eG;
#pragma unroll
    for (int k0 = 0; k0 < 64; k0 += 32) {
      const bf16x8 a = frag(KT, 80, wid * 16, k0, lane);
#pragma unroll
      for (int j = 0; j < 8; ++j) Sacc[j] = mfma16(a, frag(VV, 80, j * 16, k0, lane), Sacc[j]);
    }
    {
      float s4[4];
#pragma unroll
      for (int r = 0; r < 4; ++r) {
        float s = 0.f;
#pragma unroll
        for (int ni = 0; ni < 4; ++ni) s += accO[ni][r] * accO[ni][r];
        s += __shfl_xor(s, 1); s += __shfl_xor(s, 2); s += __shfl_xor(s, 4); s += __shfl_xor(s, 8);
        s4[r] = s;
      }
      if ((lane & 15) == 0) {
#pragma unroll
        for (int r = 0; r < 4; ++r) part[eh * 64 + pos0 + r] = s4[r];
      }
    }
    __syncthreads();
#pragma unroll
    for (int j = 0; j < 8; ++j) {
      const int e = j * 16 + (lane & 15);
      *(u2*)(ST + e * 136 + wid * 16 + (lane >> 4) * 4) = pack4v(Sacc[j]);
    }
    {
      float rs[4];
#pragma unroll
      for (int r = 0; r < 4; ++r) rs[r] = rsqrtf((part[pos0 + r] + part[64 + pos0 + r]) * (1.f / 128.f) + 1e-6f);
#pragma unroll
      for (int ni = 0; ni < 4; ++ni) {
        const int e = (eh * 4 + ni) * 16 + (lane & 15);
        const float ng = p.dn_norm_g[l * 128 + e];
#pragma unroll
        for (int r = 0; r < 4; ++r) {
          u16* zp = sz + (r0 + pos0 + r) * 512 + e;
          const float z = bf2f(*zp);
          *zp = f2bf(accO[ni][r] * rs[r] * ng * siluf(z));
        }
      }
    }
    if (n + 1 < 128) stash();
    __syncthreads();
  }
}

DEVI float ret_log2gamma(int h) { return log2f(1.f - exp2f(-5.f - (float)h)); }
DEVI void load_rope_tile(const P& p, const u16* secp, int r0, int h, float scale, u16* dst, u16* dstT, float l2g) {
  const int t = tid_l();
  const int row = t >> 2, j0 = (t & 3) * 16;
  const u16* src = secp + (size_t)(r0 + row) * 512 + h * 128;
  float x1[16], x2[16];
  unpack8(*(const u4*)(src + j0), x1); unpack8(*(const u4*)(src + j0 + 8), x1 + 8);
  unpack8(*(const u4*)(src + 64 + j0), x2); unpack8(*(const u4*)(src + 64 + j0 + 8), x2 + 8);
  const float* cs = p.ropecs + ((size_t)(r0 + row) * 64 + j0) * 2;
  float o1[16], o2[16];
#pragma unroll
  for (int j = 0; j < 16; j += 2) {
    const float4 c4 = *(const float4*)(cs + j * 2);
    o1[j] = (x1[j] * c4.x - x2[j] * c4.y) * scale;
    o2[j] = (x1[j] * c4.y + x2[j] * c4.x) * scale;
    o1[j + 1] = (x1[j + 1] * c4.z - x2[j + 1] * c4.w) * scale;
    o2[j + 1] = (x1[j + 1] * c4.w + x2[j + 1] * c4.z) * scale;
  }
  *(u4*)(dst + row * 136 + j0) = pack8(o1); *(u4*)(dst + row * 136 + j0 + 8) = pack8(o1 + 8);
  *(u4*)(dst + row * 136 + 64 + j0) = pack8(o2); *(u4*)(dst + row * 136 + 64 + j0 + 8) = pack8(o2 + 8);
  if (dstT) {
    const float z = exp2f(l2g * (float)(127 - row));
#pragma unroll
    for (int j = 0; j < 16; ++j) {
      dstT[(j0 + j) * 136 + row] = f2bf(o1[j] * z);
      dstT[(64 + j0 + j) * 136 + row] = f2bf(o2[j] * z);
    }
  }
}
DEVI void ret_d1_unit(const P& p, int u, unsigned char* smem) {
  const int t = tid_l(), lane = t & 63, wid = t >> 6;
  const int h = u & 3, n = (u >> 2) & 63, b = u >> 8;
  const int r0 = b * SEQ + n * 128;
  const float l2g = ret_log2gamma(h);
  u16* Qs = (u16*)smem;
  u16* Ks = Qs + 128 * 136;
  u16* KTz = Ks + 128 * 136;
  u16* VT = KTz + 128 * 136;
  load_rope_tile(p, p.sec + 7 * SECE, r0, h, 1.f, Qs, nullptr, 0.f);
  load_rope_tile(p, p.sec + 8 * SECE, r0, h, 0.08838834764831845f, Ks, KTz, l2g);
  {
    const int row = t >> 2, c0 = (t & 3) * 32;
    const u16* src = p.sec + 9 * SECE + (size_t)(r0 + row) * 512 + h * 128 + c0;
#pragma unroll
    for (int q = 0; q < 4; ++q) {
      const u4 v = *(const u4*)(src + q * 8);
      const u16* e = (const u16*)&v;
#pragma unroll
      for (int j = 0; j < 8; ++j) VT[(c0 + q * 8 + j) * 136 + row] = e[j];
    }
  }
  __syncthreads();
  f32x4 sacc[8];
#pragma unroll
  for (int ii = 0; ii < 8; ++ii) sacc[ii] = f32x4{0.f, 0.f, 0.f, 0.f};
#pragma unroll
  for (int k0 = 0; k0 < 128; k0 += 32) {
    const bf16x8 a = frag(Ks, 136, wid * 16, k0, lane);
#pragma unroll
    for (int ii = 0; ii < 8; ++ii) sacc[ii] = mfma16(a, frag(Qs, 136, ii * 16, k0, lane), sacc[ii]);
  }
  __syncthreads();
#pragma unroll
  for (int ii = 0; ii < 8; ++ii) {
    const int i = ii * 16 + (lane & 15), j0 = wid * 16 + (lane >> 4) * 4;
    f32x4 v;
#pragma unroll
    for (int r = 0; r < 4; ++r) v[r] = (i >= j0 + r) ? sacc[ii][r] * exp2f(l2g * (float)(i - j0 - r)) : 0.f;
    *(u2*)(Qs + i * 136 + j0) = pack4v(v);
  }
  __syncthreads();
  f32x4 oacc[8], kacc[8];
#pragma unroll
  for (int ii = 0; ii < 8; ++ii) { oacc[ii] = f32x4{0.f, 0.f, 0.f, 0.f}; kacc[ii] = f32x4{0.f, 0.f, 0.f, 0.f}; }
#pragma unroll
  for (int k0 = 0; k0 < 128; k0 += 32) {
    const bf16x8 a1 = frag(Qs, 136, wid * 16, k0, lane), a2 = frag(KTz, 136, wid * 16, k0, lane);
#pragma unroll
    for (int ii = 0; ii < 8; ++ii) {
      const bf16x8 bb = frag(VT, 136, ii * 16, k0, lane);
      oacc[ii] = mfma16(a1, bb, oacc[ii]);
      kacc[ii] = mfma16(a2, bb, kacc[ii]);
    }
  }
  u16* od = p.sec + 8 * SECE;
  u16* kd = p.sec + 9 * SECE;
#pragma unroll
  for (int ii = 0; ii < 8; ++ii) {
    const int e = ii * 16 + (lane & 15);
#pragma unroll
    for (int r = 0; r < 4; ++r) {
      const size_t o = (size_t)(r0 + wid * 16 + (lane >> 4) * 4 + r) * 512 + h * 128 + e;
      od[o] = f2bf(oacc[ii][r]);
      kd[o] = f2bf(kacc[ii][r]);
    }
  }
  __syncthreads();
}
DEVI void ret_d2_unit(const P& p, int l, int u, unsigned char* smem) {
  const int t = tid_l(), lane = t & 63, wid = t >> 6;
  const int h = u & 3, n = (u >> 2) & 63, b = u >> 8;
  const int r0 = b * SEQ + n * 128;
  const float l2g = ret_log2gamma(h);
  u16* Qs = (u16*)smem;
  u16* PT = Qs + 128 * 136;
  load_rope_tile(p, p.sec + 7 * SECE, r0, h, 1.f, Qs, nullptr, 0.f);
  {
    const int d = t >> 2, e0 = (t & 3) * 32;
    float acc[32];
#pragma unroll
    for (int j = 0; j < 32; ++j) acc[j] = 0.f;
    const float G = exp2f(l2g * 128.f);
    const u16* src = p.sec + 9 * SECE + ((size_t)b * SEQ + d) * 512 + h * 128 + e0;
    for (int m = 0; m < n; ++m) {
      const u16* s = src + (size_t)m * 128 * 512;
#pragma unroll
      for (int q = 0; q < 4; ++q) {
        float f[8];
        unpack8(*(const u4*)(s + q * 8), f);
#pragma unroll
        for (int j = 0; j < 8; ++j) acc[q * 8 + j] = acc[q * 8 + j] * G + f[j];
      }
    }
#pragma unroll
    for (int j = 0; j < 32; ++j) PT[(e0 + j) * 136 + d] = f2bf(acc[j]);
  }
  __syncthreads();
  f32x4 oacc[8];
#pragma unroll
  for (int ii = 0; ii < 8; ++ii) oacc[ii] = f32x4{0.f, 0.f, 0.f, 0.f};
#pragma unroll
  for (int k0 = 0; k0 < 128; k0 += 32) {
    const bf16x8 a = frag(Qs, 136, wid * 16, k0, lane);
#pragma unroll
    for (int ii = 0; ii < 8; ++ii) oacc[ii] = mfma16(a, frag(PT, 136, ii * 16, k0, lane), oacc[ii]);
  }
  const u16* oin = p.sec + 8 * SECE;
  u16* gd = p.sec + 10 * SECE;
  const int i0 = wid * 16 + (lane >> 4) * 4;
  float s1[4] = {0.f, 0.f, 0.f, 0.f}, s2[4] = {0.f, 0.f, 0.f, 0.f};
#pragma unroll
  for (int ii = 0; ii < 8; ++ii) {
    const int e = ii * 16 + (lane & 15);
#pragma unroll
    for (int r = 0; r < 4; ++r) {
      const float xi = exp2f(l2g * (float)(i0 + r + 1));
      const float o = bf2f(oin[(size_t)(r0 + i0 + r) * 512 + h * 128 + e]) + xi * oacc[ii][r];
      oacc[ii][r] = o;
      s1[r] += o; s2[r] += o * o;
    }
  }
#pragma unroll
  for (int r = 0; r < 4; ++r) {
#pragma unroll
    for (int o = 1; o < 16; o <<= 1) { s1[r] += __shfl_xor(s1[r], o); s2[r] += __shfl_xor(s2[r], o); }
  }
#pragma unroll
  for (int ii = 0; ii < 8; ++ii) {
    const int e = ii * 16 + (lane & 15);
    const float gg = p.ret_gn_g[l * 512 + h * 128 + e];
#pragma unroll
    for (int r = 0; r < 4; ++r) {
      const float mu = s1[r] * (1.f / 128.f);
      const float var = fmaxf(s2[r] * (1.f / 128.f) - mu * mu, 0.f);
      u16* gp = gd + (size_t)(r0 + i0 + r) * 512 + h * 128 + e;
      const float g = bf2f(*gp);
      *gp = f2bf(siluf(g) * (oacc[ii][r] - mu) * rsqrtf(var + 1e-6f) * gg);
    }
  }
  __syncthreads();
}

DEVI void pool_unit(const P& p, int l, int u, unsigned char* smem) {
  const int t = tid_l(), lane = t & 63, wid = t >> 6;
  const int g = u & 3, rt = u >> 2;
  const int r0 = rt * 64, spos0 = r0 & (SEQ - 1);
  const int win = 2 << g;
  u16* Al = (u16*)smem;
  u16* Wl = Al + 64 * 136;
  {
    const int row = t >> 3, c0 = (t & 7) * 16;
    const u16* base = p.sec + 4 * SECE + g * 128 + c0;
    float sum[16], own[16];
#pragma unroll
    for (int c = 0; c < 16; ++c) sum[c] = 0.f;
    const int sp = spos0 + row;
    const int cnt = min(sp + 1, win);
    for (int j = 0; j < cnt; ++j) {
      const u16* src = base + (size_t)(r0 + row - j) * 512;
      float f[16];
      unpack8(*(const u4*)src, f); unpack8(*(const u4*)(src + 8), f + 8);
#pragma unroll
      for (int c = 0; c < 16; ++c) { sum[c] += f[c]; if (j == 0) own[c] = f[c]; }
    }
    const float ic = 1.f / (float)cnt;
#pragma unroll
    for (int c = 0; c < 16; ++c) sum[c] = sum[c] * ic - own[c];
    *(u4*)(Al + row * 136 + c0) = pack8(sum); *(u4*)(Al + row * 136 + c0 + 8) = pack8(sum + 8);
    const u16* wsrc = p.PoolWT + (size_t)g * 16384;
#pragma unroll
    for (int q = 0; q < 4; ++q) {
      const int idx = t + q * 512;
      const int d = idx >> 4, cc = (idx & 15) * 8;
      *(u4*)(Wl + d * 136 + cc) = *(const u4*)(wsrc + d * 128 + cc);
    }
  }
  __syncthreads();
  const int pt = wid & 3, dh = wid >> 2;
  f32x4 acc[4];
#pragma unroll
  for (int ni = 0; ni < 4; ++ni) acc[ni] = f32x4{0.f, 0.f, 0.f, 0.f};
#pragma unroll
  for (int k0 = 0; k0 < 128; k0 += 32) {
    const bf16x8 a = frag(Al, 136, pt * 16, k0, lane);
#pragma unroll
    for (int ni = 0; ni < 4; ++ni) acc[ni] = mfma16(a, frag(Wl, 136, (dh * 4 + ni) * 16, k0, lane), acc[ni]);
  }
#pragma unroll
  for (int ni = 0; ni < 4; ++ni) {
    const int d = (dh * 4 + ni) * 16 + (lane & 15);
    const float sc = p.pool_scale[l * 512 + g * 128 + d];
#pragma unroll
    for (int r = 0; r < 4; ++r)
      p.YB[(size_t)(r0 + pt * 16 + (lane >> 4) * 4 + r) * 512 + g * 128 + d] = f2bf(acc[ni][r] * sc);
  }
  __syncthreads();
}

DEVI void sg_unit(const P& p, int l, int u, unsigned char* smem) {
  const int t = tid_l(), lane = t & 63, wid = t >> 6;
  const int g = u & 3, ch = u >> 2;
  const int r0 = ch * 128;
  u16* VT = (u16*)smem;
  u16* Ul = VT + 128 * 136;
  u16* Wl = Ul + 128 * 136;
  {
    const int row = t >> 2, q = t & 3;
    const u16* svr = p.sec + 6 * SECE + (size_t)(r0 + row) * 512;
    float s1 = 0.f, s2 = 0.f;
#pragma unroll 4
    for (int i = 0; i < 16; ++i) {
      float f[8];
      unpack8(*(const u4*)(svr + q * 128 + i * 8), f);
#pragma unroll
      for (int j = 0; j < 8; ++j) { const float gv = geluf(f[j]); s1 += gv; s2 += gv * gv; }
    }
    s1 += __shfl_xor(s1, 1); s2 += __shfl_xor(s2, 1);
    s1 += __shfl_xor(s1, 2); s2 += __shfl_xor(s2, 2);
    const float mu = s1 * (1.f / 512.f);
    const float rstd = rsqrtf(fmaxf(s2 * (1.f / 512.f) - mu * mu, 0.f) + 1e-6f);
    const int c0 = q * 32;
    const u16* sur = p.sec + 5 * SECE + (size_t)(r0 + row) * 512 + g * 128 + c0;
#pragma unroll
    for (int i = 0; i < 4; ++i) {
      float f[8], uu[8];
      unpack8(*(const u4*)(svr + g * 128 + c0 + i * 8), f);
      unpack8(*(const u4*)(sur + i * 8), uu);
#pragma unroll
      for (int j = 0; j < 8; ++j) {
        const int c = g * 128 + c0 + i * 8 + j;
        const float vv = (geluf(f[j]) - mu) * rstd * p.sg_ln_g[l * 512 + c] + p.sg_ln_b[l * 512 + c];
        VT[(c0 + i * 8 + j) * 136 + row] = f2bf(vv);
        uu[j] = geluf(uu[j]);
      }
      *(u4*)(Ul + row * 136 + c0 + i * 8) = pack8(uu);
    }
    const float* wsrc = p.sg_w + ((size_t)(l * 4 + g) * 128 + row) * 128 + c0;
#pragma unroll
    for (int i = 0; i < 4; ++i) {
      const float4 a = *(const float4*)(wsrc + i * 8), bq = *(const float4*)(wsrc + i * 8 + 4);
      float f[8] = {a.x, a.y, a.z, a.w, bq.x, bq.y, bq.z, bq.w};
#pragma unroll
      for (int j = 0; j < 8; ++j) f[j] = (c0 + i * 8 + j <= row) ? f[j] : 0.f;
      *(u4*)(Wl + row * 136 + c0 + i * 8) = pack8(f);
    }
  }
  __syncthreads();
  f32x4 acc[8];
#pragma unroll
  for (int ii = 0; ii < 8; ++ii) acc[ii] = f32x4{0.f, 0.f, 0.f, 0.f};
#pragma unroll
  for (int k0 = 0; k0 < 128; k0 += 32) {
    if (k0 <= wid * 16 + 15) {
      const bf16x8 a = frag(Wl, 136, wid * 16, k0, lane);
#pragma unroll
      for (int ii = 0; ii < 8; ++ii) acc[ii] = mfma16(a, frag(VT, 136, ii * 16, k0, lane), acc[ii]);
    }
  }
  u16* dst = p.sec + 5 * SECE;
  const int t0 = wid * 16 + (lane >> 4) * 4;
#pragma unroll
  for (int r = 0; r < 4; ++r) {
    const float bias = p.sg_b[(l * 4 + g) * 128 + t0 + r];
#pragma unroll
    for (int ii = 0; ii < 8; ++ii) {
      const int c = ii * 16 + (lane & 15);
      dst[(size_t)(r0 + t0 + r) * 512 + g * 128 + c] = f2bf(bf2f(Ul[(t0 + r) * 136 + c]) * (acc[ii][r] + bias));
    }
  }
  __syncthreads();
}

DEVI void final_norm_phase(const P& p) {
  const int t = tid_l(), lane = t & 63, wid = t >> 6;
  for (int u = blockIdx.x; u < 2048; u += gridDim.x) {
    const int row = u * 8 + wid;
    float* xr = p.out + (size_t)row * 1024;
    float4 xv[4];
    float ss = 0.f;
#pragma unroll
    for (int i = 0; i < 4; ++i) {
      xv[i] = *(const float4*)(xr + i * 256 + lane * 4);
      ss += xv[i].x * xv[i].x + xv[i].y * xv[i].y + xv[i].z * xv[i].z + xv[i].w * xv[i].w;
    }
    ss = wave_sum(ss);
    const float rstd = rsqrtf(ss * (1.f / 1024.f) + 1e-6f);
#pragma unroll
    for (int i = 0; i < 4; ++i) {
      const float4 g = *(const float4*)(p.final_g + i * 256 + lane * 4);
      float4 o;
      o.x = xv[i].x * rstd * g.x; o.y = xv[i].y * rstd * g.y; o.z = xv[i].z * rstd * g.z; o.w = xv[i].w * rstd * g.w;
      *(float4*)(xr + i * 256 + lane * 4) = o;
    }
  }
}

#ifndef PHMASK
#define PHMASK 0xffffffffu
#endif
#define EN(x) (((PHMASK) >> (x)) & 1u)
typedef const __attribute__((address_space(4))) P* KP;
DEVI P load_params(KP vp) {
  const __attribute__((address_space(4))) P& v = *vp;
  P q;
  q.x = v.x; q.c = v.c; q.pos = v.pos; q.norm1_g = v.norm1_g; q.norm2_g = v.norm2_g; q.ada_w = v.ada_w; q.ada_b = v.ada_b;
  q.w_in = v.w_in; q.dn_conv_w = v.dn_conv_w; q.dn_a_log = v.dn_a_log; q.dn_dt_bias = v.dn_dt_bias; q.dn_norm_g = v.dn_norm_g;
  q.pool_w = v.pool_w; q.pool_scale = v.pool_scale; q.sg_ln_g = v.sg_ln_g; q.sg_ln_b = v.sg_ln_b; q.sg_w = v.sg_w; q.sg_b = v.sg_b;
  q.ret_gn_g = v.ret_gn_g; q.w_br0 = v.w_br0; q.w_br1 = v.w_br1; q.w_br2 = v.w_br2; q.w_br3 = v.w_br3;
  q.w_out = v.w_out; q.mlp_w1 = v.mlp_w1; q.mlp_w2 = v.mlp_w2; q.final_g = v.final_g; q.out = v.out;
  q.WinT = v.WinT; q.WbrT = v.WbrT; q.WoutT = v.WoutT; q.W1T = v.W1T; q.W2T = v.W2T; q.PoolWT = v.PoolWT; q.h = v.h; q.sec = v.sec;
  q.TQ = v.TQ; q.YB = v.YB; q.halo = v.halo; q.modp = v.modp; q.beta = v.beta; q.glog = v.glog; q.gcum = v.gcum; q.ropecs = v.ropecs;
  q.phase_lo = 0; q.phase_hi = 0;
  return q;
}
#define LP() KP k2_ = kp; asm volatile("" : "+s"(k2_)); const P p = load_params(k2_)
DEVI void run_phase(int ph, unsigned char* smem) {
  KP kp = (KP)__builtin_amdgcn_kernarg_segment_ptr();
  int bid = blockIdx.x; asm volatile("" : "+s"(bid));
  const int nb = gridDim.x;
  if (ph == 0) {
    for (int u = bid; u < 96 + 2048 + NWCONV; u += nb) {
      if (u < 96) { if (EN(0)) { LP(); mod_unit(p, u, smem); } }
      else if (u < 96 + 2048) { if (EN(1)) { LP(); rope_unit(p, u - 96); } }
      else { if (EN(2)) { LP(); wconv_unit(p, 0, u - 96 - 2048, smem); } }
    }
    return;
  }
  if (ph == NPHASE - 1) { if (EN(15)) { LP(); final_norm_phase(p); } return; }
  const int l = (ph - 1) / 10, s = (ph - 1) % 10;
  switch (s) {
    case 0:
      if (l == 1 && EN(2)) for (int u = bid; u < NWCONV; u += nb) { LP(); wconv_unit(p, 1, u, smem); }
      __syncthreads();
      if (EN(3)) { LP(); norm_phase(p, l, 0, smem); }
      break;
    case 1: if (EN(4)) { LP(); proj_phase(p, smem); } break;
    case 2:
      for (int u = bid; u < 1024 + 512 + 512 + 1024; u += nb) {
        if (u < 1024) { if (EN(5)) { LP(); dn_prep_unit(p, l, u, smem); } }
        else if (u < 1536) { if (EN(6)) { LP(); ret_d1_unit(p, u - 1024, smem); } }
        else if (u < 2048) { if (EN(7)) { LP(); sg_unit(p, l, u - 1536, smem); } }
        else { if (EN(8)) { LP(); pool_unit(p, l, u - 2048, smem); } }
      }
      break;
    case 3:
      if (bid < 8) { if (EN(9)) { LP(); dn_chain(p, l, bid, smem); } }
      else if (EN(10)) for (int u = bid - 8; u < 512; u += nb - 8) { LP(); ret_d2_unit(p, l, u, smem); }
      break;
    case 4: if (EN(11)) { LP(); gates_phase(p, smem); } break;
    case 5: if (EN(12)) { LP(); merge_phase(p, smem); } break;
    case 6: if (EN(13)) { LP(); resid_gemm_phase(p, l, 0, smem); } break;
    case 7: if (EN(3)) { LP(); norm_phase(p, l, 1, smem); } break;
    case 8: if (EN(14)) { LP(); mlp1_phase(p, smem); } break;
    case 9: if (EN(13)) { LP(); resid_gemm_phase(p, l, 1, smem); } break;
  }
}

__global__ void __launch_bounds__(NT) mega(P p) {
  extern __shared__ __attribute__((aligned(16))) unsigned char smem[];
  for (int ph = p.phase_lo; ph < p.phase_hi; ++ph) {
    run_phase(ph, smem);
    if (ph + 1 < p.phase_hi) cg::this_grid().sync();
  }
}

extern "C" void kernel_launch(void* const* d_in, const int* in_sizes, int n_in, void* d_out, int out_size, void* d_ws,
                              size_t ws_size, hipStream_t stream) {
  static int grid = 0;
  constexpr size_t MiB = 1024 * 1024;
  constexpr size_t WS_NEED = 298 * MiB;
  if (grid == 0) {
    if (ws_size < WS_NEED || n_in != 27) {
      fprintf(stderr, "kernel_launch: ws_size %zu < %zu or n_in %d != 27\n", ws_size, WS_NEED, n_in);
      grid = -1;
      return;
    }
    int dev = 0, cus = 0, per_cu = 0;
    hipGetDevice(&dev);
    hipDeviceGetAttribute(&cus, hipDeviceAttributeMultiprocessorCount, dev);
    hipFuncSetAttribute((const void*)mega, hipFuncAttributeMaxDynamicSharedMemorySize, SMEM_BYTES);
    hipOccupancyMaxActiveBlocksPerMultiprocessor(&per_cu, (const void*)mega, NT, SMEM_BYTES);
    if (per_cu < 1) per_cu = 1;
    grid = cus * per_cu;
    (void)hipGetLastError();
  }
  if (grid < 0) return;
  P p{};
  p.x = (const float*)d_in[0]; p.c = (const float*)d_in[1]; p.pos = (const int*)d_in[2];
  p.norm1_g = (const float*)d_in[3]; p.norm2_g = (const float*)d_in[4];
  p.ada_w = (const float*)d_in[5]; p.ada_b = (const float*)d_in[6]; p.w_in = (const float*)d_in[7];
  p.dn_conv_w = (const float*)d_in[8]; p.dn_a_log = (const float*)d_in[9]; p.dn_dt_bias = (const float*)d_in[10];
  p.dn_norm_g = (const float*)d_in[11]; p.pool_w = (const float*)d_in[12]; p.pool_scale = (const float*)d_in[13];
  p.sg_ln_g = (const float*)d_in[14]; p.sg_ln_b = (const float*)d_in[15]; p.sg_w = (const float*)d_in[16];
  p.sg_b = (const float*)d_in[17]; p.ret_gn_g = (const float*)d_in[18];
  p.w_br0 = (const float*)d_in[19]; p.w_br1 = (const float*)d_in[20]; p.w_br2 = (const float*)d_in[21];
  p.w_br3 = (const float*)d_in[22];
  p.w_out = (const float*)d_in[23]; p.mlp_w1 = (const float*)d_in[24]; p.mlp_w2 = (const float*)d_in[25];
  p.final_g = (const float*)d_in[26];
  p.out = (float*)d_out;
  unsigned char* ws = (unsigned char*)d_ws;
  size_t o = 0;
  p.WinT = (u16*)(ws + o); o += (size_t)9728 * 1024 * 2;
  p.WbrT = (u16*)(ws + o); o += (size_t)4 * 1024 * 512 * 2;
  p.WoutT = (u16*)(ws + o); o += (size_t)1024 * 1024 * 2;
  p.W1T = (u16*)(ws + o); o += (size_t)4096 * 1024 * 2;
  p.W2T = (u16*)(ws + o); o += (size_t)4096 * 1024 * 2;
  p.PoolWT = (u16*)(ws + o); o += (size_t)4 * 128 * 128 * 2;
  o = 44 * MiB;
  p.h = (u16*)(ws + o); o += 32 * MiB;
  p.sec = (u16*)(ws + o); o += 176 * MiB;
  p.TQ = (u16*)(ws + o); o += 16 * MiB;
  p.YB = (u16*)(ws + o); o += 16 * MiB;
  p.halo = (u16*)(ws + o); o += 3 * MiB;
  p.modp = (float*)(ws + o); o += 1 * MiB;
  p.beta = (float*)(ws + o); o += 262144;
  p.glog = (float*)(ws + o); o += 262144;
  p.gcum = (float*)(ws + o); o += 262144;
  p.ropecs = (float*)(ws + o); o += 8 * MiB;
#if COOP
  p.phase_lo = 0; p.phase_hi = NPHASE;
  void* args[] = {&p};
  hipError_t e = hipLaunchCooperativeKernel((const void*)mega, dim3(grid), dim3(NT), args, SMEM_BYTES, stream);
  if (e != hipSuccess) fprintf(stderr, "cooperative launch failed: %s (grid %d)\n", hipGetErrorString(e), grid);
#else
  for (int ph = 0; ph < NPHASE; ++ph) {
    p.phase_lo = ph; p.phase_hi = ph + 1;
    hipLaunchKernelGGL(mega, dim3(grid), dim3(NT), SMEM_BYTES, stream, p);
  }
#endif
}
```

```cpp
#include <hip/hip_runtime.h>
#include <hip/hip_bf16.h>
#include <hip/hip_cooperative_groups.h>
#include <cstdio>
namespace cg = cooperative_groups;

#ifndef COOP
#define COOP 1
#endif

typedef unsigned short u16;
using bf16x8 = __attribute__((ext_vector_type(8))) short;
using f32x4 = __attribute__((ext_vector_type(4))) float;
using u4 = __attribute__((ext_vector_type(4))) unsigned;
using u2 = __attribute__((ext_vector_type(2))) unsigned;
#define DEVI __device__ __forceinline__

constexpr int NT = 512;
constexpr int SEQ = 8192;
constexpr size_t SECE = (size_t)16384 * 512;
constexpr int SMEM_BYTES = 156 * 1024;
constexpr int NPHASE = 22;

struct P {
  const float *x, *c;
  const int* pos;
  const float *norm1_g, *norm2_g, *ada_w, *ada_b, *w_in, *dn_conv_w, *dn_a_log, *dn_dt_bias, *dn_norm_g, *pool_w,
      *pool_scale, *sg_ln_g, *sg_ln_b, *sg_w, *sg_b, *ret_gn_g, *w_br0, *w_br1, *w_br2, *w_br3, *w_out, *mlp_w1, *mlp_w2, *final_g;
  float* out;
  u16 *WinT, *WbrT, *WoutT, *W1T, *W2T, *PoolWT, *h, *sec, *TQ, *YB, *halo, *QKF;
  float *modp, *beta, *glog, *EG, *ropecs;
  unsigned* prog;
  float* rowss;
  unsigned* xbar;
  int phase_lo, phase_hi;
};

DEVI int tid_l() { int t = threadIdx.x; asm volatile("" : "+v"(t)); return t; }
template <class T> DEVI void lnd(T*& q) { asm volatile("" : "+s"(q)); }
typedef float f32x2_t __attribute__((ext_vector_type(2)));
typedef __bf16 bf16x2_t __attribute__((ext_vector_type(2)));
DEVI unsigned pack2(float a, float b) { const f32x2_t v = {a, b}; const bf16x2_t r = __builtin_convertvector(v, bf16x2_t); return __builtin_bit_cast(unsigned, r); }
DEVI u16 f2bf(float f) { return (u16)(pack2(f, f) & 0xffffu); }
DEVI float bf2f(u16 h) { return __uint_as_float(((unsigned)h) << 16); }
DEVI float lo2f(unsigned u) { return __uint_as_float(u << 16); }
DEVI float hi2f(unsigned u) { return __uint_as_float(u & 0xffff0000u); }
DEVI void unpack8(u4 v, float* f) {
  f[0] = lo2f(v.x); f[1] = hi2f(v.x); f[2] = lo2f(v.y); f[3] = hi2f(v.y);
  f[4] = lo2f(v.z); f[5] = hi2f(v.z); f[6] = lo2f(v.w); f[7] = hi2f(v.w);
}
DEVI u4 pack8(const float* f) {
  u4 v; v.x = pack2(f[0], f[1]); v.y = pack2(f[2], f[3]); v.z = pack2(f[4], f[5]); v.w = pack2(f[6], f[7]);
  return v;
}
DEVI float wave_sum(float v) {
#pragma unroll
  for (int o = 32; o > 0; o >>= 1) v += __shfl_xor(v, o);
  return v;
}
DEVI float siluf(float x) { return x * __builtin_amdgcn_rcpf(1.f + __expf(-x)); }
DEVI float sigmf(float x) { return __builtin_amdgcn_rcpf(1.f + __expf(-x)); }
DEVI float geluf(float v) {
  const float av = fabsf(v), t = __builtin_amdgcn_rcpf(av * 0.2316418882f + 1.0f);
  float q = t * 0.5307027145f + (-0.7265760135f); q = q * t + 0.7107068705f; q = q * t + (-0.142248368f); q = q * t + 0.127414796f; q = q * t;
  const float e = __builtin_amdgcn_exp2f((v * v) * (-0.72134752044f));
  const float m = v * (q * e);
  return v < 0.f ? m : v - m;
}
DEVI f32x4 mfma16(bf16x8 a, bf16x8 b, f32x4 c) { return __builtin_amdgcn_mfma_f32_16x16x32_bf16(a, b, c, 0, 0, 0); }
DEVI bf16x8 frag(const u16* base, int ld, int r0, int k0, int lane) {
  return *(const bf16x8*)(base + (r0 + (lane & 15)) * ld + k0 + 8 * (lane >> 4));
}
DEVI u2 pack4v(f32x4 v) { u2 r; r.x = pack2(v[0], v[1]); r.y = pack2(v[2], v[3]); return r; }

DEVI float modval(const P& p, int l, int b, int j) { return p.modp[(size_t)(l * 2 + b) * 6144 + j]; }

DEVI void gemm_kloop(const u16* __restrict__ A, int lda, const u16* __restrict__ Bt, int ldb, int K,
                     f32x4 (&acc)[4][4], u16* sm) {
  const int t = tid_l(), lane = t & 63, wid = t >> 6, wr = wid >> 1, wc = wid & 1;
  u16* As = sm;
  u16* Bs = sm + 2 * 256 * 64;
  const int lrow = t >> 3, lch = t & 7;
  const u16* ag = A + (size_t)lrow * lda + lch * 8;
  const u16* bg = Bt + (size_t)lrow * ldb + lch * 8;
  const int soff = lrow * 64 + ((lch ^ (lrow & 7)) * 8);
  u4 ra[4], rb[2];
#pragma unroll
  for (int i = 0; i < 4; ++i) ra[i] = *(const u4*)(ag + (size_t)i * 64 * lda);
#pragma unroll
  for (int i = 0; i < 2; ++i) rb[i] = *(const u4*)(bg + (size_t)i * 64 * ldb);
  __syncthreads();
#pragma unroll
  for (int i = 0; i < 4; ++i) *(u4*)(As + i * 64 * 64 + soff) = ra[i];
#pragma unroll
  for (int i = 0; i < 2; ++i) *(u4*)(Bs + i * 64 * 64 + soff) = rb[i];
  __syncthreads();
  const int nt = K >> 6;
  const int arow = (wr * 64 + (lane & 15)) * 64, brow = (wc * 64 + (lane & 15)) * 64;
  for (int kt = 0; kt < nt; ++kt) {
    const int cur = kt & 1;
    if (kt + 1 < nt) {
      const int ko = (kt + 1) * 64;
#pragma unroll
      for (int i = 0; i < 4; ++i) ra[i] = *(const u4*)(ag + (size_t)i * 64 * lda + ko);
#pragma unroll
      for (int i = 0; i < 2; ++i) rb[i] = *(const u4*)(bg + (size_t)i * 64 * ldb + ko);
    }
    const u16* Ac = As + cur * 256 * 64 + arow;
    const u16* Bc = Bs + cur * 128 * 64 + brow;
#pragma unroll
    for (int kk = 0; kk < 2; ++kk) {
      const int ch = (((kk * 4 + (lane >> 4)) ^ (lane & 7)) * 8);
      bf16x8 af[4], bfr[4];
#pragma unroll
      for (int mi = 0; mi < 4; ++mi) af[mi] = *(const bf16x8*)(Ac + mi * 16 * 64 + ch);
#pragma unroll
      for (int ni = 0; ni < 4; ++ni) bfr[ni] = *(const bf16x8*)(Bc + ni * 16 * 64 + ch);
#pragma unroll
      for (int mi = 0; mi < 4; ++mi)
#pragma unroll
        for (int ni = 0; ni < 4; ++ni) acc[mi][ni] = mfma16(af[mi], bfr[ni], acc[mi][ni]);
    }
    if (kt + 1 < nt) {
      const int nb = cur ^ 1;
#pragma unroll
      for (int i = 0; i < 4; ++i) *(u4*)(As + nb * 256 * 64 + i * 64 * 64 + soff) = ra[i];
#pragma unroll
      for (int i = 0; i < 2; ++i) *(u4*)(Bs + nb * 128 * 64 + i * 64 * 64 + soff) = rb[i];
    }
    __syncthreads();
  }
}
DEVI void zero_acc(f32x4 (&acc)[4][4]) {
#pragma unroll
  for (int i = 0; i < 4; ++i)
#pragma unroll
    for (int j = 0; j < 4; ++j) acc[i][j] = f32x4{0.f, 0.f, 0.f, 0.f};
}
template <class F>
DEVI void epi_foreach(f32x4 (&acc)[4][4], int row0, int col0, F f) {
  const int t = tid_l(), lane = t & 63, wid = t >> 6, wr = wid >> 1, wc = wid & 1;
#pragma unroll
  for (int mi = 0; mi < 4; ++mi)
#pragma unroll
    for (int ni = 0; ni < 4; ++ni)
#pragma unroll
      for (int r = 0; r < 4; ++r)
        f(row0 + wr * 64 + mi * 16 + (lane >> 4) * 4 + r, col0 + wc * 64 + ni * 16 + (lane & 15), acc[mi][ni][r]);
}

DEVI void mod_unit(const P& p, int u, unsigned char* smem) {
  const int t = tid_l();
  const int l = u / 48, jb = u % 48;
  float* cond = (float*)smem;
  float* red = cond + 2048;
  for (int i = t; i < 2048; i += NT) cond[i] = siluf(p.c[i]);
  __syncthreads();
  const int kq = t >> 7, jj = t & 127;
  const float* w = p.ada_w + ((size_t)l * 1024 + kq * 256) * 6144 + jb * 128 + jj;
  float a0 = 0.f, a1 = 0.f;
#pragma unroll 16
  for (int k = 0; k < 256; ++k) {
    const float wv = w[(size_t)k * 6144];
    a0 += cond[kq * 256 + k] * wv;
    a1 += cond[1024 + kq * 256 + k] * wv;
  }
  red[(kq * 2 + 0) * 128 + jj] = a0;
  red[(kq * 2 + 1) * 128 + jj] = a1;
  __syncthreads();
  if (t < 256) {
    const int bb = t >> 7;
    const int j = jb * 128 + jj;
    float sacc = p.ada_b[l * 6144 + j];
#pragma unroll
    for (int q = 0; q < 4; ++q) sacc += red[(q * 2 + bb) * 128 + jj];
    p.modp[(size_t)(l * 2 + bb) * 6144 + j] = sacc;
  }
  __syncthreads();
}
DEVI void rope_unit(const P& p, int u) {
  const int idx = u * 512 + tid_l();
  const int tok = idx >> 6, j = idx & 63;
  const float inv = exp2f(-(float)j * (13.287712379549449f / 64.f));
  const float ang = (float)p.pos[tok] * inv;
  double rev = (double)ang * 0.15915494309189535;
  rev -= rint(rev);
  const float r = (float)(rev * 6.283185307179586);
  p.ropecs[(size_t)idx * 2] = __cosf(r);
  p.ropecs[(size_t)idx * 2 + 1] = __sinf(r);
}
template <int NTL>
DEVI void conv_tiles(const float* __restrict__ src, int ld, int K, int kt, int nt0, int col0, u16* __restrict__ dst, unsigned char* smem, int dkt = -1) {
  if (dkt < 0) dkt = kt;
  float* ls = (float*)smem;
  const int t = tid_l();
  float4 v[NTL][2];
#pragma unroll
  for (int q = 0; q < NTL; ++q)
#pragma unroll
    for (int ps = 0; ps < 2; ++ps) {
      const int kk = ps * 32 + (t >> 4), n4 = (t & 15) * 4;
      v[q][ps] = *(const float4*)(src + (size_t)(kt * 64 + kk) * ld + col0 + q * 64 + n4);
    }
#pragma unroll
  for (int q = 0; q < NTL; ++q)
#pragma unroll
    for (int ps = 0; ps < 2; ++ps) {
      const int kk = ps * 32 + (t >> 4), n4 = (t & 15) * 4;
      float* d = ls + q * 64 * 65 + kk * 65 + n4;
      d[0] = v[q][ps].x; d[1] = v[q][ps].y; d[2] = v[q][ps].z; d[3] = v[q][ps].w;
    }
  __syncthreads();
  const int n = t >> 3, kc = (t & 7) * 8;
#pragma unroll
  for (int q = 0; q < NTL; ++q) {
    float f[8];
#pragma unroll
    for (int j = 0; j < 8; ++j) f[j] = ls[q * 64 * 65 + (kc + j) * 65 + n];
    *(u4*)(dst + (size_t)((nt0 + q) * 64 + n) * K + dkt * 64 + kc) = pack8(f);
  }
  __syncthreads();
}
constexpr int NWCONV = 608 + 128 + 64 + 256 + 256 + 8;
DEVI void wconv_unit(const P& p, int l, int w, unsigned char* smem) {
  if (w < 608) {
    const int kt = w & 15, ng = w >> 4, n0 = ng * 256;
    conv_tiles<4>(p.w_in + (size_t)l * 1024 * 9736, 9736, 512, kt, ng * 4, n0 + (n0 >= 2048 ? 8 : 0), p.WinT + (size_t)(kt >> 3) * 9728 * 512, smem, kt & 7);
    return;
  }
  w -= 608;
  if (w < 128) {
    const int b = w >> 5, r = w & 31, kt = r & 7, ng = r >> 3;
    const float* b0 = p.w_br0; const float* b1 = p.w_br1; const float* b2 = p.w_br2; const float* b3 = p.w_br3;
    asm volatile("" : "+s"(b0)); asm volatile("" : "+s"(b1)); asm volatile("" : "+s"(b2)); asm volatile("" : "+s"(b3));
    conv_tiles<4>((b == 0 ? b0 : b == 1 ? b1 : b == 2 ? b2 : b3) + (size_t)l * 512 * 1024, 1024, 512, kt, ng * 4, ng * 256, p.WbrT + (size_t)b * 1024 * 512, smem);
    return;
  }
  w -= 128;
  if (w < 64) {
    conv_tiles<4>(p.w_out + (size_t)l * 1024 * 1024, 1024, 1024, w & 15, (w >> 4) * 4, (w >> 4) * 256, p.WoutT, smem);
    return;
  }
  w -= 64;
  if (w < 256) {
    conv_tiles<4>(p.mlp_w1 + (size_t)l * 1024 * 4096, 4096, 1024, w & 15, (w >> 4) * 4, (w >> 4) * 256, p.W1T, smem);
    return;
  }
  w -= 256;
  if (w < 256) {
    conv_tiles<4>(p.mlp_w2 + (size_t)l * 4096 * 1024, 1024, 4096, w & 63, (w >> 6) * 4, (w >> 6) * 256, p.W2T, smem);
    return;
  }
  w -= 256;
  {
    const int g = w >> 1, kt = w & 1;
    conv_tiles<2>(p.pool_w + (size_t)(l * 4 + g) * 16384, 128, 128, kt, 0, 0, p.PoolWT + (size_t)g * 16384, smem);
  }
}

DEVI void norm_phase(const P& p, int l, int which, unsigned char* smem) {
  const int t = tid_l(), lane = t & 63, wid = t >> 6;
  float* ssh = (float*)smem;
  float* ssc = ssh + 2048;
  float* w8 = ssc + 2048;
  const float* gsrc = (which == 0 ? p.norm1_g : p.norm2_g) + l * 1024;
  const int ish = which == 0 ? 0 : 3;
#pragma unroll
  for (int i = t; i < 2048; i += NT) {
    const int b = i >> 10, c = i & 1023;
    ssh[i] = modval(p, l, b, ish * 1024 + c);
    ssc[i] = gsrc[c] * (1.f + modval(p, l, b, (ish + 1) * 1024 + c));
  }
  if (which == 0) {
#pragma unroll
    for (int i = t; i < 2048; i += NT) {
      const int k = i >> 1, hf = i & 1;
      *(float4*)(w8 + k * 8 + hf * 4) = *(const float4*)(p.w_in + ((size_t)l * 1024 + k) * 9736 + 2048 + hf * 4);
    }
  }
  __syncthreads();
  const float* xs = (l == 0 && which == 0) ? p.x : p.out;
  float4 xv[4];
  {
    const int u0 = blockIdx.x;
    if (u0 < 2048) {
      const float* xr = xs + (size_t)(u0 * 8 + wid) * 1024;
#pragma unroll
      for (int i = 0; i < 4; ++i) xv[i] = *(const float4*)(xr + i * 256 + lane * 4);
    }
  }
#pragma unroll 1
  for (int u = blockIdx.x; u < 2048; u += gridDim.x) {
    const int row = u * 8 + wid, b = row >> 13;
    float4 xn[4];
    {
      const int un = u + gridDim.x;
      const float* xr = xs + (size_t)((un < 2048 ? un : u) * 8 + wid) * 1024;
#pragma unroll
      for (int i = 0; i < 4; ++i) xn[i] = *(const float4*)(xr + i * 256 + lane * 4);
    }
    float ss = 0.f;
#pragma unroll
    for (int i = 0; i < 4; ++i) {
      ss += xv[i].x * xv[i].x + xv[i].y * xv[i].y + xv[i].z * xv[i].z + xv[i].w * xv[i].w;
    }
    ss = wave_sum(ss);
    const float rstd = rsqrtf(ss * (1.f / 1024.f) + 1e-6f);
    float a8[8];
#pragma unroll
    for (int j = 0; j < 8; ++j) a8[j] = 0.f;
#pragma unroll
    for (int i = 0; i < 4; ++i) {
      const int c = i * 256 + lane * 4;
      const float4 sc = *(const float4*)(ssc + b * 1024 + c);
      const float4 sh = *(const float4*)(ssh + b * 1024 + c);
      float hv[4];
      hv[0] = xv[i].x * rstd * sc.x + sh.x;
      hv[1] = xv[i].y * rstd * sc.y + sh.y;
      hv[2] = xv[i].z * rstd * sc.z + sh.z;
      hv[3] = xv[i].w * rstd * sc.w + sh.w;
      u2 o; o.x = pack2(hv[0], hv[1]); o.y = pack2(hv[2], hv[3]);
      *(u2*)(p.h + (size_t)(c >> 9) * 8388608 + (size_t)row * 512 + (c & 511)) = o;
      if (which == 0) {
#pragma unroll
        for (int e = 0; e < 4; ++e) {
          const float4 wa = *(const float4*)(w8 + (c + e) * 8);
          const float4 wb = *(const float4*)(w8 + (c + e) * 8 + 4);
          a8[0] += hv[e] * wa.x; a8[1] += hv[e] * wa.y; a8[2] += hv[e] * wa.z; a8[3] += hv[e] * wa.w;
          a8[4] += hv[e] * wb.x; a8[5] += hv[e] * wb.y; a8[6] += hv[e] * wb.z; a8[7] += hv[e] * wb.w;
        }
      }
    }
    if (which == 0) {
#pragma unroll
      for (int j = 0; j < 8; ++j) a8[j] = wave_sum(a8[j]);
      float mine = 0.f;
#pragma unroll
      for (int j = 0; j < 8; ++j) mine = (lane == j) ? a8[j] : mine;
      if (lane < 4) {
        p.beta[(size_t)row * 4 + lane] = sigmf(mine);
      } else if (lane < 8) {
        const int hh = lane - 4;
        const float xx = mine + p.dn_dt_bias[l * 4 + hh];
        const float sp = xx > 20.f ? xx : log1pf(expf(xx));
        p.glog[(size_t)row * 4 + hh] = -expf(p.dn_a_log[l * 4 + hh]) * sp;
      }
    }
#pragma unroll
    for (int i = 0; i < 4; ++i) xv[i] = xn[i];
  }
}

DEVI int gate_sec(int gs) { return gs < 3 ? gs : (gs == 3 ? 4 : (gs == 4 ? 6 : gs + 2)); }


namespace pg8 {
#define PG8_LAS __attribute__((address_space(3)))
constexpr int BM = 256, BK = 64, HALF = 128, HTB = HALF * BK * 2, STAGE_BYTES = 8 * HTB, NXCD = 8, WGM = 8;
DEVI int lds_byte(int r, int c) { const int st = (r >> 4) * 2 + (c >> 5), rr = r & 15, cc = c & 31, ob = rr * 64 + cc * 2; return st * 1024 + (ob ^ (((ob >> 9) & 1) << 5)); }
DEVI void stage_rc(int b, int& R, int& C) { const int st = b / 1024, sb = b % 1024, swz = sb ^ (((sb >> 9) & 1) << 5); R = (st >> 1) * 16 + swz / 64; C = (st & 1) * 32 + (swz % 64) / 2; }
DEVI int perm32(int rho) { const int n = rho >> 4, i = rho & 15; return 8 * (i >> 2) + 4 * n + (i & 3); }
struct Unit { int pm, pn, br, keep; const u16* A; const u16* Bt; };
struct Gemm { const u16* A; const u16* Bt; int M, N, K; };
struct StaticOrder {
  int nM, nN, nwg, G, c; const u16* gA; const u16* gB;
  DEVI void init(int M, int N, int G_, int c_, const u16* A_, const u16* B_) { nM = M / BM; nN = N / BM; nwg = nM * nN; G = G_; c = c_; gA = A_; gB = B_; }
  DEVI bool next(int i, Unit& u) const {
    const long L = (long)i * G + c; if (L >= nwg) return false;
    int wgid = (int)L; { const int q = nwg / NXCD, r = nwg % NXCD, xcd = wgid % NXCD, off = wgid / NXCD; wgid = (xcd < r ? xcd * (q + 1) : r * (q + 1) + (xcd - r) * q) + off; }
    const int nig = WGM * nN, gid = wgid / nig, fm = gid * WGM, gsz = (nM - fm) < WGM ? (nM - fm) : WGM;
    u.pm = fm + ((wgid % nig) % gsz); u.pn = (wgid % nig) / gsz; u.br = 0; u.keep = 0; u.A = gA; u.Bt = gB; return true;
  }
};
DEVI unsigned cvt_pk_bf16(float lo, float hi) { return pack2(lo, hi); }

template <class Epi, class Sched>
DEVI void gemm_phase(PG8_LAS unsigned char* lds, const Gemm g, const Sched& S, const Epi& E) {
  const int tid = tid_l(), wid = __builtin_amdgcn_readfirstlane(tid >> 6), lane = tid & 63, wr = wid >> 2, wc = wid & 3, fr = lane & 15, fq = lane >> 4;
  const int K = g.K, nt = K / BK;
  unsigned voffA[2], voffB[2];
#pragma unroll
  for (int i = 0; i < 2; ++i) { int R, C; stage_rc(tid * 16 + i * 8192, R, C); const int Rb = Epi::PERM ? ((R & ~31) + perm32(R & 31)) : R;
    voffA[i] = (unsigned)(R * K + C) * 2u; voffB[i] = (unsigned)(Rb * K + C) * 2u; }
  const size_t kstep = (size_t)(BK * 2);
  const size_t hstep = (size_t)HALF * K * 2;
  const size_t tstep = 2 * hstep;
  const unsigned ldsw = (unsigned)wid * 1024u;
  const int aoff = lds_byte(wr * 64 + fr, fq * 8), boff = lds_byte(wc * 32 + fr, fq * 8);
#define PG8_SA(b, h) (((b) * 2 + (h)) * HTB)
#define PG8_SB(b, h) ((4 + (b) * 2 + (h)) * HTB)
#define PG8_STAGE(bufoff, gbase, voff) do { _Pragma("unroll") for (int _i = 0; _i < 2; ++_i) \
    __builtin_amdgcn_global_load_lds((const unsigned*)((const char*)(gbase) + (voff)[_i]), (PG8_LAS unsigned*)(lds + (bufoff) + ldsw + _i * 8192), 16, 0, 0); } while (0)
#define PG8_LDA(dst, b, h) do { _Pragma("unroll") for (int m = 0; m < 4; ++m) _Pragma("unroll") for (int k = 0; k < 2; ++k) dst[m][k] = *(const PG8_LAS bf16x8*)(lds + PG8_SA(b, h) + aoff + m * 2048 + k * 1024); } while (0)
#define PG8_LDB(dst, b, h) do { _Pragma("unroll") for (int n = 0; n < 2; ++n) _Pragma("unroll") for (int k = 0; k < 2; ++k) dst[n][k] = *(const PG8_LAS bf16x8*)(lds + PG8_SB(b, h) + boff + n * 2048 + k * 1024); } while (0)
#define PG8_MMA(ai, bj, At, Bt) do { __builtin_amdgcn_s_setprio(1); _Pragma("unroll") for (int m = 0; m < 4; ++m) _Pragma("unroll") for (int n = 0; n < 2; ++n) _Pragma("unroll") for (int k = 0; k < 2; ++k) \
    acc[ai][bj][m][n] = __builtin_amdgcn_mfma_f32_16x16x32_bf16(Bt[n][k], At[m][k], acc[ai][bj][m][n], 0, 0, 0); __builtin_amdgcn_s_setprio(0); } while (0)
#define PG8_WAIT_V(n) asm volatile("s_waitcnt vmcnt(" #n ")" ::: "memory")
#define PG8_WAIT_L(n) asm volatile("s_waitcnt lgkmcnt(" #n ")" ::: "memory")
#define PG8_BAR __builtin_amdgcn_s_barrier()
#define PG8_SCHED __builtin_amdgcn_sched_barrier(0)
  Unit cur, nxt; int ui = 0;
  if (!S.next(0, cur)) return;
  f32x4 acc[2][2][4][2];
#pragma unroll
  for (int a = 0; a < 2; ++a)
#pragma unroll
    for (int b = 0; b < 2; ++b)
#pragma unroll
      for (int m = 0; m < 4; ++m)
#pragma unroll
        for (int n = 0; n < 2; ++n) acc[a][b][m][n] = (f32x4){0.f, 0.f, 0.f, 0.f};
  bf16x8 At[4][2], B0[2][2], B1[2][2];
  const char* cA = (const char*)cur.A + (size_t)cur.pm * tstep; const char* cB = (const char*)cur.Bt + (size_t)cur.pn * tstep;
  PG8_STAGE(PG8_SB(0, 0), cB, voffB); PG8_STAGE(PG8_SA(0, 0), cA, voffA); PG8_STAGE(PG8_SB(0, 1), cB + hstep, voffB); PG8_STAGE(PG8_SA(0, 1), cA + hstep, voffA);
  if (wr == 1) PG8_BAR;
  PG8_WAIT_V(4); PG8_BAR;
  PG8_STAGE(PG8_SB(1, 0), cB + kstep, voffB); PG8_STAGE(PG8_SA(1, 0), cA + kstep, voffA); PG8_STAGE(PG8_SB(1, 1), cB + hstep + kstep, voffB);
  PG8_WAIT_V(6); PG8_BAR;
  for (;;) {
    const bool has_next = S.next(ui + 1, nxt);
    const char* nA = has_next ? (const char*)nxt.A + (size_t)nxt.pm * tstep : cA; const char* nB = has_next ? (const char*)nxt.Bt + (size_t)nxt.pn * tstep : cB;
    for (int t = 0; t < nt; t += 2) {
      const bool last = (t == nt - 2);
      const char* a1 = cA + (size_t)(t + 1) * kstep;
      const char* a2 = last ? nA : cA + (size_t)(t + 2) * kstep; const char* b2 = last ? nB : cB + (size_t)(t + 2) * kstep;
      const char* a3 = a2 + kstep; const char* b3 = b2 + kstep;
      PG8_LDB(B0, 0, 0); PG8_SCHED; PG8_LDA(At, 0, 0); PG8_STAGE(PG8_SA(1, 1), a1 + hstep, voffA);
      PG8_WAIT_L(8); PG8_BAR; PG8_WAIT_L(0); PG8_MMA(0, 0, At, B0); PG8_BAR; PG8_SCHED;
      PG8_LDB(B1, 0, 1); PG8_STAGE(PG8_SB(0, 0), b2, voffB);
      PG8_BAR; PG8_WAIT_L(0); PG8_MMA(0, 1, At, B1); PG8_BAR;
      PG8_LDA(At, 0, 1); PG8_STAGE(PG8_SA(0, 0), a2, voffA);
      PG8_BAR; PG8_WAIT_L(0); PG8_MMA(1, 0, At, B0); PG8_BAR; PG8_SCHED;
      PG8_STAGE(PG8_SB(0, 1), b2 + hstep, voffB);
      PG8_WAIT_V(6); PG8_BAR; PG8_MMA(1, 1, At, B1); PG8_BAR;
      PG8_LDB(B0, 1, 0); PG8_SCHED; PG8_LDA(At, 1, 0); PG8_STAGE(PG8_SA(0, 1), a2 + hstep, voffA);
      PG8_WAIT_L(8); PG8_BAR; PG8_WAIT_L(0); PG8_MMA(0, 0, At, B0); PG8_BAR; PG8_SCHED;
      PG8_LDB(B1, 1, 1); PG8_STAGE(PG8_SB(1, 0), b3, voffB);
      PG8_BAR; PG8_WAIT_L(0); PG8_MMA(0, 1, At, B1); PG8_BAR;
      PG8_LDA(At, 1, 1); PG8_STAGE(PG8_SA(1, 0), a3, voffA);
      PG8_BAR; PG8_WAIT_L(0); PG8_MMA(1, 0, At, B0); PG8_BAR; PG8_SCHED;
      PG8_STAGE(PG8_SB(1, 1), b3 + hstep, voffB);
      PG8_WAIT_V(6); PG8_BAR; PG8_MMA(1, 1, At, B1); PG8_BAR;
    }
    if (!cur.keep) E(acc, cur, wr, wc, fr, fq);
    if (!has_next) break;
    if (!cur.keep) {
#pragma unroll
      for (int a = 0; a < 2; ++a)
#pragma unroll
        for (int b = 0; b < 2; ++b)
#pragma unroll
          for (int m = 0; m < 4; ++m)
#pragma unroll
            for (int n = 0; n < 2; ++n) acc[a][b][m][n] = (f32x4){0.f, 0.f, 0.f, 0.f};
    }
    cur = nxt; cA = nA; cB = nB; ++ui;
  }
  PG8_WAIT_V(0);
  if (wr == 0) PG8_BAR;
  PG8_BAR;
#undef PG8_SA
#undef PG8_SB
#undef PG8_STAGE
#undef PG8_LDA
#undef PG8_LDB
#undef PG8_MMA
#undef PG8_WAIT_V
#undef PG8_WAIT_L
#undef PG8_BAR
#undef PG8_SCHED
}

DEVI u4 pack8acc(f32x4 v0, f32x4 v1) { u4 o; o.x = cvt_pk_bf16(v0[0], v0[1]); o.y = cvt_pk_bf16(v0[2], v0[3]); o.z = cvt_pk_bf16(v1[0], v1[1]); o.w = cvt_pk_bf16(v1[2], v1[3]); return o; }
struct EpiProj {
  static constexpr bool PERM = true;
  u16* sec; u16* halo;
  DEVI void operator()(const f32x4 (&acc)[2][2][4][2], const Unit& u, int wr, int wc, int fr, int fq) const {
    const int s = u.pn >> 1, cb = (u.pn & 1) * 256 + wc * 32 + 8 * fq;
    u16* dst = sec + (size_t)s * SECE;
#pragma unroll
    for (int ai = 0; ai < 2; ++ai)
#pragma unroll
      for (int m = 0; m < 4; ++m) {
        const int row = u.pm * 256 + ai * 128 + wr * 64 + m * 16 + fr;
        const bool hl = (s < 3) && ((row & 63) >= 61);
#pragma unroll
        for (int bj = 0; bj < 2; ++bj) {
          const u4 o = pack8acc(acc[ai][bj][m][0], acc[ai][bj][m][1]);
          *(u4*)(dst + (size_t)row * 512 + cb + bj * 128) = o;
          if (hl) *(u4*)(halo + ((size_t)(row >> 6) * 3 + ((row & 63) - 61)) * 1536 + s * 512 + cb + bj * 128) = o;
        }
      }
  }
};
struct EpiGates {
  static constexpr bool PERM = true;
  u16* sec;
  DEVI void operator()(const f32x4 (&acc)[2][2][4][2], const Unit& u, int wr, int wc, int fr, int fq) const {
    const int cb = (u.pn & 1) * 256 + wc * 32 + 8 * fq;
    u16* dst = sec + (size_t)gate_sec(u.pn >> 1) * SECE;
#pragma unroll
    for (int ai = 0; ai < 2; ++ai)
#pragma unroll
      for (int m = 0; m < 4; ++m) {
        const int row = u.pm * 256 + ai * 128 + wr * 64 + m * 16 + fr;
#pragma unroll
        for (int bj = 0; bj < 2; ++bj) {
          f32x4 v0 = acc[ai][bj][m][0], v1 = acc[ai][bj][m][1];
#pragma unroll
          for (int e = 0; e < 4; ++e) { v0[e] = __builtin_amdgcn_rcpf(1.f + __expf(-v0[e])); v1[e] = __builtin_amdgcn_rcpf(1.f + __expf(-v1[e])); }
          *(u4*)(dst + (size_t)row * 512 + cb + bj * 128) = pack8acc(v0, v1);
        }
      }
  }
};
struct EpiMlp1 {
  static constexpr bool PERM = true;
  u16* hid; const float* rowss; const float* bias2;
  DEVI void operator()(const f32x4 (&acc)[2][2][4][2], const Unit& u, int wr, int wc, int fr, int fq) const {
    const int cb = u.pn * 256 + wc * 32 + 8 * fq;
    const int b = (u.pm * 256) >> 13;
    const int lane = fq * 16 + fr;
    float rs[2];
#pragma unroll
    for (int ai = 0; ai < 2; ++ai) {
      const float* rp = rowss + (size_t)(u.pm * 256 + ai * 128 + wr * 64 + lane) * 16;
      const f32x4 p0 = *(const f32x4*)rp, p1 = *(const f32x4*)(rp + 4), p2 = *(const f32x4*)(rp + 8), p3 = *(const f32x4*)(rp + 12);
      const float ssum = (p0[0] + p0[1] + p0[2] + p0[3]) + (p1[0] + p1[1] + p1[2] + p1[3]) + (p2[0] + p2[1] + p2[2] + p2[3]) + (p3[0] + p3[1] + p3[2] + p3[3]);
      rs[ai] = rsqrtf(ssum * (1.f / 1024.f) + 1e-6f);
    }
    f32x4 bv[2][2];
#pragma unroll
    for (int bj = 0; bj < 2; ++bj)
#pragma unroll
      for (int n = 0; n < 2; ++n) bv[bj][n] = *(const f32x4*)(bias2 + (size_t)b * 4096 + cb + bj * 128 + 4 * n);
#pragma unroll
    for (int ai = 0; ai < 2; ++ai)
#pragma unroll
      for (int m = 0; m < 4; ++m) {
        const int row = u.pm * 256 + ai * 128 + wr * 64 + m * 16 + fr;
        const float r = __shfl(rs[ai], m * 16 + fr);
#pragma unroll
        for (int bj = 0; bj < 2; ++bj) {
          f32x4 v0 = acc[ai][bj][m][0] * r + bv[bj][0], v1 = acc[ai][bj][m][1] * r + bv[bj][1];
#pragma unroll
          for (int e = 0; e < 4; ++e) { const float a = fmaxf(v0[e], 0.f), c = fmaxf(v1[e], 0.f); v0[e] = a * a; v1[e] = c * c; }
          *(u4*)(hid + (size_t)row * 4096 + cb + bj * 128) = pack8acc(v0, v1);
        }
      }
  }
};
struct EpiResidXs {
  static constexpr bool PERM = false;
  const float* xin; float* out; const float* gate; const float* sc2g; const float* sc2s; u16* xs; float* rowss;
  DEVI void operator()(const f32x4 (&acc)[2][2][4][2], const Unit& u, int wr, int wc, int fr, int fq) const {
    const int b = (u.pm * 256) >> 13;
    const int cb = u.pn * 256 + wc * 32 + 4 * fq;
    f32x4 gv[2][2], sc[2][2];
#pragma unroll
    for (int bj = 0; bj < 2; ++bj)
#pragma unroll
      for (int n = 0; n < 2; ++n) {
        gv[bj][n] = *(const f32x4*)(gate + (size_t)b * 6144 + cb + bj * 128 + n * 16);
        sc[bj][n] = *(const f32x4*)(sc2g + cb + bj * 128 + n * 16) * (*(const f32x4*)(sc2s + (size_t)b * 6144 + cb + bj * 128 + n * 16) + 1.f);
      }
#pragma unroll
    for (int am = 0; am < 8; ++am) {
      const int ai = am >> 2, m = am & 3;
      const int row = u.pm * 256 + ai * 128 + wr * 64 + m * 16 + fr;
      const size_t ro = (size_t)row * 1024 + cb;
      f32x4 xv[2][2];
#pragma unroll
      for (int bj = 0; bj < 2; ++bj)
#pragma unroll
        for (int n = 0; n < 2; ++n) xv[bj][n] = *(const f32x4*)(xin + ro + bj * 128 + n * 16);
      float ssq = 0.f;
#pragma unroll
      for (int bj = 0; bj < 2; ++bj)
#pragma unroll
        for (int n = 0; n < 2; ++n) {
          const f32x4 v = xv[bj][n] + gv[bj][n] * acc[ai][bj][m][n];
          *(f32x4*)(out + ro + bj * 128 + n * 16) = v;
          ssq += v[0] * v[0] + v[1] * v[1] + v[2] * v[2] + v[3] * v[3];
          const f32x4 w = v * sc[bj][n];
          u2 o; o.x = cvt_pk_bf16(w[0], w[1]); o.y = cvt_pk_bf16(w[2], w[3]);
          *(u2*)(xs + ro + bj * 128 + n * 16) = o;
        }
      ssq += __shfl_xor(ssq, 16); ssq += __shfl_xor(ssq, 32);
      if (fq == 0) rowss[(size_t)row * 16 + u.pn * 4 + wc] = ssq;
    }
  }
};
struct EpiResid {
  static constexpr bool PERM = false;
  const float* xin; float* out; const float* gate;
  DEVI void operator()(const f32x4 (&acc)[2][2][4][2], const Unit& u, int wr, int wc, int fr, int fq) const {
    const int b = (u.pm * 256) >> 13;
    const int cb = u.pn * 256 + wc * 32 + 4 * fq;
    f32x4 gv[2][2];
#pragma unroll
    for (int bj = 0; bj < 2; ++bj)
#pragma unroll
      for (int n = 0; n < 2; ++n) gv[bj][n] = *(const f32x4*)(gate + (size_t)b * 6144 + cb + bj * 128 + n * 16);
#pragma unroll
    for (int am = 0; am < 4; ++am) {
      const int ai = am >> 1, m0 = (am & 1) * 2;
      f32x4 xv[2][2][2];
#pragma unroll
      for (int mm = 0; mm < 2; ++mm) {
        const size_t ro = (size_t)(u.pm * 256 + ai * 128 + wr * 64 + (m0 + mm) * 16 + fr) * 1024 + cb;
#pragma unroll
        for (int bj = 0; bj < 2; ++bj)
#pragma unroll
          for (int n = 0; n < 2; ++n) xv[mm][bj][n] = *(const f32x4*)(xin + ro + bj * 128 + n * 16);
      }
#pragma unroll
      for (int mm = 0; mm < 2; ++mm) {
        const size_t ro = (size_t)(u.pm * 256 + ai * 128 + wr * 64 + (m0 + mm) * 16 + fr) * 1024 + cb;
#pragma unroll
        for (int bj = 0; bj < 2; ++bj)
#pragma unroll
          for (int n = 0; n < 2; ++n) *(f32x4*)(out + ro + bj * 128 + n * 16) = xv[mm][bj][n] + gv[bj][n] * acc[ai][bj][m0 + mm][n];
      }
    }
  }
};

struct HalfKOrder {
  StaticOrder base; size_t aPlane, bPlane;
  DEVI bool next(int i, Unit& u) const {
    if (!base.next(i >> 1, u)) return false;
    const int hf = i & 1;
    u.A += (size_t)hf * aPlane; u.Bt += (size_t)hf * bPlane; u.keep = hf == 0;
    return true;
  }
};
struct FusedOrder {
  int G, c; const u16 *y0, *y1, *Wbr, *hA, *Wg;
  static constexpr size_t aPlane = 8388608, bPlane = (size_t)9728 * 512;
  DEVI bool next(int i, Unit& u) const {
    const int tile = c + (i / 12) * G; if (tile >= 256) return false;
    const int sub = i % 12, b = sub / 3, r = sub % 3;
    u.pm = tile >> 2; u.pn = tile & 3;
    if (r < 2) { u.A = hA + (size_t)r * aPlane; u.Bt = Wg + (size_t)r * bPlane + (size_t)b * 1024 * 512; u.keep = r == 0; u.br = b * 2; }
    else {
      const u16* sb = y0; const u16* yb = y1;
      asm volatile("" : "+s"(sb)); asm volatile("" : "+s"(yb));
      const size_t so = b == 0 ? 0 : (b == 2 ? 2 * SECE : 7 * SECE);
      u.A = (b == 1) ? yb : sb + so;
      u.Bt = Wbr + (size_t)b * 1024 * 512; u.keep = 0; u.br = b * 2 + 1;
    }
    return true;
  }
};
struct EpiFused {
  static constexpr bool PERM = true;
  u16* scratch; u16* mg;
  DEVI void operator()(const f32x4 (&acc)[2][2][4][2], const Unit& u, int wr, int wc, int fr_, int fq_) const {
    int ln_ = fq_ * 16 + fr_; asm volatile("" : "+v"(ln_));
    const int fr = ln_ & 15, fq = ln_ >> 4;
    const int tid = (wr * 4 + wc) * 64 + fq * 16 + fr;
    u16* sp = scratch + (size_t)blockIdx.x * 65536 + tid * 8;
    if ((u.br & 1) == 0) {
#pragma unroll
      for (int ai = 0; ai < 2; ++ai)
#pragma unroll
        for (int m = 0; m < 4; ++m)
#pragma unroll
          for (int bj = 0; bj < 2; ++bj) {
            f32x4 v0 = acc[ai][bj][m][0], v1 = acc[ai][bj][m][1];
#pragma unroll
            for (int e2 = 0; e2 < 4; ++e2) { v0[e2] = sigmf(v0[e2]); v1[e2] = sigmf(v1[e2]); }
            *(u4*)(sp + ((ai * 4 + m) * 2 + bj) * 4096) = pack8acc(v0, v1);
          }
    } else {
      const int cg0 = u.pn * 256 + wc * 32 + 8 * fq;
      const bool first = (u.br >> 1) == 0;
#pragma unroll
      for (int am = 0; am < 4; ++am) {
        const int ai = am >> 1, m0 = (am & 1) * 2;
        u4 gq[2][2], hq[2][2];
#pragma unroll
        for (int mm = 0; mm < 2; ++mm) {
          const size_t ro = (size_t)(u.pm * 256 + ai * 128 + wr * 64 + (m0 + mm) * 16 + fr) * 1024 + cg0;
#pragma unroll
          for (int bj = 0; bj < 2; ++bj) {
            gq[mm][bj] = *(const u4*)(sp + ((ai * 4 + m0 + mm) * 2 + bj) * 4096);
            hq[mm][bj] = u4{0, 0, 0, 0};
            if (!first) hq[mm][bj] = *(const u4*)(mg + ro + bj * 128);
          }
        }
#pragma unroll
        for (int mm = 0; mm < 2; ++mm) {
          const int m = m0 + mm;
          const size_t ro = (size_t)(u.pm * 256 + ai * 128 + wr * 64 + m * 16 + fr) * 1024 + cg0;
#pragma unroll
          for (int bj = 0; bj < 2; ++bj) {
            float gv[8], hv[8];
            unpack8(gq[mm][bj], gv); unpack8(hq[mm][bj], hv);
            f32x4 v0 = acc[ai][bj][m][0], v1 = acc[ai][bj][m][1];
#pragma unroll
            for (int e2 = 0; e2 < 4; ++e2) { v0[e2] = hv[e2] + gv[e2] * v0[e2]; v1[e2] = hv[4 + e2] + gv[4 + e2] * v1[e2]; }
            *(u4*)(mg + ro + bj * 128) = pack8acc(v0, v1);
          }
        }
      }
    }
  }
};
struct MergeOrder {
  int G, c; const u16* yA[4]; const u16* Wbr;
  DEVI bool next(int i, Unit& u) const {
    const int tile = c + (i >> 2) * G; if (tile >= 256) return false;
    const int b = i & 3;
    u.pm = tile >> 2; u.pn = tile & 3; u.br = b; u.keep = 0;
    u.A = b == 0 ? yA[0] : (b == 1 ? yA[1] : (b == 2 ? yA[2] : yA[3]));
    u.Bt = Wbr + (size_t)b * 1024 * 512;
    return true;
  }
};
struct EpiMerge {
  static constexpr bool PERM = true;
  const u16* sec; u16* hb;
  DEVI void operator()(const f32x4 (&acc)[2][2][4][2], const Unit& u, int wr, int wc, int fr, int fq) const {
    const int cg0 = u.pn * 256 + wc * 32 + 8 * fq;
    const u16* gs = sec + (size_t)gate_sec(u.br * 2 + (cg0 >> 9)) * SECE + (cg0 & 511);
    const bool first = (u.br == 0);
#pragma unroll
    for (int am = 0; am < 4; ++am) {
      const int ai = am >> 1, m0 = (am & 1) * 2;
      u4 gq[2][2], hq[2][2];
#pragma unroll
      for (int mm = 0; mm < 2; ++mm) {
        const int row = u.pm * 256 + ai * 128 + wr * 64 + (m0 + mm) * 16 + fr;
#pragma unroll
        for (int bj = 0; bj < 2; ++bj) {
          gq[mm][bj] = *(const u4*)(gs + (size_t)row * 512 + bj * 128);
          hq[mm][bj] = u4{0, 0, 0, 0};
          if (!first) hq[mm][bj] = *(const u4*)(hb + (size_t)row * 1024 + cg0 + bj * 128);
        }
      }
#pragma unroll
      for (int mm = 0; mm < 2; ++mm) {
        const int m = m0 + mm;
        const int row = u.pm * 256 + ai * 128 + wr * 64 + m * 16 + fr;
#pragma unroll
        for (int bj = 0; bj < 2; ++bj) {
          float gv[8], hv[8];
          unpack8(gq[mm][bj], gv); unpack8(hq[mm][bj], hv);
          f32x4 v0 = acc[ai][bj][m][0], v1 = acc[ai][bj][m][1];
#pragma unroll
          for (int e = 0; e < 4; ++e) { v0[e] = hv[e] + gv[e] * v0[e]; v1[e] = hv[4 + e] + gv[4 + e] * v1[e]; }
          *(u4*)(hb + (size_t)row * 1024 + cg0 + bj * 128) = pack8acc(v0, v1);
        }
      }
    }
  }
};
}

DEVI void proj_phase(const P& p, unsigned char* smem) {
  pg8::HalfKOrder S; S.base.init(16384, 5632, gridDim.x, blockIdx.x, p.h, p.WinT); S.aPlane = 8388608; S.bPlane = (size_t)9728 * 512;
  const pg8::Gemm g{p.h, p.WinT, 16384, 5632, 512};
  const pg8::EpiProj E{p.sec, p.halo};
  pg8::gemm_phase((PG8_LAS unsigned char*)smem, g, S, E);
}
DEVI void gates_phase(const P& p, unsigned char* smem) {
  pg8::StaticOrder S; S.init(16384, 4096, gridDim.x, blockIdx.x, p.h, p.WinT + (size_t)5632 * 1024);
  const pg8::Gemm g{p.h, p.WinT + (size_t)5632 * 1024, 16384, 4096, 1024};
  const pg8::EpiGates E{p.sec};
  pg8::gemm_phase((PG8_LAS unsigned char*)smem, g, S, E);
}
DEVI void merge_phase(const P& p, unsigned char* smem) {
  pg8::FusedOrder S;
  S.G = gridDim.x; S.c = blockIdx.x; S.y0 = p.sec + 3 * SECE; S.y1 = p.YB; S.Wbr = p.WbrT;
  S.hA = p.h; S.Wg = p.WinT + (size_t)5632 * 512;
  const pg8::Gemm g{p.YB, p.WbrT, 16384, 1024, 512};
  const pg8::EpiFused E{p.sec + 6 * SECE, p.sec};
  pg8::gemm_phase((PG8_LAS unsigned char*)smem, g, S, E);
}
DEVI void resid_gemm_phase(const P& p, int l, int which, unsigned char* smem) {
  pg8::StaticOrder S; S.init(16384, 1024, gridDim.x, blockIdx.x, p.sec, which == 0 ? p.WoutT : p.W2T);
  const pg8::Gemm g{p.sec, which == 0 ? p.WoutT : p.W2T, 16384, 1024, which == 0 ? 1024 : 4096};
  const float* modl = p.modp + (size_t)l * 2 * 6144;
  if (which == 0) {
    const pg8::EpiResidXs E{l == 0 ? p.x : p.out, p.out, modl + 2 * 1024, p.norm2_g + l * 1024, modl + 4 * 1024, p.sec + 8 * SECE, p.rowss};
    pg8::gemm_phase((PG8_LAS unsigned char*)smem, g, S, E);
  } else {
    const pg8::EpiResid E{p.out, p.out, modl + 5 * 1024};
    pg8::gemm_phase((PG8_LAS unsigned char*)smem, g, S, E);
  }
}
DEVI void mlp1_phase(const P& p, unsigned char* smem) {
  pg8::StaticOrder S; S.init(16384, 4096, gridDim.x, blockIdx.x, p.sec + 8 * SECE, p.W1T);
  const pg8::Gemm g{p.sec + 8 * SECE, p.W1T, 16384, 4096, 1024};
  const pg8::EpiMlp1 E{p.sec, p.rowss, p.modp + 32768};
  pg8::gemm_phase((PG8_LAS unsigned char*)smem, g, S, E);
}
DEVI void bias2_unit(const P& p, int l, int u) {
  const int t = tid_l(), lane = t & 63, wid = t >> 6;
  float sh0[16], sh1[16];
#pragma unroll
  for (int j = 0; j < 16; ++j) { sh0[j] = modval(p, l, 0, 3 * 1024 + lane * 16 + j); sh1[j] = modval(p, l, 1, 3 * 1024 + lane * 16 + j); }
#pragma unroll 1
  for (int c = 0; c < 8; ++c) {
    const int n = u * 64 + wid * 8 + c;
    float w[16];
    const u16* wp = p.W1T + (size_t)n * 1024 + lane * 16;
    unpack8(*(const u4*)wp, w); unpack8(*(const u4*)(wp + 8), w + 8);
    float a0 = 0.f, a1 = 0.f;
#pragma unroll
    for (int j = 0; j < 16; ++j) { a0 += sh0[j] * w[j]; a1 += sh1[j] * w[j]; }
    a0 = wave_sum(a0); a1 = wave_sum(a1);
    if (lane == 0) { p.modp[32768 + n] = a0; p.modp[32768 + 4096 + n] = a1; }
  }
}

DEVI bf16x8 acc2frag(f32x4 t0, f32x4 t1, float sgn) {
  u4 o; o.x = pack2(sgn * t0[0], sgn * t0[1]); o.y = pack2(sgn * t0[2], sgn * t0[3]); o.z = pack2(sgn * t1[0], sgn * t1[1]); o.w = pack2(sgn * t1[2], sgn * t1[3]);
  return *(bf16x8*)&o;
}
DEVI void dn_prep_unit(const P& p, int l, int u, unsigned char* smem) {
  const int t = tid_l(), lane = t & 63, wid = t >> 6, mr = lane & 15, g = lane >> 4;
  const int h = u & 3, n = (u >> 2) & 127, b = u >> 9;
  const int r0 = b * SEQ + n * 64;
  float* Lm = (float*)smem;
  float* cw = Lm + 64 * 64;
  float* gcs = cw + 1536;
  u16* Qs = (u16*)(gcs + 128);
  u16* Ks = Qs + 64 * 136;
  u16* KTl = Ks + 64 * 136;
  u16* VTl = KTl + 128 * 72;
  u16* TB = VTl + 128 * 72;
  u16* TBe = TB + 64 * 72;
  float* bs = gcs + 64;
  for (int i = t; i < 1536; i += NT) {
    const int s = i >> 9, j = (i >> 7) & 3, c = i & 127;
    cw[i] = p.dn_conv_w[(size_t)(l * 4 + j) * 1536 + s * 512 + h * 128 + c];
  }
  if (wid == 0) {
    float gg = p.glog[(size_t)(r0 + lane) * 4 + h];
#pragma unroll
    for (int o = 1; o < 64; o <<= 1) {
      const float v = __shfl_up(gg, o);
      if (lane >= o) gg += v;
    }
    gcs[lane] = gg;
    bs[lane] = p.beta[(size_t)(r0 + lane) * 4 + h];
  }
  __syncthreads();
  const int row = t >> 3, c0 = (t & 7) * 16;
#pragma unroll
  for (int s = 0; s < 3; ++s) {
    const u16* sp = p.sec + (size_t)s * SECE;
    float y[16];
#pragma unroll
    for (int c = 0; c < 16; ++c) y[c] = 0.f;
#pragma unroll
    for (int j = 0; j < 4; ++j) {
      const int tt = row - 3 + j;
      u4 v0 = {0, 0, 0, 0}, v1 = {0, 0, 0, 0};
      if (tt >= 0) {
        const u16* src = sp + (size_t)(r0 + tt) * 512 + h * 128 + c0;
        v0 = *(const u4*)src; v1 = *(const u4*)(src + 8);
      } else if (n > 0) {
        const u16* src = p.halo + ((size_t)((r0 >> 6) - 1) * 3 + (tt + 3)) * 1536 + s * 512 + h * 128 + c0;
        v0 = *(const u4*)src; v1 = *(const u4*)(src + 8);
      }
      float f[16];
      unpack8(v0, f); unpack8(v1, f + 8);
#pragma unroll
      for (int c = 0; c < 16; ++c) y[c] += cw[(s * 4 + j) * 128 + c0 + c] * f[c];
    }
    float ss = 0.f;
#pragma unroll
    for (int c = 0; c < 16; ++c) { y[c] = siluf(y[c]); ss += y[c] * y[c]; }
    if (s < 2) {
      ss += __shfl_xor(ss, 1); ss += __shfl_xor(ss, 2); ss += __shfl_xor(ss, 4);
      const float sc = rsqrtf(ss + 1e-6f) * (s == 0 ? 0.08838834764831845f : 1.f);
#pragma unroll
      for (int c = 0; c < 16; ++c) y[c] *= sc;
    }
    if (s < 2) {
      u16* dl = (s == 0 ? Qs : Ks) + row * 136 + c0;
      *(u4*)dl = pack8(y); *(u4*)(dl + 8) = pack8(y + 8);
    }
    if (s >= 1) {
      u16* dT = (s == 1 ? KTl : VTl);
#pragma unroll
      for (int c = 0; c < 16; ++c) dT[(c0 + c) * 72 + row] = f2bf(y[c]);
    }
  }
  __syncthreads();
#pragma unroll 1
  for (int idx = wid; idx < 10; idx += 8) {
    const int ti = idx >= 6 ? 3 : (idx >= 3 ? 2 : (idx >= 1 ? 1 : 0)), tj = idx - ti * (ti + 1) / 2;
    f32x4 akk = {0.f, 0.f, 0.f, 0.f};
#pragma unroll
    for (int k0 = 0; k0 < 128; k0 += 32) akk = mfma16(frag(Ks, 136, ti * 16, k0, lane), frag(Ks, 136, tj * 16, k0, lane), akk);
    const int j = tj * 16 + mr;
#pragma unroll
    for (int r = 0; r < 4; ++r) {
      const int i = ti * 16 + g * 4 + r;
      Lm[i * 64 + j] = (i > j) ? bs[i] * akk[r] * __expf(gcs[i] - gcs[j]) : 0.f;
    }
  }
  if (wid < 6) {
    const int m = wid < 2 ? wid : (wid < 4 ? 2 : 3), ks2 = wid < 2 ? 0 : ((wid - 2) & 1);
    f32x4 t0 = {0.f, 0.f, 0.f, 0.f}, t1 = {0.f, 0.f, 0.f, 0.f};
#pragma unroll
    for (int k0 = 0; k0 < 128; k0 += 32) {
      const bf16x8 bq = frag(Qs, 136, m * 16, k0, lane);
      t0 = mfma16(frag(Ks, 136, (2 * ks2) * 16, k0, lane), bq, t0);
      t1 = mfma16(frag(Ks, 136, (2 * ks2 + 1) * 16, k0, lane), bq, t1);
    }
    const int i = m * 16 + mr;
    const float gi = gcs[i];
#pragma unroll
    for (int r = 0; r < 4; ++r) {
      const int j0 = 32 * ks2 + 4 * g + r, j1 = j0 + 16;
      t0[r] = (i >= j0) ? t0[r] * __expf(gi - gcs[j0]) : 0.f;
      t1[r] = (i >= j1) ? t1[r] * __expf(gi - gcs[j1]) : 0.f;
    }
    *(bf16x8*)(p.QKF + (size_t)u * 3072 + wid * 512 + lane * 8) = acc2frag(t0, t1, 1.f);
  }
  __syncthreads();
  {
    typedef float f32x16 __attribute__((ext_vector_type(16)));
    float* Tf = (float*)(TBe + 64 * 72);
    float* Xf = Tf + 2048;
    if (wid < 2 && lane < 32) {
      const int o = wid * 32;
      float T[32];
#pragma unroll
      for (int i = 0; i < 32; ++i) {
        float sv = (i == lane) ? 1.f : 0.f;
#pragma unroll
        for (int j = 0; j < i; ++j) sv -= Lm[(o + i) * 64 + o + j] * T[j];
        T[i] = sv;
      }
#pragma unroll
      for (int i = 0; i < 32; ++i) Tf[wid * 1024 + i * 32 + lane] = T[i];
    }
    __syncthreads();
    if (wid == 0) {
      const int li = lane & 31, lh = lane >> 5;
      f32x16 acc;
#pragma unroll
      for (int r = 0; r < 16; ++r) acc[r] = 0.f;
#pragma unroll
      for (int kk = 0; kk < 16; ++kk)
        acc = __builtin_amdgcn_mfma_f32_32x32x2f32(Lm[(32 + li) * 64 + 2 * kk + lh], Tf[(2 * kk + lh) * 32 + li], acc, 0, 0, 0);
#pragma unroll
      for (int r = 0; r < 16; ++r) Xf[((r & 3) + 8 * (r >> 2) + 4 * lh) * 32 + li] = acc[r];
      asm volatile("s_waitcnt lgkmcnt(0)" ::: "memory");
      f32x16 acc2;
#pragma unroll
      for (int r = 0; r < 16; ++r) acc2[r] = 0.f;
#pragma unroll
      for (int kk = 0; kk < 16; ++kk)
        acc2 = __builtin_amdgcn_mfma_f32_32x32x2f32(Tf[1024 + li * 32 + 2 * kk + lh], Xf[(2 * kk + lh) * 32 + li], acc2, 0, 0, 0);
#pragma unroll
      for (int r = 0; r < 16; ++r) Lm[(32 + (r & 3) + 8 * (r >> 2) + 4 * lh) * 64 + li] = -acc2[r];
    }
    __syncthreads();
#pragma unroll
    for (int q = 0; q < 8; ++q) {
      const int idx = t + q * NT, i = idx >> 6, j = idx & 63;
      float val = 0.f;
      if (i < 32) { if (j < 32) val = Tf[i * 32 + j]; }
      else if (j >= 32) val = Tf[1024 + (i - 32) * 32 + (j - 32)];
      else val = Lm[i * 64 + j];
      const float bl = bs[j];
      TB[i * 72 + j] = f2bf(val * bl);
      TBe[i * 72 + j] = f2bf(val * bl * __expf(gcs[j]));
    }
  }
  __syncthreads();
  const size_t rbase = (size_t)r0 * 512 + h * 128;
  u16* secQ = p.sec + rbase;
  u16* secW = p.sec + SECE + rbase;
  u16* secK = p.sec + 2 * SECE + rbase;
  const size_t fo = (size_t)(lane >> 4) * 512 + (lane & 15) * 8;
#pragma unroll
  for (int rep = 0; rep < 2; ++rep) {
    const int f = wid + rep * 8;
    {
      const int m = f >> 2, ks = f & 3;
      f32x4 t0 = {0.f, 0.f, 0.f, 0.f}, t1 = {0.f, 0.f, 0.f, 0.f};
#pragma unroll
      for (int k0 = 0; k0 < 64; k0 += 32) {
        const bf16x8 bt = frag(TBe, 72, m * 16, k0, lane);
        t0 = mfma16(frag(KTl, 72, (2 * ks) * 16, k0, lane), bt, t0);
        t1 = mfma16(frag(KTl, 72, (2 * ks + 1) * 16, k0, lane), bt, t1);
      }
      *(bf16x8*)(secW + (size_t)(4 * f) * 512 + fo) = acc2frag(t0, t1, -1.f);
    }
    {
      const int m = f >> 2, ks = f & 3, pos = m * 16 + mr;
      const float eg = __expf(gcs[pos]);
      const u2 a = *(const u2*)(Qs + pos * 136 + 32 * ks + 4 * g), c = *(const u2*)(Qs + pos * 136 + 32 * ks + 16 + 4 * g);
      u4 o;
      o.x = pack2(eg * lo2f(a.x), eg * hi2f(a.x)); o.y = pack2(eg * lo2f(a.y), eg * hi2f(a.y));
      o.z = pack2(eg * lo2f(c.x), eg * hi2f(c.x)); o.w = pack2(eg * lo2f(c.y), eg * hi2f(c.y));
      *(u4*)(secQ + (size_t)(4 * f) * 512 + fo) = o;
    }
    {
      const int d = f >> 1, ks2 = f & 1, dk = d * 16 + mr;
      const float G = gcs[63];
      const u2 a = *(const u2*)(KTl + dk * 72 + 32 * ks2 + 4 * g), c = *(const u2*)(KTl + dk * 72 + 32 * ks2 + 16 + 4 * g);
      const int p0 = 32 * ks2 + 4 * g, p1 = p0 + 16;
      u4 o;
      o.x = pack2(__expf(G - gcs[p0]) * lo2f(a.x), __expf(G - gcs[p0 + 1]) * hi2f(a.x));
      o.y = pack2(__expf(G - gcs[p0 + 2]) * lo2f(a.y), __expf(G - gcs[p0 + 3]) * hi2f(a.y));
      o.z = pack2(__expf(G - gcs[p1]) * lo2f(c.x), __expf(G - gcs[p1 + 1]) * hi2f(c.x));
      o.w = pack2(__expf(G - gcs[p1 + 2]) * lo2f(c.y), __expf(G - gcs[p1 + 3]) * hi2f(c.y));
      *(u4*)(secK + (size_t)(4 * f) * 512 + fo) = o;
    }
  }
  {
    u16* ud = p.TQ + (size_t)u * 8192 + wid * 1024 + lane * 16;
#pragma unroll
    for (int m = 0; m < 4; ++m) {
      f32x4 a = {0.f, 0.f, 0.f, 0.f};
#pragma unroll
      for (int k0 = 0; k0 < 64; k0 += 32) a = mfma16(frag(TB, 72, m * 16, k0, lane), frag(VTl, 72, wid * 16, k0, lane), a);
      *(u2*)(ud + m * 4) = pack4v(a);
    }
  }
  if (t == 0) p.EG[u] = __expf(gcs[63]);
  __syncthreads();
}

DEVI void dn_chain(const P& p, int l, int bh, int half, unsigned char* smem) {
  constexpr int NQ = 1;
  const int t = tid_l(), lane = t & 63, wid = __builtin_amdgcn_readfirstlane(t >> 6);
  const int h = bh & 3, b = bh >> 2;
  typedef __attribute__((address_space(3))) unsigned char* LP_;
  LP_ lds = (LP_)smem;
  constexpr int BUFB = 55296;
  const size_t lo = (size_t)(lane >> 4) * 512 + (lane & 15) * 8;
  auto issue = [&](int n, int bi) __attribute__((always_inline)) {
    if (wid >= 4) {
      const int w4 = wid - 4;
      const size_t rbase = ((size_t)b * SEQ + (size_t)n * 64) * 512 + h * 128;
      const size_t unit = ((size_t)b * 128 + n) * 4 + h;
#pragma unroll
      for (int rep = 0; rep < 4; ++rep) {
        const int f = w4 + rep * 4;
        const size_t go = rbase + (size_t)(4 * f) * 512 + lo;
        __builtin_amdgcn_global_load_lds((const unsigned*)(p.sec + SECE + go), (__attribute__((address_space(3))) unsigned*)(lds + bi * BUFB + f * 1024), 16, 0, 0);
        __builtin_amdgcn_global_load_lds((const unsigned*)(p.sec + go), (__attribute__((address_space(3))) unsigned*)(lds + bi * BUFB + 16384 + f * 1024), 16, 0, 0);
        __builtin_amdgcn_global_load_lds((const unsigned*)(p.sec + 2 * SECE + go), (__attribute__((address_space(3))) unsigned*)(lds + bi * BUFB + 32768 + f * 1024), 16, 0, 0);
      }
#pragma unroll
      for (int rep = 0; rep < 2; ++rep) {
        const int f = w4 + rep * 4;
        if (f < 6)
          __builtin_amdgcn_global_load_lds((const unsigned*)(p.QKF + unit * 3072 + f * 512 + lane * 8), (__attribute__((address_space(3))) unsigned*)(lds + bi * BUFB + 49152 + f * 1024), 16, 0, 0);
      }
    }
  };
  const bool cw_ = wid < 4;
  f32x4 Sacc[2][8];
#pragma unroll
  for (int q = 0; q < NQ; ++q)
#pragma unroll
    for (int j = 0; j < 8; ++j) Sacc[q][j] = f32x4{0.f, 0.f, 0.f, 0.f};
  u4 ur[2][2];
  u4 op[2][2];
  float eGn;
  {
    const size_t unit = ((size_t)b * 128) * 4 + h;
    issue(0, 0);
    if (cw_) {
#pragma unroll
      for (int q = 0; q < NQ; ++q) {
        const u16* us = p.TQ + unit * 8192 + (half * 4 + wid * NQ + q) * 1024 + lane * 16;
        ur[q][0] = *(const u4*)us; ur[q][1] = *(const u4*)(us + 8);
      }
    }
    eGn = p.EG[unit];
  }
#pragma unroll 1
  for (int n = 0; n < 128; ++n) {
    asm volatile("s_waitcnt vmcnt(0)" ::: "memory");
    __syncthreads();
    if (t == 256 && (n & 3) == 0) {
      __builtin_amdgcn_fence(__ATOMIC_RELEASE, "agent");
      asm volatile("s_waitcnt vmcnt(0)" ::: "memory");
      __hip_atomic_store(p.prog + (bh * 2 + half) * 16, (unsigned)(n > 0 ? n - 1 : 0), __ATOMIC_RELAXED, __HIP_MEMORY_SCOPE_AGENT);
    }
    if (cw_ && n > 0) {
      const size_t pu = ((size_t)b * 128 + (n - 1)) * 4 + h;
#pragma unroll
      for (int q = 0; q < NQ; ++q) {
        u16* od = p.TQ + pu * 8192 + (half * 4 + wid * NQ + q) * 1024 + lane * 16;
        *(u4*)od = op[q][0]; *(u4*)(od + 8) = op[q][1];
      }
    }
    u4 uc[2][2];
#pragma unroll
    for (int q = 0; q < NQ; ++q) { uc[q][0] = ur[q][0]; uc[q][1] = ur[q][1]; }
    const float eG = eGn;
    const size_t unit = ((size_t)b * 128 + n) * 4 + h;
    if (n + 1 < 128) {
      issue(n + 1, (n + 1) & 1);
      if (cw_) {
#pragma unroll
        for (int q = 0; q < NQ; ++q) {
          const u16* us = p.TQ + (unit + 4) * 8192 + (half * 4 + wid * NQ + q) * 1024 + lane * 16;
          ur[q][0] = *(const u4*)us; ur[q][1] = *(const u4*)(us + 8);
        }
      }
      eGn = p.EG[unit + 4];
    }
    if (cw_) {
      const __attribute__((address_space(3))) unsigned char* bb = lds + (n & 1) * BUFB + lane * 16;
#define LFRAG(off) (*(const __attribute__((address_space(3))) bf16x8*)(bb + (off)))
      bf16x8 Sb[2][4];
#pragma unroll
      for (int q = 0; q < NQ; ++q)
#pragma unroll
        for (int ks = 0; ks < 4; ++ks) Sb[q][ks] = acc2frag(Sacc[q][2 * ks], Sacc[q][2 * ks + 1], 1.f);
      f32x4 accV[2][4], accO[2][4];
#pragma unroll
      for (int q = 0; q < NQ; ++q) {
        accV[q][0] = f32x4{lo2f(uc[q][0].x), hi2f(uc[q][0].x), lo2f(uc[q][0].y), hi2f(uc[q][0].y)};
        accV[q][1] = f32x4{lo2f(uc[q][0].z), hi2f(uc[q][0].z), lo2f(uc[q][0].w), hi2f(uc[q][0].w)};
        accV[q][2] = f32x4{lo2f(uc[q][1].x), hi2f(uc[q][1].x), lo2f(uc[q][1].y), hi2f(uc[q][1].y)};
        accV[q][3] = f32x4{lo2f(uc[q][1].z), hi2f(uc[q][1].z), lo2f(uc[q][1].w), hi2f(uc[q][1].w)};
#pragma unroll
        for (int m = 0; m < 4; ++m) accO[q][m] = f32x4{0.f, 0.f, 0.f, 0.f};
      }
      constexpr int RING = 24;
      bf16x8 R[RING];
      bf16x8 Vb[2][2];
#define FOFF(i) ((i) < 16 ? (((i) & 3) * 4 + ((i) >> 2)) * 1024 : (i) < 32 ? 16384 + ((((i) - 16) & 3) * 4 + (((i) - 16) >> 2)) * 1024 : (i) < 38 ? 49152 + ((i) - 32) * 1024 : 32768 + ((i) - 38) * 1024)
#pragma unroll
      for (int i = 0; i < RING; ++i) R[i] = LFRAG(FOFF(i));
#pragma unroll
      for (int i = 0; i < 54; ++i) {
        const bf16x8 fr = R[i % RING];
        if (i < 16) {
          const int ks = i >> 2, m = i & 3;
#pragma unroll
          for (int q = 0; q < NQ; ++q) accV[q][m] = mfma16(fr, Sb[q][ks], accV[q][m]);
        } else if (i < 32) {
          const int ks = (i - 16) >> 2, m = (i - 16) & 3;
#pragma unroll
          for (int q = 0; q < NQ; ++q) accO[q][m] = mfma16(fr, Sb[q][ks], accO[q][m]);
        } else if (i < 38) {
          const int f = i - 32;
          const int m = f < 2 ? f : (f < 4 ? 2 : 3), k2 = f < 2 ? 0 : ((f - 2) & 1);
#pragma unroll
          for (int q = 0; q < NQ; ++q) accO[q][m] = mfma16(fr, Vb[q][k2], accO[q][m]);
        } else {
          const int j = i - 38, d = j >> 1, k2 = j & 1;
#pragma unroll
          for (int q = 0; q < NQ; ++q) {
            if (k2 == 0) Sacc[q][d] *= eG;
            Sacc[q][d] = mfma16(fr, Vb[q][k2], Sacc[q][d]);
          }
        }
        if (i == 15) {
#pragma unroll
          for (int q = 0; q < NQ; ++q) { Vb[q][0] = acc2frag(accV[q][0], accV[q][1], 1.f); Vb[q][1] = acc2frag(accV[q][2], accV[q][3], 1.f); }
        }
        if (i + RING < 54) R[i % RING] = LFRAG(FOFF(i + RING));
        __builtin_amdgcn_sched_barrier(0);
      }
#undef FOFF
#undef LFRAG
#pragma unroll
      for (int q = 0; q < NQ; ++q) {
        u4 o0, o1;
        o0.x = pack2(accO[q][0][0], accO[q][0][1]); o0.y = pack2(accO[q][0][2], accO[q][0][3]); o0.z = pack2(accO[q][1][0], accO[q][1][1]); o0.w = pack2(accO[q][1][2], accO[q][1][3]);
        o1.x = pack2(accO[q][2][0], accO[q][2][1]); o1.y = pack2(accO[q][2][2], accO[q][2][3]); o1.z = pack2(accO[q][3][0], accO[q][3][1]); o1.w = pack2(accO[q][3][2], accO[q][3][3]);
        op[q][0] = o0; op[q][1] = o1;
      }
    }
  }
  if (cw_) {
    const size_t pu = ((size_t)b * 128 + 127) * 4 + h;
#pragma unroll
    for (int q = 0; q < NQ; ++q) {
      u16* od = p.TQ + pu * 8192 + (half * 4 + wid * NQ + q) * 1024 + lane * 16;
      *(u4*)od = op[q][0]; *(u4*)(od + 8) = op[q][1];
    }
  }
  asm volatile("s_waitcnt vmcnt(0)" ::: "memory");
  __syncthreads();
  if (t == 256) {
    __builtin_amdgcn_fence(__ATOMIC_RELEASE, "agent");
    asm volatile("s_waitcnt vmcnt(0)" ::: "memory");
    __hip_atomic_store(p.prog + (bh * 2 + half) * 16, 128u, __ATOMIC_RELAXED, __HIP_MEMORY_SCOPE_AGENT);
  }
  __syncthreads();
}

DEVI void dn_chain_helper(const P& p, int bh, unsigned char* smem) {
  const int t = tid_l();
  const int h = bh & 3, b = bh >> 2;
  unsigned acc = 0;
#pragma unroll 1
  for (int n = 1; n < 128; ++n) {
    if (t == 0) {
      unsigned polls = 0;
      while ((int)__hip_atomic_load(p.prog + (bh * 2) * 16, __ATOMIC_RELAXED, __HIP_MEMORY_SCOPE_AGENT) + 4 < n && polls < 200000u) { __builtin_amdgcn_s_sleep(4); ++polls; }
    }
    __syncthreads();
    const size_t r0 = (size_t)b * SEQ + (size_t)n * 64;
    const size_t unit = ((size_t)b * 128 + n) * 4 + h;
    const size_t ro = (r0 + (t >> 3)) * 512 + h * 128 + (t & 7) * 16;
#pragma unroll
    for (int s3 = 0; s3 < 3; ++s3) {
      const u4 a = *(const u4*)(p.sec + (size_t)s3 * SECE + ro), c = *(const u4*)(p.sec + (size_t)s3 * SECE + ro + 8);
      acc ^= a.x ^ a.y ^ a.z ^ a.w ^ c.x ^ c.y ^ c.z ^ c.w;
    }
    {
      const u4 a = *(const u4*)(p.TQ + unit * 8192 + (size_t)t * 16), c = *(const u4*)(p.TQ + unit * 8192 + (size_t)t * 16 + 8);
      acc ^= a.x ^ a.y ^ a.z ^ a.w ^ c.x ^ c.y ^ c.z ^ c.w;
      if (t < 384) { const u4 q = *(const u4*)(p.QKF + unit * 3072 + (size_t)t * 8); acc ^= q.x ^ q.y ^ q.z ^ q.w; }
    }
  }
  if (acc == 0x9e3779b9u) p.prog[1024 - 1] = acc;
  __syncthreads();
}

DEVI void ya_unit(const P& p, int l, int u, unsigned char* smem) {
  const int t = tid_l(), lane = t & 63, wid = t >> 6, c = lane & 15, g = lane >> 4;
  const int h = u & 3, n = (u >> 2) & 127, b = u >> 9;
  const int r0 = b * SEQ + n * 64;
  float* part = (float*)smem;
  const u16* os = p.TQ + (size_t)u * 8192 + wid * 1024 + lane * 16;
  float o[16];
  unpack8(*(const u4*)os, o); unpack8(*(const u4*)(os + 8), o + 8);
#pragma unroll
  for (int i = 0; i < 16; ++i) {
    float s = o[i] * o[i];
    s += __shfl_xor(s, 1); s += __shfl_xor(s, 2); s += __shfl_xor(s, 4); s += __shfl_xor(s, 8);
    if (c == 0) part[wid * 64 + (i >> 2) * 16 + g * 4 + (i & 3)] = s;
  }
  __syncthreads();
  const int dv = wid * 16 + c;
  const float ng = p.dn_norm_g[l * 128 + dv];
  u16* zs = p.sec + 3 * SECE + (size_t)r0 * 512 + h * 128 + dv;
  u16 zv[16];
#pragma unroll
  for (int i = 0; i < 16; ++i) zv[i] = zs[(size_t)((i >> 2) * 16 + g * 4 + (i & 3)) * 512];
#pragma unroll
  for (int i = 0; i < 16; ++i) {
    const int pos = (i >> 2) * 16 + g * 4 + (i & 3);
    float ss = 0.f;
#pragma unroll
    for (int w = 0; w < 8; ++w) ss += part[w * 64 + pos];
    const float rs = rsqrtf(ss * (1.f / 128.f) + 1e-6f);
    zs[(size_t)pos * 512] = f2bf(o[i] * rs * ng * siluf(bf2f(zv[i])));
  }
  __syncthreads();
}

DEVI float ret_log2gamma(int h) { return log2f(1.f - exp2f(-5.f - (float)h)); }
DEVI void load_rope_tile(const P& p, const u16* secp, int r0, int h, float scale, u16* dst, u16* dstT, float l2g) {
  const int t = tid_l();
  const int row = t >> 2, j0 = (t & 3) * 16;
  const u16* src = secp + (size_t)(r0 + row) * 512 + h * 128;
  float x1[16], x2[16];
  unpack8(*(const u4*)(src + j0), x1); unpack8(*(const u4*)(src + j0 + 8), x1 + 8);
  unpack8(*(const u4*)(src + 64 + j0), x2); unpack8(*(const u4*)(src + 64 + j0 + 8), x2 + 8);
  const float* cs = p.ropecs + ((size_t)(r0 + row) * 64 + j0) * 2;
  float o1[16], o2[16];
#pragma unroll
  for (int j = 0; j < 16; j += 2) {
    const float4 c4 = *(const float4*)(cs + j * 2);
    o1[j] = (x1[j] * c4.x - x2[j] * c4.y) * scale;
    o2[j] = (x1[j] * c4.y + x2[j] * c4.x) * scale;
    o1[j + 1] = (x1[j + 1] * c4.z - x2[j + 1] * c4.w) * scale;
    o2[j + 1] = (x1[j + 1] * c4.w + x2[j + 1] * c4.z) * scale;
  }
  *(u4*)(dst + row * 136 + j0) = pack8(o1); *(u4*)(dst + row * 136 + j0 + 8) = pack8(o1 + 8);
  *(u4*)(dst + row * 136 + 64 + j0) = pack8(o2); *(u4*)(dst + row * 136 + 64 + j0 + 8) = pack8(o2 + 8);
  if (dstT) {
    const float z = exp2f(l2g * (float)(127 - row));
#pragma unroll
    for (int j = 0; j < 16; ++j) {
      dstT[(j0 + j) * 136 + row] = f2bf(o1[j] * z);
      dstT[(64 + j0 + j) * 136 + row] = f2bf(o2[j] * z);
    }
  }
}
DEVI void ret_d1_unit(const P& p, int u, unsigned char* smem) {
  const int t = tid_l(), lane = t & 63, wid = t >> 6;
  const int h = u & 3, n = (u >> 2) & 63, b = u >> 8;
  const int r0 = b * SEQ + n * 128;
  const float l2g = ret_log2gamma(h);
  u16* Qs = (u16*)smem;
  u16* Ks = Qs + 128 * 136;
  u16* KTz = Ks + 128 * 136;
  u16* VT = KTz + 128 * 136;
  load_rope_tile(p, p.sec + 7 * SECE, r0, h, 1.f, Qs, nullptr, 0.f);
  load_rope_tile(p, p.sec + 8 * SECE, r0, h, 0.08838834764831845f, Ks, KTz, l2g);
  {
    const int row = t >> 2, c0 = (t & 3) * 32;
    const u16* src = p.sec + 9 * SECE + (size_t)(r0 + row) * 512 + h * 128 + c0;
#pragma unroll
    for (int q = 0; q < 4; ++q) {
      const u4 v = *(const u4*)(src + q * 8);
      const u16* e = (const u16*)&v;
#pragma unroll
      for (int j = 0; j < 8; ++j) VT[(c0 + q * 8 + j) * 136 + row] = e[j];
    }
  }
  __syncthreads();
  f32x4 sacc[8];
#pragma unroll
  for (int ii = 0; ii < 8; ++ii) sacc[ii] = f32x4{0.f, 0.f, 0.f, 0.f};
#pragma unroll
  for (int k0 = 0; k0 < 128; k0 += 32) {
    const bf16x8 a = frag(Ks, 136, wid * 16, k0, lane);
#pragma unroll
    for (int ii = 0; ii < 8; ++ii) sacc[ii] = mfma16(a, frag(Qs, 136, ii * 16, k0, lane), sacc[ii]);
  }
  __syncthreads();
#pragma unroll
  for (int ii = 0; ii < 8; ++ii) {
    const int i = ii * 16 + (lane & 15), j0 = wid * 16 + (lane >> 4) * 4;
    f32x4 v;
#pragma unroll
    for (int r = 0; r < 4; ++r) v[r] = (i >= j0 + r) ? sacc[ii][r] * exp2f(l2g * (float)(i - j0 - r)) : 0.f;
    *(u2*)(Qs + i * 136 + j0) = pack4v(v);
  }
  __syncthreads();
  f32x4 oacc[8], kacc[8];
#pragma unroll
  for (int ii = 0; ii < 8; ++ii) { oacc[ii] = f32x4{0.f, 0.f, 0.f, 0.f}; kacc[ii] = f32x4{0.f, 0.f, 0.f, 0.f}; }
#pragma unroll
  for (int k0 = 0; k0 < 128; k0 += 32) {
    const bf16x8 a1 = frag(Qs, 136, wid * 16, k0, lane), a2 = frag(KTz, 136, wid * 16, k0, lane);
#pragma unroll
    for (int ii = 0; ii < 8; ++ii) {
      const bf16x8 bb = frag(VT, 136, ii * 16, k0, lane);
      oacc[ii] = mfma16(a1, bb, oacc[ii]);
      kacc[ii] = mfma16(a2, bb, kacc[ii]);
    }
  }
  u16* od = p.sec + 8 * SECE;
  u16* kd = p.sec + 9 * SECE;
#pragma unroll
  for (int ii = 0; ii < 8; ++ii) {
    const int e = ii * 16 + (lane & 15);
#pragma unroll
    for (int r = 0; r < 4; ++r) {
      const size_t o = (size_t)(r0 + wid * 16 + (lane >> 4) * 4 + r) * 512 + h * 128 + e;
      od[o] = f2bf(oacc[ii][r]);
      kd[o] = f2bf(kacc[ii][r]);
    }
  }
  __syncthreads();
}
DEVI void ret_d2_unit(const P& p, int l, int u, unsigned char* smem) {
  const int t = tid_l(), lane = t & 63, wid = t >> 6;
  const int h = u & 3, n = (u >> 2) & 63, b = u >> 8;
  const int r0 = b * SEQ + n * 128;
  const float l2g = ret_log2gamma(h);
  u16* Qs = (u16*)smem;
  u16* PT = Qs + 128 * 136;
  load_rope_tile(p, p.sec + 7 * SECE, r0, h, 1.f, Qs, nullptr, 0.f);
  {
    const int d = t >> 2, e0 = (t & 3) * 32;
    float acc[32];
#pragma unroll
    for (int j = 0; j < 32; ++j) acc[j] = 0.f;
    const float G = exp2f(l2g * 128.f);
    const u16* src = p.sec + 9 * SECE + ((size_t)b * SEQ + d) * 512 + h * 128 + e0;
    int m = 0;
#pragma unroll 1
    for (; m + 4 <= n; m += 4) {
      u4 v[4][4];
#pragma unroll
      for (int mm = 0; mm < 4; ++mm)
#pragma unroll
        for (int q = 0; q < 4; ++q) v[mm][q] = *(const u4*)(src + (size_t)(m + mm) * 128 * 512 + q * 8);
#pragma unroll
      for (int mm = 0; mm < 4; ++mm)
#pragma unroll
        for (int q = 0; q < 4; ++q) {
          float f[8];
          unpack8(v[mm][q], f);
#pragma unroll
          for (int j = 0; j < 8; ++j) acc[q * 8 + j] = acc[q * 8 + j] * G + f[j];
        }
    }
#pragma unroll 1
    for (; m < n; ++m) {
      const u16* s = src + (size_t)m * 128 * 512;
#pragma unroll
      for (int q = 0; q < 4; ++q) {
        float f[8];
        unpack8(*(const u4*)(s + q * 8), f);
#pragma unroll
        for (int j = 0; j < 8; ++j) acc[q * 8 + j] = acc[q * 8 + j] * G + f[j];
      }
    }
#pragma unroll
    for (int j = 0; j < 32; ++j) PT[(e0 + j) * 136 + d] = f2bf(acc[j]);
  }
  __syncthreads();
  f32x4 oacc[8];
#pragma unroll
  for (int ii = 0; ii < 8; ++ii) oacc[ii] = f32x4{0.f, 0.f, 0.f, 0.f};
#pragma unroll
  for (int k0 = 0; k0 < 128; k0 += 32) {
    const bf16x8 a = frag(Qs, 136, wid * 16, k0, lane);
#pragma unroll
    for (int ii = 0; ii < 8; ++ii) oacc[ii] = mfma16(a, frag(PT, 136, ii * 16, k0, lane), oacc[ii]);
  }
  const u16* oin = p.sec + 8 * SECE;
  u16* gd = p.sec + 10 * SECE;
  const int i0 = wid * 16 + (lane >> 4) * 4;
  float s1[4] = {0.f, 0.f, 0.f, 0.f}, s2[4] = {0.f, 0.f, 0.f, 0.f};
#pragma unroll
  for (int ii = 0; ii < 8; ++ii) {
    const int e = ii * 16 + (lane & 15);
#pragma unroll
    for (int r = 0; r < 4; ++r) {
      const float xi = exp2f(l2g * (float)(i0 + r + 1));
      const float o = bf2f(oin[(size_t)(r0 + i0 + r) * 512 + h * 128 + e]) + xi * oacc[ii][r];
      oacc[ii][r] = o;
      s1[r] += o; s2[r] += o * o;
    }
  }
#pragma unroll
  for (int r = 0; r < 4; ++r) {
#pragma unroll
    for (int o = 1; o < 16; o <<= 1) { s1[r] += __shfl_xor(s1[r], o); s2[r] += __shfl_xor(s2[r], o); }
  }
#pragma unroll
  for (int ii = 0; ii < 8; ++ii) {
    const int e = ii * 16 + (lane & 15);
    const float gg = p.ret_gn_g[l * 512 + h * 128 + e];
#pragma unroll
    for (int r = 0; r < 4; ++r) {
      const float mu = s1[r] * (1.f / 128.f);
      const float var = fmaxf(s2[r] * (1.f / 128.f) - mu * mu, 0.f);
      u16* gp = gd + (size_t)(r0 + i0 + r) * 512 + h * 128 + e;
      const float g = bf2f(*gp);
      *gp = f2bf(siluf(g) * (oacc[ii][r] - mu) * rsqrtf(var + 1e-6f) * gg);
    }
  }
  __syncthreads();
}

DEVI void pool_unit(const P& p, int l, int u, unsigned char* smem) {
  const int t = tid_l(), lane = t & 63, wid = t >> 6;
  const int g = u & 3, rt = u >> 2;
  const int r0 = rt * 64, spos0 = r0 & (SEQ - 1);
  const int win = 2 << g;
  u16* Al = (u16*)smem;
  u16* Wl = Al + 64 * 136;
  {
    const int row = t >> 3, c0 = (t & 7) * 16;
    const u16* base = p.sec + 4 * SECE + g * 128 + c0;
    float sum[16], own[16];
#pragma unroll
    for (int c = 0; c < 16; ++c) sum[c] = 0.f;
    const int sp = spos0 + row;
    const int cnt = min(sp + 1, win);
    for (int j = 0; j < cnt; ++j) {
      const u16* src = base + (size_t)(r0 + row - j) * 512;
      float f[16];
      unpack8(*(const u4*)src, f); unpack8(*(const u4*)(src + 8), f + 8);
#pragma unroll
      for (int c = 0; c < 16; ++c) { sum[c] += f[c]; if (j == 0) own[c] = f[c]; }
    }
    const float ic = 1.f / (float)cnt;
#pragma unroll
    for (int c = 0; c < 16; ++c) sum[c] = sum[c] * ic - own[c];
    *(u4*)(Al + row * 136 + c0) = pack8(sum); *(u4*)(Al + row * 136 + c0 + 8) = pack8(sum + 8);
    const u16* wsrc = p.PoolWT + (size_t)g * 16384;
#pragma unroll
    for (int q = 0; q < 4; ++q) {
      const int idx = t + q * 512;
      const int d = idx >> 4, cc = (idx & 15) * 8;
      *(u4*)(Wl + d * 136 + cc) = *(const u4*)(wsrc + d * 128 + cc);
    }
  }
  __syncthreads();
  const int pt = wid & 3, dh = wid >> 2;
  f32x4 acc[4];
#pragma unroll
  for (int ni = 0; ni < 4; ++ni) acc[ni] = f32x4{0.f, 0.f, 0.f, 0.f};
#pragma unroll
  for (int k0 = 0; k0 < 128; k0 += 32) {
    const bf16x8 a = frag(Al, 136, pt * 16, k0, lane);
#pragma unroll
    for (int ni = 0; ni < 4; ++ni) acc[ni] = mfma16(a, frag(Wl, 136, (dh * 4 + ni) * 16, k0, lane), acc[ni]);
  }
#pragma unroll
  for (int ni = 0; ni < 4; ++ni) {
    const int d = (dh * 4 + ni) * 16 + (lane & 15);
    const float sc = p.pool_scale[l * 512 + g * 128 + d];
#pragma unroll
    for (int r = 0; r < 4; ++r)
      p.YB[(size_t)(r0 + pt * 16 + (lane >> 4) * 4 + r) * 512 + g * 128 + d] = f2bf(acc[ni][r] * sc);
  }
  __syncthreads();
}

DEVI void sg_unit(const P& p, int l, int u, unsigned char* smem) {
  const int t = tid_l(), lane = t & 63, wid = t >> 6;
  const int g = u & 3, ch = u >> 2;
  const int r0 = ch * 128;
  u16* VT = (u16*)smem;
  u16* Ul = VT + 128 * 136;
  u16* Wl = Ul + 128 * 136;
  {
    const int row = t >> 2, q = t & 3;
    const u16* svr = p.sec + 6 * SECE + (size_t)(r0 + row) * 512;
    float s1 = 0.f, s2 = 0.f;
#pragma unroll 4
    for (int i = 0; i < 16; ++i) {
      float f[8];
      unpack8(*(const u4*)(svr + q * 128 + i * 8), f);
#pragma unroll
      for (int j = 0; j < 8; ++j) { const float gv = geluf(f[j]); s1 += gv; s2 += gv * gv; }
    }
    s1 += __shfl_xor(s1, 1); s2 += __shfl_xor(s2, 1);
    s1 += __shfl_xor(s1, 2); s2 += __shfl_xor(s2, 2);
    const float mu = s1 * (1.f / 512.f);
    const float rstd = rsqrtf(fmaxf(s2 * (1.f / 512.f) - mu * mu, 0.f) + 1e-6f);
    const int c0 = q * 32;
    const u16* sur = p.sec + 5 * SECE + (size_t)(r0 + row) * 512 + g * 128 + c0;
#pragma unroll
    for (int i = 0; i < 4; ++i) {
      float f[8], uu[8];
      unpack8(*(const u4*)(svr + g * 128 + c0 + i * 8), f);
      unpack8(*(const u4*)(sur + i * 8), uu);
#pragma unroll
      for (int j = 0; j < 8; ++j) {
        const int c = g * 128 + c0 + i * 8 + j;
        const float vv = (geluf(f[j]) - mu) * rstd * p.sg_ln_g[l * 512 + c] + p.sg_ln_b[l * 512 + c];
        VT[(c0 + i * 8 + j) * 136 + row] = f2bf(vv);
        uu[j] = geluf(uu[j]);
      }
      *(u4*)(Ul + row * 136 + c0 + i * 8) = pack8(uu);
    }
    const float* wsrc = p.sg_w + ((size_t)(l * 4 + g) * 128 + row) * 128 + c0;
#pragma unroll
    for (int i = 0; i < 4; ++i) {
      const float4 a = *(const float4*)(wsrc + i * 8), bq = *(const float4*)(wsrc + i * 8 + 4);
      float f[8] = {a.x, a.y, a.z, a.w, bq.x, bq.y, bq.z, bq.w};
#pragma unroll
      for (int j = 0; j < 8; ++j) f[j] = (c0 + i * 8 + j <= row) ? f[j] : 0.f;
      *(u4*)(Wl + row * 136 + c0 + i * 8) = pack8(f);
    }
  }
  __syncthreads();
  f32x4 acc[8];
#pragma unroll
  for (int ii = 0; ii < 8; ++ii) acc[ii] = f32x4{0.f, 0.f, 0.f, 0.f};
#pragma unroll
  for (int k0 = 0; k0 < 128; k0 += 32) {
    if (k0 <= wid * 16 + 15) {
      const bf16x8 a = frag(Wl, 136, wid * 16, k0, lane);
#pragma unroll
      for (int ii = 0; ii < 8; ++ii) acc[ii] = mfma16(a, frag(VT, 136, ii * 16, k0, lane), acc[ii]);
    }
  }
  u16* dst = p.sec + 5 * SECE;
  const int t0 = wid * 16 + (lane >> 4) * 4;
#pragma unroll
  for (int r = 0; r < 4; ++r) {
    const float bias = p.sg_b[(l * 4 + g) * 128 + t0 + r];
#pragma unroll
    for (int ii = 0; ii < 8; ++ii) {
      const int c = ii * 16 + (lane & 15);
      dst[(size_t)(r0 + t0 + r) * 512 + g * 128 + c] = f2bf(bf2f(Ul[(t0 + r) * 136 + c]) * (acc[ii][r] + bias));
    }
  }
  __syncthreads();
}

DEVI void final_norm_phase(const P& p) {
  const int t = tid_l(), lane = t & 63, wid = t >> 6;
  for (int u = blockIdx.x; u < 2048; u += gridDim.x) {
    const int row = u * 8 + wid;
    float* xr = p.out + (size_t)row * 1024;
    float4 xv[4];
    float ss = 0.f;
#pragma unroll
    for (int i = 0; i < 4; ++i) {
      xv[i] = *(const float4*)(xr + i * 256 + lane * 4);
      ss += xv[i].x * xv[i].x + xv[i].y * xv[i].y + xv[i].z * xv[i].z + xv[i].w * xv[i].w;
    }
    ss = wave_sum(ss);
    const float rstd = rsqrtf(ss * (1.f / 1024.f) + 1e-6f);
#pragma unroll
    for (int i = 0; i < 4; ++i) {
      const float4 g = *(const float4*)(p.final_g + i * 256 + lane * 4);
      float4 o;
      o.x = xv[i].x * rstd * g.x; o.y = xv[i].y * rstd * g.y; o.z = xv[i].z * rstd * g.z; o.w = xv[i].w * rstd * g.w;
      *(float4*)(xr + i * 256 + lane * 4) = o;
    }
  }
}


#define XB_TMO      128
#define XB_XCNT(j)  (256  + 64 * (j))
#define XB_XSUB(j)  (1280 + 64 * (j))
#define XB_XGEN(j)  (2304 + 64 * (j))
#define XB_TOP      3328
#define XB_TOPGEN   3392
#define XCD_BAR_WORDS 3456
#define XB_SPIN_CAP (1u << 20)
#define XLAS __attribute__((address_space(3)))
DEVI unsigned xb_ld(unsigned* p) { return __hip_atomic_load(p, __ATOMIC_RELAXED, __HIP_MEMORY_SCOPE_AGENT); }
DEVI unsigned xb_add(unsigned* p, unsigned v) { return __hip_atomic_fetch_add(p, v, __ATOMIC_RELAXED, __HIP_MEMORY_SCOPE_AGENT); }
DEVI unsigned xb_xcc_id() { return (unsigned)__builtin_amdgcn_s_getreg((3 << 11) | 20) & 0xFu; }
#define XB_SPIN(cond, bar) do { unsigned _sp = 0; while (cond) { __builtin_amdgcn_s_sleep(1); \
    if ((++_sp & 255u) == 0u) { if (xb_ld(&(bar)[XB_TMO])) break; if (_sp > XB_SPIN_CAP) { atomicAdd(&(bar)[XB_TMO], 1u); break; } } } } while (0)
struct XcdBarrier { unsigned* bar; unsigned x; volatile XLAS unsigned* st; };
DEVI XcdBarrier xcd_barrier_post(unsigned* bar, volatile XLAS unsigned* st) {
  XcdBarrier b; b.bar = bar; b.x = xb_xcc_id(); b.st = st;
  if (threadIdx.x == 0) (void)xb_add(&bar[XB_XCNT(b.x)], 1u);
  return b;
}
DEVI void xcd_barrier_complete(unsigned* bar, unsigned x, unsigned& nloc, unsigned& nx) {
  const unsigned G = gridDim.x * gridDim.y * gridDim.z;
  unsigned sum, cnt, mine, sp = 0u;
  for (;;) {
    sum = 0u; cnt = 0u; mine = 0u;
#pragma unroll
    for (unsigned j = 0; j < 16; ++j) { const unsigned c = xb_ld(&bar[XB_XCNT(j)]); sum += c; cnt += (c > 0u) ? 1u : 0u; mine = (j == x) ? c : mine; }
    if (sum == G) break;
    __builtin_amdgcn_s_sleep(1);
    if ((++sp & 255u) == 0u) { if (xb_ld(&bar[XB_TMO])) break; if (sp > XB_SPIN_CAP) { atomicAdd(&bar[XB_TMO], 1u); break; } }
  }
  nloc = mine > 0u ? mine : 1u; nx = cnt > 0u ? cnt : 1u;
}
DEVI void xcd_barrier(const XcdBarrier& b) {
  asm volatile("s_waitcnt vmcnt(0)" ::: "memory");
  __syncthreads();
  if (threadIdx.x == 0) {
    unsigned* bar = b.bar;
    __builtin_amdgcn_s_waitcnt(0);
    unsigned nloc = b.st[0], nx = b.st[1];
    if (nloc == 0u) { xcd_barrier_complete(bar, b.x, nloc, nx); b.st[0] = nloc; b.st[1] = nx; }
    const unsigned old = xb_add(&bar[XB_XSUB(b.x)], 1u);
    const unsigned gen = old / nloc;
    if (old + 1u == (gen + 1u) * nloc) {
      __builtin_amdgcn_fence(__ATOMIC_RELEASE, "agent");
      asm volatile("s_waitcnt vmcnt(0)" ::: "memory");
      const unsigned og = xb_add(&bar[XB_TOP], 1u);
      const unsigned tg = og / nx;
      if (og + 1u == (tg + 1u) * nx) xb_add(&bar[XB_TOPGEN], 1u);
      else XB_SPIN(xb_ld(&bar[XB_TOPGEN]) == tg, bar);
      __builtin_amdgcn_fence(__ATOMIC_ACQUIRE, "agent");
      xb_add(&bar[XB_XGEN(b.x)], 1u);
      asm volatile("s_waitcnt vmcnt(0)" ::: "memory");
    } else {
      XB_SPIN(xb_ld(&bar[XB_XGEN(b.x)]) == gen, bar);
      __builtin_amdgcn_fence(__ATOMIC_ACQUIRE, "agent");
      asm volatile("s_waitcnt vmcnt(0)" ::: "memory");
    }
  }
  __syncthreads();
}

#ifndef PHMASK
#define PHMASK 0xffffffffu
#endif
#define EN(x) (((PHMASK) >> (x)) & 1u)
typedef const __attribute__((address_space(4))) P* KP;
DEVI P load_params(KP vp) {
  const __attribute__((address_space(4))) P& v = *vp;
  P q;
  q.x = v.x; q.c = v.c; q.pos = v.pos; q.norm1_g = v.norm1_g; q.norm2_g = v.norm2_g; q.ada_w = v.ada_w; q.ada_b = v.ada_b;
  q.w_in = v.w_in; q.dn_conv_w = v.dn_conv_w; q.dn_a_log = v.dn_a_log; q.dn_dt_bias = v.dn_dt_bias; q.dn_norm_g = v.dn_norm_g;
  q.pool_w = v.pool_w; q.pool_scale = v.pool_scale; q.sg_ln_g = v.sg_ln_g; q.sg_ln_b = v.sg_ln_b; q.sg_w = v.sg_w; q.sg_b = v.sg_b;
  q.ret_gn_g = v.ret_gn_g; q.w_br0 = v.w_br0; q.w_br1 = v.w_br1; q.w_br2 = v.w_br2; q.w_br3 = v.w_br3;
  q.w_out = v.w_out; q.mlp_w1 = v.mlp_w1; q.mlp_w2 = v.mlp_w2; q.final_g = v.final_g; q.out = v.out;
  q.WinT = v.WinT; q.WbrT = v.WbrT; q.WoutT = v.WoutT; q.W1T = v.W1T; q.W2T = v.W2T; q.PoolWT = v.PoolWT; q.h = v.h; q.sec = v.sec;
  q.TQ = v.TQ; q.YB = v.YB; q.halo = v.halo; q.QKF = v.QKF; q.modp = v.modp; q.beta = v.beta; q.glog = v.glog; q.EG = v.EG; q.ropecs = v.ropecs; q.prog = v.prog; q.rowss = v.rowss; q.xbar = v.xbar;
  q.phase_lo = 0; q.phase_hi = 0;
  return q;
}
#define LP() KP k2_ = kp; asm volatile("" : "+s"(k2_)); const P p = load_params(k2_)
DEVI void run_phase(int ph, unsigned char* smem) {
  KP kp = (KP)__builtin_amdgcn_kernarg_segment_ptr();
  int bid = blockIdx.x; asm volatile("" : "+s"(bid));
  const int nb = gridDim.x;
  if (ph == 0) {
    for (int u = bid; u < 96 + 2048 + NWCONV; u += nb) {
      if (u < 96) { if (EN(0)) { LP(); mod_unit(p, u, smem); } }
      else if (u < 96 + 2048) { if (EN(1)) { LP(); rope_unit(p, u - 96); } }
      else { if (EN(2)) { LP(); wconv_unit(p, 0, u - 96 - 2048, smem); } }
    }
    return;
  }
  if (ph == NPHASE - 1) { if (EN(15)) { LP(); final_norm_phase(p); } return; }
  const int l = (ph - 1) / 10, s = (ph - 1) % 10;
  switch (s) {
    case 0:
      if (l == 1 && EN(2)) for (int u = bid; u < NWCONV; u += nb) { LP(); wconv_unit(p, 1, u, smem); }
      __syncthreads();
      if (EN(3)) { LP(); norm_phase(p, l, 0, smem); }
      break;
    case 1:
      if (EN(3)) for (int u = bid; u < 64; u += nb) { LP(); bias2_unit(p, l, u); }
      if (EN(4)) { LP(); proj_phase(p, smem); }
      break;
    case 2:
      if (bid == 0 && threadIdx.x < 17) { LP(); p.prog[threadIdx.x * 16] = 0u; }
      for (int u = bid; u < 1024; u += nb) { if (EN(5)) { LP(); dn_prep_unit(p, l, u, smem); } }
      break;
    case 3:
      if (bid < 16) { if (EN(9)) { LP(); dn_chain(p, l, bid & 7, bid >> 3, smem); } }
      else if (bid < 24) { if (EN(9)) { LP(); dn_chain_helper(p, bid - 16, smem); } }
      else {
        const int nw = nb - 24, wb = bid - 24;
        for (int u = wb; u < 512 + 512 + 1024; u += nw) {
          if (u < 512) { if (EN(6)) { LP(); ret_d1_unit(p, u, smem); } }
          else if (u < 1024) { if (EN(7)) { LP(); sg_unit(p, l, u - 512, smem); } }
          else { if (EN(8)) { LP(); pool_unit(p, l, u - 1024, smem); } }
        }
        {
          LP();
          unsigned* cnt = p.prog + 16 * 16;
          asm volatile("s_waitcnt vmcnt(0)" ::: "memory");
          __syncthreads();
          if (threadIdx.x == 0) {
            __builtin_amdgcn_fence(__ATOMIC_RELEASE, "agent");
            asm volatile("s_waitcnt vmcnt(0)" ::: "memory");
            __hip_atomic_fetch_add(cnt, 1u, __ATOMIC_RELAXED, __HIP_MEMORY_SCOPE_AGENT);
            unsigned polls = 0;
            while (__hip_atomic_load(cnt, __ATOMIC_RELAXED, __HIP_MEMORY_SCOPE_AGENT) < (unsigned)nw && polls < 4000000u) { __builtin_amdgcn_s_sleep(2); ++polls; }
            __builtin_amdgcn_fence(__ATOMIC_ACQUIRE, "agent");
            asm volatile("s_waitcnt vmcnt(0)" ::: "memory");
          }
          __syncthreads();
        }
        if (EN(10)) for (int u = wb; u < 512; u += nw) { LP(); ret_d2_unit(p, l, u, smem); }
        if (EN(9)) for (int k = wb; k < 1024; k += nw) {
          LP();
          const int n = k >> 3, bh = k & 7;
          if (threadIdx.x == 0) {
            unsigned polls = 0;
            while ((__hip_atomic_load(p.prog + (bh * 2) * 16, __ATOMIC_RELAXED, __HIP_MEMORY_SCOPE_AGENT) <= (unsigned)n ||
                    __hip_atomic_load(p.prog + (bh * 2 + 1) * 16, __ATOMIC_RELAXED, __HIP_MEMORY_SCOPE_AGENT) <= (unsigned)n) && polls < 8000000u) { __builtin_amdgcn_s_sleep(8); ++polls; }
            __builtin_amdgcn_fence(__ATOMIC_ACQUIRE, "agent");
            asm volatile("s_waitcnt vmcnt(0)" ::: "memory");
          }
          __syncthreads();
          ya_unit(p, l, (((bh >> 2) * 128 + n) << 2) | (bh & 3), smem);
        }
      }
      break;
    case 4: break;
    case 5: if (EN(12)) { LP(); merge_phase(p, smem); } break;
    case 6: if (EN(13)) { LP(); resid_gemm_phase(p, l, 0, smem); } break;
    case 7: break;
    case 8: if (EN(14)) { LP(); mlp1_phase(p, smem); } break;
    case 9: if (EN(13)) { LP(); resid_gemm_phase(p, l, 1, smem); } break;
  }
}

__global__ void __launch_bounds__(NT) mega(P p) {
  extern __shared__ __attribute__((aligned(16))) unsigned char smem[];
#ifdef PROBE_A
  unsigned long long* stamps = (unsigned long long*)(smem + 159000);
  if (threadIdx.x == 0) { stamps[0] = __builtin_amdgcn_s_memrealtime(); stamps[23] = 0; }
#endif
  volatile XLAS unsigned* xst = (volatile XLAS unsigned*)((XLAS unsigned char*)smem + (SMEM_BYTES - 16));
  if (threadIdx.x == 0) { xst[0] = 0u; xst[1] = 0u; }
  __syncthreads();
  const XcdBarrier xb = xcd_barrier_post(p.xbar, xst);
  for (int ph = p.phase_lo; ph < p.phase_hi; ++ph) {
    if (ph > 0 && ph < NPHASE - 1 && ((ph - 1) % 10 == 7 || (ph - 1) % 10 == 4)) continue;
    run_phase(ph, smem);
    if (ph + 1 < p.phase_hi) {
      if (ph == 0) cg::this_grid().sync();
      else xcd_barrier(xb);
    }
  }
#ifdef PROBE_A
  cg::this_grid().sync();
  if (blockIdx.x == 0) {
    __syncthreads();
    auto dur = [&](int code) -> unsigned long long {
      if (code == 100) return stamps[1] - stamps[0];
      if (code == 101) return stamps[23];
      if (code == 102) return stamps[NPHASE - 1] - stamps[0];
      return (stamps[1 + code + 1] - stamps[1 + code]) + (stamps[11 + code + 1] - stamps[11 + code]);
    };
    const unsigned N = (unsigned)(dur(PROBE_A) * 4096ull / 100ull);
    for (unsigned i = threadIdx.x; i < N && i < 16384u * 1024u; i += NT) p.out[i] += 0.0078125f;
  }
#endif
}

extern "C" void kernel_launch(void* const* d_in, const int* in_sizes, int n_in, void* d_out, int out_size, void* d_ws,
                              size_t ws_size, hipStream_t stream) {
  static int grid = 0;
  constexpr size_t MiB = 1024 * 1024;
  constexpr size_t WS_NEED = 304 * MiB;
  if (grid == 0) {
    if (ws_size < WS_NEED || n_in != 27) {
      fprintf(stderr, "kernel_launch: ws_size %zu < %zu or n_in %d != 27\n", ws_size, WS_NEED, n_in);
      grid = -1;
      return;
    }
    int dev = 0, cus = 0, per_cu = 0;
    hipGetDevice(&dev);
    hipDeviceGetAttribute(&cus, hipDeviceAttributeMultiprocessorCount, dev);
    hipFuncSetAttribute((const void*)mega, hipFuncAttributeMaxDynamicSharedMemorySize, SMEM_BYTES);
    hipOccupancyMaxActiveBlocksPerMultiprocessor(&per_cu, (const void*)mega, NT, SMEM_BYTES);
    if (per_cu < 1) per_cu = 1;
    grid = cus * per_cu;
    (void)hipGetLastError();
  }
  if (grid < 0) return;
  P p{};
  p.x = (const float*)d_in[0]; p.c = (const float*)d_in[1]; p.pos = (const int*)d_in[2];
  p.norm1_g = (const float*)d_in[3]; p.norm2_g = (const float*)d_in[4];
  p.ada_w = (const float*)d_in[5]; p.ada_b = (const float*)d_in[6]; p.w_in = (const float*)d_in[7];
  p.dn_conv_w = (const float*)d_in[8]; p.dn_a_log = (const float*)d_in[9]; p.dn_dt_bias = (const float*)d_in[10];
  p.dn_norm_g = (const float*)d_in[11]; p.pool_w = (const float*)d_in[12]; p.pool_scale = (const float*)d_in[13];
  p.sg_ln_g = (const float*)d_in[14]; p.sg_ln_b = (const float*)d_in[15]; p.sg_w = (const float*)d_in[16];
  p.sg_b = (const float*)d_in[17]; p.ret_gn_g = (const float*)d_in[18];
  p.w_br0 = (const float*)d_in[19]; p.w_br1 = (const float*)d_in[20]; p.w_br2 = (const float*)d_in[21];
  p.w_br3 = (const float*)d_in[22];
  p.w_out = (const float*)d_in[23]; p.mlp_w1 = (const float*)d_in[24]; p.mlp_w2 = (const float*)d_in[25];
  p.final_g = (const float*)d_in[26];
  p.out = (float*)d_out;
  unsigned char* ws = (unsigned char*)d_ws;
  size_t o = 0;
  p.WinT = (u16*)(ws + o); o += (size_t)9728 * 1024 * 2;
  p.WbrT = (u16*)(ws + o); o += (size_t)4 * 1024 * 512 * 2;
  p.WoutT = (u16*)(ws + o); o += (size_t)1024 * 1024 * 2;
  p.W1T = (u16*)(ws + o); o += (size_t)4096 * 1024 * 2;
  p.W2T = (u16*)(ws + o); o += (size_t)4096 * 1024 * 2;
  p.PoolWT = (u16*)(ws + o); o += (size_t)4 * 128 * 128 * 2;
  o = 44 * MiB;
  p.h = (u16*)(ws + o); o += 32 * MiB;
  p.sec = (u16*)(ws + o); o += 176 * MiB;
  p.TQ = (u16*)(ws + o); o += 16 * MiB;
  p.YB = (u16*)(ws + o); o += 16 * MiB;
  p.halo = (u16*)(ws + o); o += 3 * MiB;
  p.modp = (float*)(ws + o); o += 1 * MiB;
  p.beta = (float*)(ws + o); o += 262144;
  p.glog = (float*)(ws + o); o += 262144;
  p.EG = (float*)(ws + o); o += 262144;
  p.ropecs = (float*)(ws + o); o += 8 * MiB;
  p.QKF = (u16*)(ws + o); o += (size_t)1024 * 3072 * 2;
  p.prog = (unsigned*)(ws + o); o += 4096;
  p.rowss = (float*)(ws + o); o += (size_t)16384 * 16 * 4;
  p.xbar = (unsigned*)(ws + o); o += 16384;
#if COOP
  (void)hipMemsetAsync(p.xbar, 0, 16384, stream);
  p.phase_lo = 0; p.phase_hi = NPHASE;
  void* args[] = {&p};
  hipError_t e = hipLaunchCooperativeKernel((const void*)mega, dim3(grid), dim3(NT), args, SMEM_BYTES, stream);
  if (e != hipSuccess) fprintf(stderr, "cooperative launch failed: %s (grid %d)\n", hipGetErrorString(e), grid);
#else
  for (int ph = 0; ph < NPHASE; ++ph) {
    p.phase_lo = ph; p.phase_hi = ph + 1;
    hipLaunchKernelGGL(mega, dim3(grid), dim3(NT), SMEM_BYTES, stream, p);
  }
#endif
}
```

```cpp
#include <hip/hip_runtime.h>
#include <hip/hip_bf16.h>
#include <hip/hip_cooperative_groups.h>
#include <cstdio>
namespace cg = cooperative_groups;

#ifndef COOP
#define COOP 1
#endif

typedef unsigned short u16;
using bf16x8 = __attribute__((ext_vector_type(8))) short;
using f32x4 = __attribute__((ext_vector_type(4))) float;
using u4 = __attribute__((ext_vector_type(4))) unsigned;
using u2 = __attribute__((ext_vector_type(2))) unsigned;
#define DEVI __device__ __forceinline__

constexpr int NT = 512;
constexpr int SEQ = 8192;
constexpr size_t SECE = (size_t)16384 * 512;
constexpr int SMEM_BYTES = 156 * 1024;
constexpr int NPHASE = 22;

struct P {
  const float *x, *c;
  const int* pos;
  const float *norm1_g, *norm2_g, *ada_w, *ada_b, *w_in, *dn_conv_w, *dn_a_log, *dn_dt_bias, *dn_norm_g, *pool_w,
      *pool_scale, *sg_ln_g, *sg_ln_b, *sg_w, *sg_b, *ret_gn_g, *w_br0, *w_br1, *w_br2, *w_br3, *w_out, *mlp_w1, *mlp_w2, *final_g;
  float* out;
  u16 *WinT, *WbrT, *WoutT, *W1T, *W2T, *PoolWT, *h, *sec, *TQ, *YB, *halo, *QKF;
  float *modp, *beta, *glog, *EG, *ropecs;
  unsigned* prog;
  float* rowss;
  unsigned* xbar;
  int phase_lo, phase_hi;
};

DEVI int tid_l() { int t = threadIdx.x; asm volatile("" : "+v"(t)); return t; }
template <class T> DEVI void lnd(T*& q) { asm volatile("" : "+s"(q)); }
typedef float f32x2_t __attribute__((ext_vector_type(2)));
typedef __bf16 bf16x2_t __attribute__((ext_vector_type(2)));
DEVI unsigned pack2(float a, float b) { const f32x2_t v = {a, b}; const bf16x2_t r = __builtin_convertvector(v, bf16x2_t); return __builtin_bit_cast(unsigned, r); }
DEVI u16 f2bf(float f) { return (u16)(pack2(f, f) & 0xffffu); }
DEVI float bf2f(u16 h) { return __uint_as_float(((unsigned)h) << 16); }
DEVI float lo2f(unsigned u) { return __uint_as_float(u << 16); }
DEVI float hi2f(unsigned u) { return __uint_as_float(u & 0xffff0000u); }
DEVI void unpack8(u4 v, float* f) {
  f[0] = lo2f(v.x); f[1] = hi2f(v.x); f[2] = lo2f(v.y); f[3] = hi2f(v.y);
  f[4] = lo2f(v.z); f[5] = hi2f(v.z); f[6] = lo2f(v.w); f[7] = hi2f(v.w);
}
DEVI u4 pack8(const float* f) {
  u4 v; v.x = pack2(f[0], f[1]); v.y = pack2(f[2], f[3]); v.z = pack2(f[4], f[5]); v.w = pack2(f[6], f[7]);
  return v;
}
DEVI float wave_sum(float v) {
#pragma unroll
  for (int o = 32; o > 0; o >>= 1) v += __shfl_xor(v, o);
  return v;
}
DEVI float siluf(float x) { return x * __builtin_amdgcn_rcpf(1.f + __expf(-x)); }
DEVI float sigmf(float x) { return __builtin_amdgcn_rcpf(1.f + __expf(-x)); }
DEVI float geluf(float v) {
  const float av = fabsf(v), t = __builtin_amdgcn_rcpf(av * 0.2316418882f + 1.0f);
  float q = t * 0.5307027145f + (-0.7265760135f); q = q * t + 0.7107068705f; q = q * t + (-0.142248368f); q = q * t + 0.127414796f; q = q * t;
  const float e = __builtin_amdgcn_exp2f((v * v) * (-0.72134752044f));
  const float m = v * (q * e);
  return v < 0.f ? m : v - m;
}
DEVI f32x4 mfma16(bf16x8 a, bf16x8 b, f32x4 c) { return __builtin_amdgcn_mfma_f32_16x16x32_bf16(a, b, c, 0, 0, 0); }
DEVI bf16x8 frag(const u16* base, int ld, int r0, int k0, int lane) {
  return *(const bf16x8*)(base + (r0 + (lane & 15)) * ld + k0 + 8 * (lane >> 4));
}
DEVI u2 pack4v(f32x4 v) { u2 r; r.x = pack2(v[0], v[1]); r.y = pack2(v[2], v[3]); return r; }

DEVI float modval(const P& p, int l, int b, int j) { return p.modp[(size_t)(l * 2 + b) * 6144 + j]; }

DEVI void gemm_kloop(const u16* __restrict__ A, int lda, const u16* __restrict__ Bt, int ldb, int K,
                     f32x4 (&acc)[4][4], u16* sm) {
  const int t = tid_l(), lane = t & 63, wid = t >> 6, wr = wid >> 1, wc = wid & 1;
  u16* As = sm;
  u16* Bs = sm + 2 * 256 * 64;
  const int lrow = t >> 3, lch = t & 7;
  const u16* ag = A + (size_t)lrow * lda + lch * 8;
  const u16* bg = Bt + (size_t)lrow * ldb + lch * 8;
  const int soff = lrow * 64 + ((lch ^ (lrow & 7)) * 8);
  u4 ra[4], rb[2];
#pragma unroll
  for (int i = 0; i < 4; ++i) ra[i] = *(const u4*)(ag + (size_t)i * 64 * lda);
#pragma unroll
  for (int i = 0; i < 2; ++i) rb[i] = *(const u4*)(bg + (size_t)i * 64 * ldb);
  __syncthreads();
#pragma unroll
  for (int i = 0; i < 4; ++i) *(u4*)(As + i * 64 * 64 + soff) = ra[i];
#pragma unroll
  for (int i = 0; i < 2; ++i) *(u4*)(Bs + i * 64 * 64 + soff) = rb[i];
  __syncthreads();
  const int nt = K >> 6;
  const int arow = (wr * 64 + (lane & 15)) * 64, brow = (wc * 64 + (lane & 15)) * 64;
  for (int kt = 0; kt < nt; ++kt) {
    const int cur = kt & 1;
    if (kt + 1 < nt) {
      const int ko = (kt + 1) * 64;
#pragma unroll
      for (int i = 0; i < 4; ++i) ra[i] = *(const u4*)(ag + (size_t)i * 64 * lda + ko);
#pragma unroll
      for (int i = 0; i < 2; ++i) rb[i] = *(const u4*)(bg + (size_t)i * 64 * ldb + ko);
    }
    const u16* Ac = As + cur * 256 * 64 + arow;
    const u16* Bc = Bs + cur * 128 * 64 + brow;
#pragma unroll
    for (int kk = 0; kk < 2; ++kk) {
      const int ch = (((kk * 4 + (lane >> 4)) ^ (lane & 7)) * 8);
      bf16x8 af[4], bfr[4];
#pragma unroll
      for (int mi = 0; mi < 4; ++mi) af[mi] = *(const bf16x8*)(Ac + mi * 16 * 64 + ch);
#pragma unroll
      for (int ni = 0; ni < 4; ++ni) bfr[ni] = *(const bf16x8*)(Bc + ni * 16 * 64 + ch);
#pragma unroll
      for (int mi = 0; mi < 4; ++mi)
#pragma unroll
        for (int ni = 0; ni < 4; ++ni) acc[mi][ni] = mfma16(af[mi], bfr[ni], acc[mi][ni]);
    }
    if (kt + 1 < nt) {
      const int nb = cur ^ 1;
#pragma unroll
      for (int i = 0; i < 4; ++i) *(u4*)(As + nb * 256 * 64 + i * 64 * 64 + soff) = ra[i];
#pragma unroll
      for (int i = 0; i < 2; ++i) *(u4*)(Bs + nb * 128 * 64 + i * 64 * 64 + soff) = rb[i];
    }
    __syncthreads();
  }
}
DEVI void zero_acc(f32x4 (&acc)[4][4]) {
#pragma unroll
  for (int i = 0; i < 4; ++i)
#pragma unroll
    for (int j = 0; j < 4; ++j) acc[i][j] = f32x4{0.f, 0.f, 0.f, 0.f};
}
template <class F>
DEVI void epi_foreach(f32x4 (&acc)[4][4], int row0, int col0, F f) {
  const int t = tid_l(), lane = t & 63, wid = t >> 6, wr = wid >> 1, wc = wid & 1;
#pragma unroll
  for (int mi = 0; mi < 4; ++mi)
#pragma unroll
    for (int ni = 0; ni < 4; ++ni)
#pragma unroll
      for (int r = 0; r < 4; ++r)
        f(row0 + wr * 64 + mi * 16 + (lane >> 4) * 4 + r, col0 + wc * 64 + ni * 16 + (lane & 15), acc[mi][ni][r]);
}

DEVI void mod_unit(const P& p, int u, unsigned char* smem) {
  const int t = tid_l();
  const int l = u / 48, jb = u % 48;
  float* cond = (float*)smem;
  float* red = cond + 2048;
  for (int i = t; i < 2048; i += NT) cond[i] = siluf(p.c[i]);
  __syncthreads();
  const int kq = t >> 7, jj = t & 127;
  const float* w = p.ada_w + ((size_t)l * 1024 + kq * 256) * 6144 + jb * 128 + jj;
  float a0 = 0.f, a1 = 0.f;
#pragma unroll 16
  for (int k = 0; k < 256; ++k) {
    const float wv = w[(size_t)k * 6144];
    a0 += cond[kq * 256 + k] * wv;
    a1 += cond[1024 + kq * 256 + k] * wv;
  }
  red[(kq * 2 + 0) * 128 + jj] = a0;
  red[(kq * 2 + 1) * 128 + jj] = a1;
  __syncthreads();
  if (t < 256) {
    const int bb = t >> 7;
    const int j = jb * 128 + jj;
    float sacc = p.ada_b[l * 6144 + j];
#pragma unroll
    for (int q = 0; q < 4; ++q) sacc += red[(q * 2 + bb) * 128 + jj];
    p.modp[(size_t)(l * 2 + bb) * 6144 + j] = sacc;
  }
  __syncthreads();
}
DEVI void rope_unit(const P& p, int u) {
  const int idx = u * 512 + tid_l();
  const int tok = idx >> 6, j = idx & 63;
  const float inv = exp2f(-(float)j * (13.287712379549449f / 64.f));
  const float ang = (float)p.pos[tok] * inv;
  double rev = (double)ang * 0.15915494309189535;
  rev -= rint(rev);
  const float r = (float)(rev * 6.283185307179586);
  p.ropecs[(size_t)idx * 2] = __cosf(r);
  p.ropecs[(size_t)idx * 2 + 1] = __sinf(r);
}
template <int NTL>
DEVI void conv_tiles(const float* __restrict__ src, int ld, int K, int kt, int nt0, int col0, u16* __restrict__ dst, unsigned char* smem, int dkt = -1) {
  if (dkt < 0) dkt = kt;
  float* ls = (float*)smem;
  const int t = tid_l();
  float4 v[NTL][2];
#pragma unroll
  for (int q = 0; q < NTL; ++q)
#pragma unroll
    for (int ps = 0; ps < 2; ++ps) {
      const int kk = ps * 32 + (t >> 4), n4 = (t & 15) * 4;
      v[q][ps] = *(const float4*)(src + (size_t)(kt * 64 + kk) * ld + col0 + q * 64 + n4);
    }
#pragma unroll
  for (int q = 0; q < NTL; ++q)
#pragma unroll
    for (int ps = 0; ps < 2; ++ps) {
      const int kk = ps * 32 + (t >> 4), n4 = (t & 15) * 4;
      float* d = ls + q * 64 * 65 + kk * 65 + n4;
      d[0] = v[q][ps].x; d[1] = v[q][ps].y; d[2] = v[q][ps].z; d[3] = v[q][ps].w;
    }
  __syncthreads();
  const int n = t >> 3, kc = (t & 7) * 8;
#pragma unroll
  for (int q = 0; q < NTL; ++q) {
    float f[8];
#pragma unroll
    for (int j = 0; j < 8; ++j) f[j] = ls[q * 64 * 65 + (kc + j) * 65 + n];
    *(u4*)(dst + (size_t)((nt0 + q) * 64 + n) * K + dkt * 64 + kc) = pack8(f);
  }
  __syncthreads();
}
constexpr int NWCONV = 608 + 128 + 64 + 256 + 256 + 8;
DEVI void wconv_unit(const P& p, int l, int w, unsigned char* smem) {
  if (w < 608) {
    const int kt = w & 15, ng = w >> 4, n0 = ng * 256;
    conv_tiles<4>(p.w_in + (size_t)l * 1024 * 9736, 9736, 512, kt, ng * 4, n0 + (n0 >= 2048 ? 8 : 0), p.WinT + (size_t)(kt >> 3) * 9728 * 512, smem, kt & 7);
    return;
  }
  w -= 608;
  if (w < 128) {
    const int b = w >> 5, r = w & 31, kt = r & 7, ng = r >> 3;
    const float* b0 = p.w_br0; const float* b1 = p.w_br1; const float* b2 = p.w_br2; const float* b3 = p.w_br3;
    asm volatile("" : "+s"(b0)); asm volatile("" : "+s"(b1)); asm volatile("" : "+s"(b2)); asm volatile("" : "+s"(b3));
    conv_tiles<4>((b == 0 ? b0 : b == 1 ? b1 : b == 2 ? b2 : b3) + (size_t)l * 512 * 1024, 1024, 512, kt, ng * 4, ng * 256, p.WbrT + (size_t)b * 1024 * 512, smem);
    return;
  }
  w -= 128;
  if (w < 64) {
    conv_tiles<4>(p.w_out + (size_t)l * 1024 * 1024, 1024, 1024, w & 15, (w >> 4) * 4, (w >> 4) * 256, p.WoutT, smem);
    return;
  }
  w -= 64;
  if (w < 256) {
    conv_tiles<4>(p.mlp_w1 + (size_t)l * 1024 * 4096, 4096, 1024, w & 15, (w >> 4) * 4, (w >> 4) * 256, p.W1T, smem);
    return;
  }
  w -= 256;
  if (w < 256) {
    conv_tiles<4>(p.mlp_w2 + (size_t)l * 4096 * 1024, 1024, 4096, w & 63, (w >> 6) * 4, (w >> 6) * 256, p.W2T, smem);
    return;
  }
  w -= 256;
  {
    const int g = w >> 1, kt = w & 1;
    conv_tiles<2>(p.pool_w + (size_t)(l * 4 + g) * 16384, 128, 128, kt, 0, 0, p.PoolWT + (size_t)g * 16384, smem);
  }
}

DEVI void norm_phase(const P& p, int l, int which, unsigned char* smem) {
  const int t = tid_l(), lane = t & 63, wid = t >> 6;
  float* ssh = (float*)smem;
  float* ssc = ssh + 2048;
  float* w8 = ssc + 2048;
  const float* gsrc = (which == 0 ? p.norm1_g : p.norm2_g) + l * 1024;
  const int ish = which == 0 ? 0 : 3;
#pragma unroll 1
  for (int i = t; i < 2048; i += NT) {
    const int b = i >> 10, c = i & 1023;
    ssh[i] = modval(p, l, b, ish * 1024 + c);
    ssc[i] = gsrc[c] * (1.f + modval(p, l, b, (ish + 1) * 1024 + c));
  }
  if (which == 0) {
#pragma unroll 1
    for (int i = t; i < 2048; i += NT) {
      const int k = i >> 1, hf = i & 1;
      *(float4*)(w8 + k * 8 + hf * 4) = *(const float4*)(p.w_in + ((size_t)l * 1024 + k) * 9736 + 2048 + hf * 4);
    }
  }
  __syncthreads();
  const float* xs = (l == 0 && which == 0) ? p.x : p.out;
  float4 xv[4];
  {
    const int u0 = blockIdx.x;
    if (u0 < 2048) {
      const float* xr = xs + (size_t)(u0 * 8 + wid) * 1024;
#pragma unroll
      for (int i = 0; i < 4; ++i) xv[i] = *(const float4*)(xr + i * 256 + lane * 4);
    }
  }
#pragma unroll 1
  for (int u = blockIdx.x; u < 2048; u += gridDim.x) {
    const int row = u * 8 + wid, b = row >> 13;
    float4 xn[4];
    {
      const int un = u + gridDim.x;
      const float* xr = xs + (size_t)((un < 2048 ? un : u) * 8 + wid) * 1024;
#pragma unroll
      for (int i = 0; i < 4; ++i) xn[i] = *(const float4*)(xr + i * 256 + lane * 4);
    }
    float ss = 0.f;
#pragma unroll
    for (int i = 0; i < 4; ++i) {
      ss += xv[i].x * xv[i].x + xv[i].y * xv[i].y + xv[i].z * xv[i].z + xv[i].w * xv[i].w;
    }
    ss = wave_sum(ss);
    const float rstd = rsqrtf(ss * (1.f / 1024.f) + 1e-6f);
    float a8[8];
#pragma unroll
    for (int j = 0; j < 8; ++j) a8[j] = 0.f;
#pragma unroll
    for (int i = 0; i < 4; ++i) {
      const int c = i * 256 + lane * 4;
      const float4 sc = *(const float4*)(ssc + b * 1024 + c);
      const float4 sh = *(const float4*)(ssh + b * 1024 + c);
      float hv[4];
      hv[0] = xv[i].x * rstd * sc.x + sh.x;
      hv[1] = xv[i].y * rstd * sc.y + sh.y;
      hv[2] = xv[i].z * rstd * sc.z + sh.z;
      hv[3] = xv[i].w * rstd * sc.w + sh.w;
      u2 o; o.x = pack2(hv[0], hv[1]); o.y = pack2(hv[2], hv[3]);
      *(u2*)(p.h + (size_t)(c >> 9) * 8388608 + (size_t)row * 512 + (c & 511)) = o;
      if (which == 0) {
#pragma unroll
        for (int e = 0; e < 4; ++e) {
          const float4 wa = *(const float4*)(w8 + (c + e) * 8);
          const float4 wb = *(const float4*)(w8 + (c + e) * 8 + 4);
          a8[0] += hv[e] * wa.x; a8[1] += hv[e] * wa.y; a8[2] += hv[e] * wa.z; a8[3] += hv[e] * wa.w;
          a8[4] += hv[e] * wb.x; a8[5] += hv[e] * wb.y; a8[6] += hv[e] * wb.z; a8[7] += hv[e] * wb.w;
        }
      }
    }
    if (which == 0) {
#pragma unroll
      for (int j = 0; j < 8; ++j) a8[j] = wave_sum(a8[j]);
      float mine = 0.f;
#pragma unroll
      for (int j = 0; j < 8; ++j) mine = (lane == j) ? a8[j] : mine;
      if (lane < 4) {
        p.beta[(size_t)row * 4 + lane] = sigmf(mine);
      } else if (lane < 8) {
        const int hh = lane - 4;
        const float xx = mine + p.dn_dt_bias[l * 4 + hh];
        const float sp = xx > 20.f ? xx : log1pf(expf(xx));
        p.glog[(size_t)row * 4 + hh] = -expf(p.dn_a_log[l * 4 + hh]) * sp;
      }
    }
#pragma unroll
    for (int i = 0; i < 4; ++i) xv[i] = xn[i];
  }
}

DEVI int gate_sec(int gs) { return gs < 3 ? gs : (gs == 3 ? 4 : (gs == 4 ? 6 : gs + 2)); }


namespace pg8 {
#define PG8_LAS __attribute__((address_space(3)))
constexpr int BM = 256, BK = 64, HALF = 128, HTB = HALF * BK * 2, STAGE_BYTES = 8 * HTB, NXCD = 8, WGM = 8;
DEVI int lds_byte(int r, int c) { const int st = (r >> 4) * 2 + (c >> 5), rr = r & 15, cc = c & 31, ob = rr * 64 + cc * 2; return st * 1024 + (ob ^ (((ob >> 9) & 1) << 5)); }
DEVI void stage_rc(int b, int& R, int& C) { const int st = b / 1024, sb = b % 1024, swz = sb ^ (((sb >> 9) & 1) << 5); R = (st >> 1) * 16 + swz / 64; C = (st & 1) * 32 + (swz % 64) / 2; }
DEVI int perm32(int rho) { const int n = rho >> 4, i = rho & 15; return 8 * (i >> 2) + 4 * n + (i & 3); }
struct Unit { int pm, pn, br, keep; const u16* A; const u16* Bt; };
struct Gemm { const u16* A; const u16* Bt; int M, N, K; };
struct StaticOrder {
  int nM, nN, nwg, G, c; const u16* gA; const u16* gB;
  DEVI void init(int M, int N, int G_, int c_, const u16* A_, const u16* B_) { nM = M / BM; nN = N / BM; nwg = nM * nN; G = G_; c = c_; gA = A_; gB = B_; }
  DEVI bool next(int i, Unit& u) const {
    const long L = (long)i * G + c; if (L >= nwg) return false;
    int wgid = (int)L; { const int q = nwg / NXCD, r = nwg % NXCD, xcd = wgid % NXCD, off = wgid / NXCD; wgid = (xcd < r ? xcd * (q + 1) : r * (q + 1) + (xcd - r) * q) + off; }
    const int nig = WGM * nN, gid = wgid / nig, fm = gid * WGM, gsz = (nM - fm) < WGM ? (nM - fm) : WGM;
    u.pm = fm + ((wgid % nig) % gsz); u.pn = (wgid % nig) / gsz; u.br = 0; u.keep = 0; u.A = gA; u.Bt = gB; return true;
  }
};
DEVI unsigned cvt_pk_bf16(float lo, float hi) { return pack2(lo, hi); }

template <class Epi, class Sched>
DEVI void gemm_phase(PG8_LAS unsigned char* lds, const Gemm g, const Sched& S, const Epi& E) {
  const int tid = tid_l(), wid = __builtin_amdgcn_readfirstlane(tid >> 6), lane = tid & 63, wr = wid >> 2, wc = wid & 3, fr = lane & 15, fq = lane >> 4;
  const int K = g.K, nt = K / BK;
  unsigned voffA[2], voffB[2];
#pragma unroll
  for (int i = 0; i < 2; ++i) { int R, C; stage_rc(tid * 16 + i * 8192, R, C); const int Rb = Epi::PERM ? ((R & ~31) + perm32(R & 31)) : R;
    voffA[i] = (unsigned)(R * K + C) * 2u; voffB[i] = (unsigned)(Rb * K + C) * 2u; }
  const size_t kstep = (size_t)(BK * 2);
  const size_t hstep = (size_t)HALF * K * 2;
  const size_t tstep = 2 * hstep;
  const unsigned ldsw = (unsigned)wid * 1024u;
  const int aoff = lds_byte(wr * 64 + fr, fq * 8), boff = lds_byte(wc * 32 + fr, fq * 8);
#define PG8_SA(b, h) (((b) * 2 + (h)) * HTB)
#define PG8_SB(b, h) ((4 + (b) * 2 + (h)) * HTB)
#define PG8_STAGE(bufoff, gbase, voff) do { _Pragma("unroll") for (int _i = 0; _i < 2; ++_i) \
    __builtin_amdgcn_global_load_lds((const unsigned*)((const char*)(gbase) + (voff)[_i]), (PG8_LAS unsigned*)(lds + (bufoff) + ldsw + _i * 8192), 16, 0, 0); } while (0)
#define PG8_LDA(dst, b, h) do { _Pragma("unroll") for (int m = 0; m < 4; ++m) _Pragma("unroll") for (int k = 0; k < 2; ++k) dst[m][k] = *(const PG8_LAS bf16x8*)(lds + PG8_SA(b, h) + aoff + m * 2048 + k * 1024); } while (0)
#define PG8_LDB(dst, b, h) do { _Pragma("unroll") for (int n = 0; n < 2; ++n) _Pragma("unroll") for (int k = 0; k < 2; ++k) dst[n][k] = *(const PG8_LAS bf16x8*)(lds + PG8_SB(b, h) + boff + n * 2048 + k * 1024); } while (0)
#define PG8_MMA(ai, bj, At, Bt) do { __builtin_amdgcn_s_setprio(1); _Pragma("unroll") for (int m = 0; m < 4; ++m) _Pragma("unroll") for (int n = 0; n < 2; ++n) _Pragma("unroll") for (int k = 0; k < 2; ++k) \
    acc[ai][bj][m][n] = __builtin_amdgcn_mfma_f32_16x16x32_bf16(Bt[n][k], At[m][k], acc[ai][bj][m][n], 0, 0, 0); __builtin_amdgcn_s_setprio(0); } while (0)
#define PG8_WAIT_V(n) asm volatile("s_waitcnt vmcnt(" #n ")" ::: "memory")
#define PG8_WAIT_L(n) asm volatile("s_waitcnt lgkmcnt(" #n ")" ::: "memory")
#define PG8_BAR __builtin_amdgcn_s_barrier()
#define PG8_SCHED __builtin_amdgcn_sched_barrier(0)
  Unit cur, nxt; int ui = 0;
  if (!S.next(0, cur)) return;
  f32x4 acc[2][2][4][2];
#pragma unroll
  for (int a = 0; a < 2; ++a)
#pragma unroll
    for (int b = 0; b < 2; ++b)
#pragma unroll
      for (int m = 0; m < 4; ++m)
#pragma unroll
        for (int n = 0; n < 2; ++n) acc[a][b][m][n] = (f32x4){0.f, 0.f, 0.f, 0.f};
  bf16x8 At[4][2], B0[2][2], B1[2][2];
  const char* cA = (const char*)cur.A + (size_t)cur.pm * tstep; const char* cB = (const char*)cur.Bt + (size_t)cur.pn * tstep;
  PG8_STAGE(PG8_SB(0, 0), cB, voffB); PG8_STAGE(PG8_SA(0, 0), cA, voffA); PG8_STAGE(PG8_SB(0, 1), cB + hstep, voffB); PG8_STAGE(PG8_SA(0, 1), cA + hstep, voffA);
  if (wr == 1) PG8_BAR;
  PG8_WAIT_V(4); PG8_BAR;
  PG8_STAGE(PG8_SB(1, 0), cB + kstep, voffB); PG8_STAGE(PG8_SA(1, 0), cA + kstep, voffA); PG8_STAGE(PG8_SB(1, 1), cB + hstep + kstep, voffB);
  PG8_WAIT_V(6); PG8_BAR;
  for (;;) {
    const bool has_next = S.next(ui + 1, nxt);
    const char* nA = has_next ? (const char*)nxt.A + (size_t)nxt.pm * tstep : cA; const char* nB = has_next ? (const char*)nxt.Bt + (size_t)nxt.pn * tstep : cB;
    for (int t = 0; t < nt; t += 2) {
      const bool last = (t == nt - 2);
      const char* a1 = cA + (size_t)(t + 1) * kstep;
      const char* a2 = last ? nA : cA + (size_t)(t + 2) * kstep; const char* b2 = last ? nB : cB + (size_t)(t + 2) * kstep;
      const char* a3 = a2 + kstep; const char* b3 = b2 + kstep;
      PG8_LDB(B0, 0, 0); PG8_SCHED; PG8_LDA(At, 0, 0); PG8_STAGE(PG8_SA(1, 1), a1 + hstep, voffA);
      PG8_WAIT_L(8); PG8_BAR; PG8_WAIT_L(0); PG8_MMA(0, 0, At, B0); PG8_BAR; PG8_SCHED;
      PG8_LDB(B1, 0, 1); PG8_STAGE(PG8_SB(0, 0), b2, voffB);
      PG8_BAR; PG8_WAIT_L(0); PG8_MMA(0, 1, At, B1); PG8_BAR;
      PG8_LDA(At, 0, 1); PG8_STAGE(PG8_SA(0, 0), a2, voffA);
      PG8_BAR; PG8_WAIT_L(0); PG8_MMA(1, 0, At, B0); PG8_BAR; PG8_SCHED;
      PG8_STAGE(PG8_SB(0, 1), b2 + hstep, voffB);
      PG8_WAIT_V(6); PG8_BAR; PG8_MMA(1, 1, At, B1); PG8_BAR;
      PG8_LDB(B0, 1, 0); PG8_SCHED; PG8_LDA(At, 1, 0); PG8_STAGE(PG8_SA(0, 1), a2 + hstep, voffA);
      PG8_WAIT_L(8); PG8_BAR; PG8_WAIT_L(0); PG8_MMA(0, 0, At, B0); PG8_BAR; PG8_SCHED;
      PG8_LDB(B1, 1, 1); PG8_STAGE(PG8_SB(1, 0), b3, voffB);
      PG8_BAR; PG8_WAIT_L(0); PG8_MMA(0, 1, At, B1); PG8_BAR;
      PG8_LDA(At, 1, 1); PG8_STAGE(PG8_SA(1, 0), a3, voffA);
      PG8_BAR; PG8_WAIT_L(0); PG8_MMA(1, 0, At, B0); PG8_BAR; PG8_SCHED;
      PG8_STAGE(PG8_SB(1, 1), b3 + hstep, voffB);
      PG8_WAIT_V(6); PG8_BAR; PG8_MMA(1, 1, At, B1); PG8_BAR;
    }
    if (!cur.keep) E(acc, cur, wr, wc, fr, fq);
    if (!has_next) break;
    if (!cur.keep) {
#pragma unroll
      for (int a = 0; a < 2; ++a)
#pragma unroll
        for (int b = 0; b < 2; ++b)
#pragma unroll
          for (int m = 0; m < 4; ++m)
#pragma unroll
            for (int n = 0; n < 2; ++n) acc[a][b][m][n] = (f32x4){0.f, 0.f, 0.f, 0.f};
    }
    cur = nxt; cA = nA; cB = nB; ++ui;
  }
  PG8_WAIT_V(0);
  if (wr == 0) PG8_BAR;
  PG8_BAR;
#undef PG8_SA
#undef PG8_SB
#undef PG8_STAGE
#undef PG8_LDA
#undef PG8_LDB
#undef PG8_MMA
#undef PG8_WAIT_V
#undef PG8_WAIT_L
#undef PG8_BAR
#undef PG8_SCHED
}

DEVI u4 pack8acc(f32x4 v0, f32x4 v1) { u4 o; o.x = cvt_pk_bf16(v0[0], v0[1]); o.y = cvt_pk_bf16(v0[2], v0[3]); o.z = cvt_pk_bf16(v1[0], v1[1]); o.w = cvt_pk_bf16(v1[2], v1[3]); return o; }
struct EpiProj {
  static constexpr bool PERM = true;
  u16* sec; u16* halo;
  DEVI void operator()(const f32x4 (&acc)[2][2][4][2], const Unit& u, int wr, int wc, int fr, int fq) const {
    const int s = u.pn >> 1, cb = (u.pn & 1) * 256 + wc * 32 + 8 * fq;
    u16* dst = sec + (size_t)s * SECE;
#pragma unroll
    for (int ai = 0; ai < 2; ++ai)
#pragma unroll
      for (int m = 0; m < 4; ++m) {
        const int row = u.pm * 256 + ai * 128 + wr * 64 + m * 16 + fr;
        const bool hl = (s < 3) && ((row & 63) >= 61);
#pragma unroll
        for (int bj = 0; bj < 2; ++bj) {
          const u4 o = pack8acc(acc[ai][bj][m][0], acc[ai][bj][m][1]);
          *(u4*)(dst + (size_t)row * 512 + cb + bj * 128) = o;
          if (hl) *(u4*)(halo + ((size_t)(row >> 6) * 3 + ((row & 63) - 61)) * 1536 + s * 512 + cb + bj * 128) = o;
        }
      }
  }
};
struct EpiGates {
  static constexpr bool PERM = true;
  u16* sec;
  DEVI void operator()(const f32x4 (&acc)[2][2][4][2], const Unit& u, int wr, int wc, int fr, int fq) const {
    const int cb = (u.pn & 1) * 256 + wc * 32 + 8 * fq;
    u16* dst = sec + (size_t)gate_sec(u.pn >> 1) * SECE;
#pragma unroll
    for (int ai = 0; ai < 2; ++ai)
#pragma unroll
      for (int m = 0; m < 4; ++m) {
        const int row = u.pm * 256 + ai * 128 + wr * 64 + m * 16 + fr;
#pragma unroll
        for (int bj = 0; bj < 2; ++bj) {
          f32x4 v0 = acc[ai][bj][m][0], v1 = acc[ai][bj][m][1];
#pragma unroll
          for (int e = 0; e < 4; ++e) { v0[e] = __builtin_amdgcn_rcpf(1.f + __expf(-v0[e])); v1[e] = __builtin_amdgcn_rcpf(1.f + __expf(-v1[e])); }
          *(u4*)(dst + (size_t)row * 512 + cb + bj * 128) = pack8acc(v0, v1);
        }
      }
  }
};
struct EpiMlp1 {
  static constexpr bool PERM = true;
  u16* hid; const float* rowss; const float* bias2;
  DEVI void operator()(const f32x4 (&acc)[2][2][4][2], const Unit& u, int wr, int wc, int fr, int fq) const {
    const int cb = u.pn * 256 + wc * 32 + 8 * fq;
    const int b = (u.pm * 256) >> 13;
    const int lane = fq * 16 + fr;
    float rs[2];
#pragma unroll
    for (int ai = 0; ai < 2; ++ai) {
      const float* rp = rowss + (size_t)(u.pm * 256 + ai * 128 + wr * 64 + lane) * 16;
      const f32x4 p0 = *(const f32x4*)rp, p1 = *(const f32x4*)(rp + 4), p2 = *(const f32x4*)(rp + 8), p3 = *(const f32x4*)(rp + 12);
      const float ssum = (p0[0] + p0[1] + p0[2] + p0[3]) + (p1[0] + p1[1] + p1[2] + p1[3]) + (p2[0] + p2[1] + p2[2] + p2[3]) + (p3[0] + p3[1] + p3[2] + p3[3]);
      rs[ai] = rsqrtf(ssum * (1.f / 1024.f) + 1e-6f);
    }
    f32x4 bv[2][2];
#pragma unroll
    for (int bj = 0; bj < 2; ++bj)
#pragma unroll
      for (int n = 0; n < 2; ++n) bv[bj][n] = *(const f32x4*)(bias2 + (size_t)b * 4096 + cb + bj * 128 + 4 * n);
#pragma unroll
    for (int ai = 0; ai < 2; ++ai)
#pragma unroll
      for (int m = 0; m < 4; ++m) {
        const int row = u.pm * 256 + ai * 128 + wr * 64 + m * 16 + fr;
        const float r = __shfl(rs[ai], m * 16 + fr);
#pragma unroll
        for (int bj = 0; bj < 2; ++bj) {
          f32x4 v0 = acc[ai][bj][m][0] * r + bv[bj][0], v1 = acc[ai][bj][m][1] * r + bv[bj][1];
#pragma unroll
          for (int e = 0; e < 4; ++e) { const float a = fmaxf(v0[e], 0.f), c = fmaxf(v1[e], 0.f); v0[e] = a * a; v1[e] = c * c; }
          *(u4*)(hid + (size_t)row * 4096 + cb + bj * 128) = pack8acc(v0, v1);
        }
      }
  }
};
struct EpiResidXs {
  static constexpr bool PERM = false;
  const float* xin; float* out; const float* gate; const float* sc2g; const float* sc2s; u16* xs; float* rowss;
  DEVI void operator()(const f32x4 (&acc)[2][2][4][2], const Unit& u, int wr, int wc, int fr, int fq) const {
    const int b = (u.pm * 256) >> 13;
    const int cb = u.pn * 256 + wc * 32 + 4 * fq;
    f32x4 gv[2][2], sc[2][2];
#pragma unroll
    for (int bj = 0; bj < 2; ++bj)
#pragma unroll
      for (int n = 0; n < 2; ++n) {
        gv[bj][n] = *(const f32x4*)(gate + (size_t)b * 6144 + cb + bj * 128 + n * 16);
        sc[bj][n] = *(const f32x4*)(sc2g + cb + bj * 128 + n * 16) * (*(const f32x4*)(sc2s + (size_t)b * 6144 + cb + bj * 128 + n * 16) + 1.f);
      }
#pragma unroll
    for (int am = 0; am < 8; ++am) {
      const int ai = am >> 2, m = am & 3;
      const int row = u.pm * 256 + ai * 128 + wr * 64 + m * 16 + fr;
      const size_t ro = (size_t)row * 1024 + cb;
      f32x4 xv[2][2];
#pragma unroll
      for (int bj = 0; bj < 2; ++bj)
#pragma unroll
        for (int n = 0; n < 2; ++n) xv[bj][n] = *(const f32x4*)(xin + ro + bj * 128 + n * 16);
      float ssq = 0.f;
#pragma unroll
      for (int bj = 0; bj < 2; ++bj)
#pragma unroll
        for (int n = 0; n < 2; ++n) {
          const f32x4 v = xv[bj][n] + gv[bj][n] * acc[ai][bj][m][n];
          *(f32x4*)(out + ro + bj * 128 + n * 16) = v;
          ssq += v[0] * v[0] + v[1] * v[1] + v[2] * v[2] + v[3] * v[3];
          const f32x4 w = v * sc[bj][n];
          u2 o; o.x = cvt_pk_bf16(w[0], w[1]); o.y = cvt_pk_bf16(w[2], w[3]);
          *(u2*)(xs + ro + bj * 128 + n * 16) = o;
        }
      ssq += __shfl_xor(ssq, 16); ssq += __shfl_xor(ssq, 32);
      if (fq == 0) rowss[(size_t)row * 16 + u.pn * 4 + wc] = ssq;
    }
  }
};
struct EpiResid {
  static constexpr bool PERM = false;
  const float* xin; float* out; const float* gate;
  DEVI void operator()(const f32x4 (&acc)[2][2][4][2], const Unit& u, int wr, int wc, int fr, int fq) const {
    const int b = (u.pm * 256) >> 13;
    const int cb = u.pn * 256 + wc * 32 + 4 * fq;
    f32x4 gv[2][2];
#pragma unroll
    for (int bj = 0; bj < 2; ++bj)
#pragma unroll
      for (int n = 0; n < 2; ++n) gv[bj][n] = *(const f32x4*)(gate + (size_t)b * 6144 + cb + bj * 128 + n * 16);
#pragma unroll
    for (int am = 0; am < 4; ++am) {
      const int ai = am >> 1, m0 = (am & 1) * 2;
      f32x4 xv[2][2][2];
#pragma unroll
      for (int mm = 0; mm < 2; ++mm) {
        const size_t ro = (size_t)(u.pm * 256 + ai * 128 + wr * 64 + (m0 + mm) * 16 + fr) * 1024 + cb;
#pragma unroll
        for (int bj = 0; bj < 2; ++bj)
#pragma unroll
          for (int n = 0; n < 2; ++n) xv[mm][bj][n] = *(const f32x4*)(xin + ro + bj * 128 + n * 16);
      }
#pragma unroll
      for (int mm = 0; mm < 2; ++mm) {
        const size_t ro = (size_t)(u.pm * 256 + ai * 128 + wr * 64 + (m0 + mm) * 16 + fr) * 1024 + cb;
#pragma unroll
        for (int bj = 0; bj < 2; ++bj)
#pragma unroll
          for (int n = 0; n < 2; ++n) *(f32x4*)(out + ro + bj * 128 + n * 16) = xv[mm][bj][n] + gv[bj][n] * acc[ai][bj][m0 + mm][n];
      }
    }
  }
};

struct HalfKOrder {
  StaticOrder base; size_t aPlane, bPlane;
  DEVI bool next(int i, Unit& u) const {
    if (!base.next(i >> 1, u)) return false;
    const int hf = i & 1;
    u.A += (size_t)hf * aPlane; u.Bt += (size_t)hf * bPlane; u.keep = hf == 0;
    return true;
  }
};
struct FusedOrder {
  int G, c; const u16 *y0, *y1, *Wbr, *hA, *Wg;
  static constexpr size_t aPlane = 8388608, bPlane = (size_t)9728 * 512;
  DEVI bool next(int i, Unit& u) const {
    const int tile = c + (i / 12) * G; if (tile >= 256) return false;
    const int sub = i % 12, b = sub / 3, r = sub % 3;
    u.pm = tile >> 2; u.pn = tile & 3;
    if (r < 2) { u.A = hA + (size_t)r * aPlane; u.Bt = Wg + (size_t)r * bPlane + (size_t)b * 1024 * 512; u.keep = r == 0; u.br = b * 2; }
    else {
      const u16* sb = y0; const u16* yb = y1;
      asm volatile("" : "+s"(sb)); asm volatile("" : "+s"(yb));
      const size_t so = b == 0 ? 0 : (b == 2 ? 2 * SECE : 7 * SECE);
      u.A = (b == 1) ? yb : sb + so;
      u.Bt = Wbr + (size_t)b * 1024 * 512; u.keep = 0; u.br = b * 2 + 1;
    }
    return true;
  }
};
struct EpiFused {
  static constexpr bool PERM = true;
  u16* scratch; u16* mg;
  DEVI void operator()(const f32x4 (&acc)[2][2][4][2], const Unit& u, int wr, int wc, int fr_, int fq_) const {
    int ln_ = fq_ * 16 + fr_; asm volatile("" : "+v"(ln_));
    const int fr = ln_ & 15, fq = ln_ >> 4;
    const int tid = (wr * 4 + wc) * 64 + fq * 16 + fr;
    u16* sp = scratch + (size_t)blockIdx.x * 65536 + tid * 8;
    if ((u.br & 1) == 0) {
#pragma unroll
      for (int ai = 0; ai < 2; ++ai)
#pragma unroll
        for (int m = 0; m < 4; ++m)
#pragma unroll
          for (int bj = 0; bj < 2; ++bj) {
            f32x4 v0 = acc[ai][bj][m][0], v1 = acc[ai][bj][m][1];
#pragma unroll
            for (int e2 = 0; e2 < 4; ++e2) { v0[e2] = sigmf(v0[e2]); v1[e2] = sigmf(v1[e2]); }
            *(u4*)(sp + ((ai * 4 + m) * 2 + bj) * 4096) = pack8acc(v0, v1);
          }
    } else {
      const int cg0 = u.pn * 256 + wc * 32 + 8 * fq;
      const bool first = (u.br >> 1) == 0;
#pragma unroll
      for (int am = 0; am < 4; ++am) {
        const int ai = am >> 1, m0 = (am & 1) * 2;
        u4 gq[2][2], hq[2][2];
#pragma unroll
        for (int mm = 0; mm < 2; ++mm) {
          const size_t ro = (size_t)(u.pm * 256 + ai * 128 + wr * 64 + (m0 + mm) * 16 + fr) * 1024 + cg0;
#pragma unroll
          for (int bj = 0; bj < 2; ++bj) {
            gq[mm][bj] = *(const u4*)(sp + ((ai * 4 + m0 + mm) * 2 + bj) * 4096);
            hq[mm][bj] = u4{0, 0, 0, 0};
            if (!first) hq[mm][bj] = *(const u4*)(mg + ro + bj * 128);
          }
        }
#pragma unroll
        for (int mm = 0; mm < 2; ++mm) {
          const int m = m0 + mm;
          const size_t ro = (size_t)(u.pm * 256 + ai * 128 + wr * 64 + m * 16 + fr) * 1024 + cg0;
#pragma unroll
          for (int bj = 0; bj < 2; ++bj) {
            float gv[8], hv[8];
            unpack8(gq[mm][bj], gv); unpack8(hq[mm][bj], hv);
            f32x4 v0 = acc[ai][bj][m][0], v1 = acc[ai][bj][m][1];
#pragma unroll
            for (int e2 = 0; e2 < 4; ++e2) { v0[e2] = hv[e2] + gv[e2] * v0[e2]; v1[e2] = hv[4 + e2] + gv[4 + e2] * v1[e2]; }
            *(u4*)(mg + ro + bj * 128) = pack8acc(v0, v1);
          }
        }
      }
    }
  }
};
struct MergeOrder {
  int G, c; const u16* yA[4]; const u16* Wbr;
  DEVI bool next(int i, Unit& u) const {
    const int tile = c + (i >> 2) * G; if (tile >= 256) return false;
    const int b = i & 3;
    u.pm = tile >> 2; u.pn = tile & 3; u.br = b; u.keep = 0;
    u.A = b == 0 ? yA[0] : (b == 1 ? yA[1] : (b == 2 ? yA[2] : yA[3]));
    u.Bt = Wbr + (size_t)b * 1024 * 512;
    return true;
  }
};
struct EpiMerge {
  static constexpr bool PERM = true;
  const u16* sec; u16* hb;
  DEVI void operator()(const f32x4 (&acc)[2][2][4][2], const Unit& u, int wr, int wc, int fr, int fq) const {
    const int cg0 = u.pn * 256 + wc * 32 + 8 * fq;
    const u16* gs = sec + (size_t)gate_sec(u.br * 2 + (cg0 >> 9)) * SECE + (cg0 & 511);
    const bool first = (u.br == 0);
#pragma unroll
    for (int am = 0; am < 4; ++am) {
      const int ai = am >> 1, m0 = (am & 1) * 2;
      u4 gq[2][2], hq[2][2];
#pragma unroll
      for (int mm = 0; mm < 2; ++mm) {
        const int row = u.pm * 256 + ai * 128 + wr * 64 + (m0 + mm) * 16 + fr;
#pragma unroll
        for (int bj = 0; bj < 2; ++bj) {
          gq[mm][bj] = *(const u4*)(gs + (size_t)row * 512 + bj * 128);
          hq[mm][bj] = u4{0, 0, 0, 0};
          if (!first) hq[mm][bj] = *(const u4*)(hb + (size_t)row * 1024 + cg0 + bj * 128);
        }
      }
#pragma unroll
      for (int mm = 0; mm < 2; ++mm) {
        const int m = m0 + mm;
        const int row = u.pm * 256 + ai * 128 + wr * 64 + m * 16 + fr;
#pragma unroll
        for (int bj = 0; bj < 2; ++bj) {
          float gv[8], hv[8];
          unpack8(gq[mm][bj], gv); unpack8(hq[mm][bj], hv);
          f32x4 v0 = acc[ai][bj][m][0], v1 = acc[ai][bj][m][1];
#pragma unroll
          for (int e = 0; e < 4; ++e) { v0[e] = hv[e] + gv[e] * v0[e]; v1[e] = hv[4 + e] + gv[4 + e] * v1[e]; }
          *(u4*)(hb + (size_t)row * 1024 + cg0 + bj * 128) = pack8acc(v0, v1);
        }
      }
    }
  }
};
}

DEVI void proj_phase(const P& p, unsigned char* smem) {
  pg8::HalfKOrder S; S.base.init(16384, 5632, gridDim.x, blockIdx.x, p.h, p.WinT); S.aPlane = 8388608; S.bPlane = (size_t)9728 * 512;
  const pg8::Gemm g{p.h, p.WinT, 16384, 5632, 512};
  const pg8::EpiProj E{p.sec, p.halo};
  pg8::gemm_phase((PG8_LAS unsigned char*)smem, g, S, E);
}
DEVI void gates_phase(const P& p, unsigned char* smem) {
  pg8::StaticOrder S; S.init(16384, 4096, gridDim.x, blockIdx.x, p.h, p.WinT + (size_t)5632 * 1024);
  const pg8::Gemm g{p.h, p.WinT + (size_t)5632 * 1024, 16384, 4096, 1024};
  const pg8::EpiGates E{p.sec};
  pg8::gemm_phase((PG8_LAS unsigned char*)smem, g, S, E);
}
DEVI void merge_phase(const P& p, unsigned char* smem) {
  pg8::FusedOrder S;
  S.G = gridDim.x; S.c = blockIdx.x; S.y0 = p.sec + 3 * SECE; S.y1 = p.YB; S.Wbr = p.WbrT;
  S.hA = p.h; S.Wg = p.WinT + (size_t)5632 * 512;
  const pg8::Gemm g{p.YB, p.WbrT, 16384, 1024, 512};
  const pg8::EpiFused E{p.sec + 6 * SECE, p.sec};
  pg8::gemm_phase((PG8_LAS unsigned char*)smem, g, S, E);
}
DEVI void resid_gemm_phase(const P& p, int l, int which, unsigned char* smem) {
  pg8::StaticOrder S; S.init(16384, 1024, gridDim.x, blockIdx.x, p.sec, which == 0 ? p.WoutT : p.W2T);
  const pg8::Gemm g{p.sec, which == 0 ? p.WoutT : p.W2T, 16384, 1024, which == 0 ? 1024 : 4096};
  const float* modl = p.modp + (size_t)l * 2 * 6144;
  if (which == 0) {
    const pg8::EpiResidXs E{l == 0 ? p.x : p.out, p.out, modl + 2 * 1024, p.norm2_g + l * 1024, modl + 4 * 1024, p.sec + 8 * SECE, p.rowss};
    pg8::gemm_phase((PG8_LAS unsigned char*)smem, g, S, E);
  } else {
    const pg8::EpiResid E{p.out, p.out, modl + 5 * 1024};
    pg8::gemm_phase((PG8_LAS unsigned char*)smem, g, S, E);
  }
}
DEVI void mlp1_phase(const P& p, unsigned char* smem) {
  pg8::StaticOrder S; S.init(16384, 4096, gridDim.x, blockIdx.x, p.sec + 8 * SECE, p.W1T);
  const pg8::Gemm g{p.sec + 8 * SECE, p.W1T, 16384, 4096, 1024};
  const pg8::EpiMlp1 E{p.sec, p.rowss, p.modp + 32768};
  pg8::gemm_phase((PG8_LAS unsigned char*)smem, g, S, E);
}
DEVI void bias2_unit(const P& p, int l, int u) {
  const int t = tid_l(), lane = t & 63, wid = t >> 6;
  float sh0[16], sh1[16];
#pragma unroll
  for (int j = 0; j < 16; ++j) { sh0[j] = modval(p, l, 0, 3 * 1024 + lane * 16 + j); sh1[j] = modval(p, l, 1, 3 * 1024 + lane * 16 + j); }
#pragma unroll 1
  for (int c = 0; c < 8; ++c) {
    const int n = u * 64 + wid * 8 + c;
    float w[16];
    const u16* wp = p.W1T + (size_t)n * 1024 + lane * 16;
    unpack8(*(const u4*)wp, w); unpack8(*(const u4*)(wp + 8), w + 8);
    float a0 = 0.f, a1 = 0.f;
#pragma unroll
    for (int j = 0; j < 16; ++j) { a0 += sh0[j] * w[j]; a1 += sh1[j] * w[j]; }
    a0 = wave_sum(a0); a1 = wave_sum(a1);
    if (lane == 0) { p.modp[32768 + n] = a0; p.modp[32768 + 4096 + n] = a1; }
  }
}

DEVI bf16x8 acc2frag(f32x4 t0, f32x4 t1, float sgn) {
  u4 o; o.x = pack2(sgn * t0[0], sgn * t0[1]); o.y = pack2(sgn * t0[2], sgn * t0[3]); o.z = pack2(sgn * t1[0], sgn * t1[1]); o.w = pack2(sgn * t1[2], sgn * t1[3]);
  return *(bf16x8*)&o;
}
DEVI void dn_prep_unit(const P& p, int l, int u, unsigned char* smem) {
  const int t = tid_l(), lane = t & 63, wid = t >> 6, mr = lane & 15, g = lane >> 4;
  const int h = u & 3, n = (u >> 2) & 127, b = u >> 9;
  const int r0 = b * SEQ + n * 64;
  float* Lm = (float*)smem;
  float* cw = Lm + 64 * 64;
  float* gcs = cw + 1536;
  u16* Qs = (u16*)(gcs + 128);
  u16* Ks = Qs + 64 * 136;
  u16* KTl = Ks + 64 * 136;
  u16* VTl = KTl + 128 * 72;
  u16* TB = VTl + 128 * 72;
  u16* TBe = TB + 64 * 72;
  float* bs = gcs + 64;
  for (int i = t; i < 1536; i += NT) {
    const int s = i >> 9, j = (i >> 7) & 3, c = i & 127;
    cw[i] = p.dn_conv_w[(size_t)(l * 4 + j) * 1536 + s * 512 + h * 128 + c];
  }
  if (wid == 0) {
    float gg = p.glog[(size_t)(r0 + lane) * 4 + h];
#pragma unroll
    for (int o = 1; o < 64; o <<= 1) {
      const float v = __shfl_up(gg, o);
      if (lane >= o) gg += v;
    }
    gcs[lane] = gg;
    bs[lane] = p.beta[(size_t)(r0 + lane) * 4 + h];
  }
  __syncthreads();
  const int row = t >> 3, c0 = (t & 7) * 16;
#pragma unroll
  for (int s = 0; s < 3; ++s) {
    const u16* sp = p.sec + (size_t)s * SECE;
    float y[16];
#pragma unroll
    for (int c = 0; c < 16; ++c) y[c] = 0.f;
#pragma unroll
    for (int j = 0; j < 4; ++j) {
      const int tt = row - 3 + j;
      u4 v0 = {0, 0, 0, 0}, v1 = {0, 0, 0, 0};
      if (tt >= 0) {
        const u16* src = sp + (size_t)(r0 + tt) * 512 + h * 128 + c0;
        v0 = *(const u4*)src; v1 = *(const u4*)(src + 8);
      } else if (n > 0) {
        const u16* src = p.halo + ((size_t)((r0 >> 6) - 1) * 3 + (tt + 3)) * 1536 + s * 512 + h * 128 + c0;
        v0 = *(const u4*)src; v1 = *(const u4*)(src + 8);
      }
      float f[16];
      unpack8(v0, f); unpack8(v1, f + 8);
#pragma unroll
      for (int c = 0; c < 16; ++c) y[c] += cw[(s * 4 + j) * 128 + c0 + c] * f[c];
    }
    float ss = 0.f;
#pragma unroll
    for (int c = 0; c < 16; ++c) { y[c] = siluf(y[c]); ss += y[c] * y[c]; }
    if (s < 2) {
      ss += __shfl_xor(ss, 1); ss += __shfl_xor(ss, 2); ss += __shfl_xor(ss, 4);
      const float sc = rsqrtf(ss + 1e-6f) * (s == 0 ? 0.08838834764831845f : 1.f);
#pragma unroll
      for (int c = 0; c < 16; ++c) y[c] *= sc;
    }
    if (s < 2) {
      u16* dl = (s == 0 ? Qs : Ks) + row * 136 + c0;
      *(u4*)dl = pack8(y); *(u4*)(dl + 8) = pack8(y + 8);
    }
    if (s >= 1) {
      u16* dT = (s == 1 ? KTl : VTl);
#pragma unroll
      for (int c = 0; c < 16; ++c) dT[(c0 + c) * 72 + row] = f2bf(y[c]);
    }
  }
  __syncthreads();
#pragma unroll 1
  for (int idx = wid; idx < 10; idx += 8) {
    const int ti = idx >= 6 ? 3 : (idx >= 3 ? 2 : (idx >= 1 ? 1 : 0)), tj = idx - ti * (ti + 1) / 2;
    f32x4 akk = {0.f, 0.f, 0.f, 0.f};
#pragma unroll
    for (int k0 = 0; k0 < 128; k0 += 32) akk = mfma16(frag(Ks, 136, ti * 16, k0, lane), frag(Ks, 136, tj * 16, k0, lane), akk);
    const int j = tj * 16 + mr;
#pragma unroll
    for (int r = 0; r < 4; ++r) {
      const int i = ti * 16 + g * 4 + r;
      Lm[i * 64 + j] = (i > j) ? bs[i] * akk[r] * __expf(gcs[i] - gcs[j]) : 0.f;
    }
  }
  if (wid < 6) {
    const int m = wid < 2 ? wid : (wid < 4 ? 2 : 3), ks2 = wid < 2 ? 0 : ((wid - 2) & 1);
    f32x4 t0 = {0.f, 0.f, 0.f, 0.f}, t1 = {0.f, 0.f, 0.f, 0.f};
#pragma unroll
    for (int k0 = 0; k0 < 128; k0 += 32) {
      const bf16x8 bq = frag(Qs, 136, m * 16, k0, lane);
      t0 = mfma16(frag(Ks, 136, (2 * ks2) * 16, k0, lane), bq, t0);
      t1 = mfma16(frag(Ks, 136, (2 * ks2 + 1) * 16, k0, lane), bq, t1);
    }
    const int i = m * 16 + mr;
    const float gi = gcs[i];
#pragma unroll
    for (int r = 0; r < 4; ++r) {
      const int j0 = 32 * ks2 + 4 * g + r, j1 = j0 + 16;
      t0[r] = (i >= j0) ? t0[r] * __expf(gi - gcs[j0]) : 0.f;
      t1[r] = (i >= j1) ? t1[r] * __expf(gi - gcs[j1]) : 0.f;
    }
    *(bf16x8*)(p.QKF + (size_t)u * 3072 + wid * 512 + lane * 8) = acc2frag(t0, t1, 1.f);
  }
  __syncthreads();
  {
    typedef float f32x16 __attribute__((ext_vector_type(16)));
    float* Tf = (float*)(TBe + 64 * 72);
    float* Xf = Tf + 2048;
    if (wid < 2 && lane < 32) {
      const int o = wid * 32;
      float T[32];
#pragma unroll
      for (int i = 0; i < 32; ++i) {
        float s0 = (i == lane) ? 1.f : 0.f, s1 = 0.f, s2 = 0.f, s3 = 0.f;
#pragma unroll
        for (int j = 0; j < i; ++j) {
          const float lt = Lm[(o + i) * 64 + o + j] * T[j];
          if ((j & 3) == 0) s0 -= lt; else if ((j & 3) == 1) s1 -= lt; else if ((j & 3) == 2) s2 -= lt; else s3 -= lt;
        }
        T[i] = (s0 + s1) + (s2 + s3);
      }
#pragma unroll
      for (int i = 0; i < 32; ++i) Tf[wid * 1024 + i * 32 + lane] = T[i];
    }
    __syncthreads();
    if (wid == 0) {
      const int li = lane & 31, lh = lane >> 5;
      f32x16 acc;
#pragma unroll
      for (int r = 0; r < 16; ++r) acc[r] = 0.f;
#pragma unroll
      for (int kk = 0; kk < 16; ++kk)
        acc = __builtin_amdgcn_mfma_f32_32x32x2f32(Lm[(32 + li) * 64 + 2 * kk + lh], Tf[(2 * kk + lh) * 32 + li], acc, 0, 0, 0);
#pragma unroll
      for (int r = 0; r < 16; ++r) Xf[((r & 3) + 8 * (r >> 2) + 4 * lh) * 32 + li] = acc[r];
      asm volatile("s_waitcnt lgkmcnt(0)" ::: "memory");
      f32x16 acc2;
#pragma unroll
      for (int r = 0; r < 16; ++r) acc2[r] = 0.f;
#pragma unroll
      for (int kk = 0; kk < 16; ++kk)
        acc2 = __builtin_amdgcn_mfma_f32_32x32x2f32(Tf[1024 + li * 32 + 2 * kk + lh], Xf[(2 * kk + lh) * 32 + li], acc2, 0, 0, 0);
#pragma unroll
      for (int r = 0; r < 16; ++r) Lm[(32 + (r & 3) + 8 * (r >> 2) + 4 * lh) * 64 + li] = -acc2[r];
    }
    __syncthreads();
#pragma unroll
    for (int q = 0; q < 8; ++q) {
      const int idx = t + q * NT, i = idx >> 6, j = idx & 63;
      float val = 0.f;
      if (i < 32) { if (j < 32) val = Tf[i * 32 + j]; }
      else if (j >= 32) val = Tf[1024 + (i - 32) * 32 + (j - 32)];
      else val = Lm[i * 64 + j];
      const float bl = bs[j];
      TB[i * 72 + j] = f2bf(val * bl);
      TBe[i * 72 + j] = f2bf(val * bl * __expf(gcs[j]));
    }
  }
  __syncthreads();
  const size_t rbase = (size_t)r0 * 512 + h * 128;
  u16* secQ = p.sec + rbase;
  u16* secW = p.sec + SECE + rbase;
  u16* secK = p.sec + 2 * SECE + rbase;
  const size_t fo = (size_t)(lane >> 4) * 512 + (lane & 15) * 8;
#pragma unroll
  for (int rep = 0; rep < 2; ++rep) {
    const int f = wid + rep * 8;
    {
      const int m = f >> 2, ks = f & 3;
      f32x4 t0 = {0.f, 0.f, 0.f, 0.f}, t1 = {0.f, 0.f, 0.f, 0.f};
#pragma unroll
      for (int k0 = 0; k0 < 64; k0 += 32) {
        const bf16x8 bt = frag(TBe, 72, m * 16, k0, lane);
        t0 = mfma16(frag(KTl, 72, (2 * ks) * 16, k0, lane), bt, t0);
        t1 = mfma16(frag(KTl, 72, (2 * ks + 1) * 16, k0, lane), bt, t1);
      }
      *(bf16x8*)(secW + (size_t)(4 * f) * 512 + fo) = acc2frag(t0, t1, -1.f);
    }
    {
      const int m = f >> 2, ks = f & 3, pos = m * 16 + mr;
      const float eg = __expf(gcs[pos]);
      const u2 a = *(const u2*)(Qs + pos * 136 + 32 * ks + 4 * g), c = *(const u2*)(Qs + pos * 136 + 32 * ks + 16 + 4 * g);
      u4 o;
      o.x = pack2(eg * lo2f(a.x), eg * hi2f(a.x)); o.y = pack2(eg * lo2f(a.y), eg * hi2f(a.y));
      o.z = pack2(eg * lo2f(c.x), eg * hi2f(c.x)); o.w = pack2(eg * lo2f(c.y), eg * hi2f(c.y));
      *(u4*)(secQ + (size_t)(4 * f) * 512 + fo) = o;
    }
    {
      const int d = f >> 1, ks2 = f & 1, dk = d * 16 + mr;
      const float G = gcs[63];
      const u2 a = *(const u2*)(KTl + dk * 72 + 32 * ks2 + 4 * g), c = *(const u2*)(KTl + dk * 72 + 32 * ks2 + 16 + 4 * g);
      const int p0 = 32 * ks2 + 4 * g, p1 = p0 + 16;
      u4 o;
      o.x = pack2(__expf(G - gcs[p0]) * lo2f(a.x), __expf(G - gcs[p0 + 1]) * hi2f(a.x));
      o.y = pack2(__expf(G - gcs[p0 + 2]) * lo2f(a.y), __expf(G - gcs[p0 + 3]) * hi2f(a.y));
      o.z = pack2(__expf(G - gcs[p1]) * lo2f(c.x), __expf(G - gcs[p1 + 1]) * hi2f(c.x));
      o.w = pack2(__expf(G - gcs[p1 + 2]) * lo2f(c.y), __expf(G - gcs[p1 + 3]) * hi2f(c.y));
      *(u4*)(secK + (size_t)(4 * f) * 512 + fo) = o;
    }
  }
  {
    u16* ud = p.TQ + (size_t)u * 8192 + wid * 1024 + lane * 16;
#pragma unroll
    for (int m = 0; m < 4; ++m) {
      f32x4 a = {0.f, 0.f, 0.f, 0.f};
#pragma unroll
      for (int k0 = 0; k0 < 64; k0 += 32) a = mfma16(frag(TB, 72, m * 16, k0, lane), frag(VTl, 72, wid * 16, k0, lane), a);
      *(u2*)(ud + m * 4) = pack4v(a);
    }
  }
  if (t == 0) p.EG[u] = __expf(gcs[63]);
  __syncthreads();
}

DEVI void dn_chain(const P& p, int l, int bh, int half, unsigned char* smem) {
  constexpr int NQ = 1;
  const int t = tid_l(), lane = t & 63, wid = __builtin_amdgcn_readfirstlane(t >> 6);
  const int h = bh & 3, b = bh >> 2;
  typedef __attribute__((address_space(3))) unsigned char* LP_;
  LP_ lds = (LP_)smem;
  constexpr int BUFB = 55296;
  const size_t lo = (size_t)(lane >> 4) * 512 + (lane & 15) * 8;
  auto issue = [&](int n, int bi) __attribute__((always_inline)) {
    if (wid >= 4) {
      const int w4 = wid - 4;
      const size_t rbase = ((size_t)b * SEQ + (size_t)n * 64) * 512 + h * 128;
      const size_t unit = ((size_t)b * 128 + n) * 4 + h;
#pragma unroll
      for (int rep = 0; rep < 4; ++rep) {
        const int f = w4 + rep * 4;
        const size_t go = rbase + (size_t)(4 * f) * 512 + lo;
        __builtin_amdgcn_global_load_lds((const unsigned*)(p.sec + SECE + go), (__attribute__((address_space(3))) unsigned*)(lds + bi * BUFB + f * 1024), 16, 0, 0);
        __builtin_amdgcn_global_load_lds((const unsigned*)(p.sec + go), (__attribute__((address_space(3))) unsigned*)(lds + bi * BUFB + 16384 + f * 1024), 16, 0, 0);
        __builtin_amdgcn_global_load_lds((const unsigned*)(p.sec + 2 * SECE + go), (__attribute__((address_space(3))) unsigned*)(lds + bi * BUFB + 32768 + f * 1024), 16, 0, 0);
      }
#pragma unroll
      for (int rep = 0; rep < 2; ++rep) {
        const int f = w4 + rep * 4;
        if (f < 6)
          __builtin_amdgcn_global_load_lds((const unsigned*)(p.QKF + unit * 3072 + f * 512 + lane * 8), (__attribute__((address_space(3))) unsigned*)(lds + bi * BUFB + 49152 + f * 1024), 16, 0, 0);
      }
    }
  };
  const bool cw_ = wid < 4;
  f32x4 Sacc[2][8];
#pragma unroll
  for (int q = 0; q < NQ; ++q)
#pragma unroll
    for (int j = 0; j < 8; ++j) Sacc[q][j] = f32x4{0.f, 0.f, 0.f, 0.f};
  u4 ur[2][2];
  u4 op[2][2];
  float eGn;
  {
    const size_t unit = ((size_t)b * 128) * 4 + h;
    issue(0, 0);
    if (cw_) {
#pragma unroll
      for (int q = 0; q < NQ; ++q) {
        const u16* us = p.TQ + unit * 8192 + (half * 4 + wid * NQ + q) * 1024 + lane * 16;
        ur[q][0] = *(const u4*)us; ur[q][1] = *(const u4*)(us + 8);
      }
    }
    eGn = p.EG[unit];
  }
#pragma unroll 1
  for (int n = 0; n < 128; ++n) {
    asm volatile("s_waitcnt vmcnt(0)" ::: "memory");
    __syncthreads();
    if (t == 256 && (n & 3) == 0) {
      __builtin_amdgcn_fence(__ATOMIC_RELEASE, "agent");
      asm volatile("s_waitcnt vmcnt(0)" ::: "memory");
      __hip_atomic_store(p.prog + (bh * 2 + half) * 16, (unsigned)(n > 0 ? n - 1 : 0), __ATOMIC_RELAXED, __HIP_MEMORY_SCOPE_AGENT);
    }
    if (cw_ && n > 0) {
      const size_t pu = ((size_t)b * 128 + (n - 1)) * 4 + h;
#pragma unroll
      for (int q = 0; q < NQ; ++q) {
        u16* od = p.TQ + pu * 8192 + (half * 4 + wid * NQ + q) * 1024 + lane * 16;
        *(u4*)od = op[q][0]; *(u4*)(od + 8) = op[q][1];
      }
    }
    u4 uc[2][2];
#pragma unroll
    for (int q = 0; q < NQ; ++q) { uc[q][0] = ur[q][0]; uc[q][1] = ur[q][1]; }
    const float eG = eGn;
    const size_t unit = ((size_t)b * 128 + n) * 4 + h;
    if (n + 1 < 128) {
      issue(n + 1, (n + 1) & 1);
      if (cw_) {
#pragma unroll
        for (int q = 0; q < NQ; ++q) {
          const u16* us = p.TQ + (unit + 4) * 8192 + (half * 4 + wid * NQ + q) * 1024 + lane * 16;
          ur[q][0] = *(const u4*)us; ur[q][1] = *(const u4*)(us + 8);
        }
      }
      eGn = p.EG[unit + 4];
    }
    if (cw_) {
      const __attribute__((address_space(3))) unsigned char* bb = lds + (n & 1) * BUFB + lane * 16;
#define LFRAG(off) (*(const __attribute__((address_space(3))) bf16x8*)(bb + (off)))
      bf16x8 Sb[2][4];
#pragma unroll
      for (int q = 0; q < NQ; ++q)
#pragma unroll
        for (int ks = 0; ks < 4; ++ks) Sb[q][ks] = acc2frag(Sacc[q][2 * ks], Sacc[q][2 * ks + 1], 1.f);
      f32x4 accV[2][4], accO[2][4];
#pragma unroll
      for (int q = 0; q < NQ; ++q) {
        accV[q][0] = f32x4{lo2f(uc[q][0].x), hi2f(uc[q][0].x), lo2f(uc[q][0].y), hi2f(uc[q][0].y)};
        accV[q][1] = f32x4{lo2f(uc[q][0].z), hi2f(uc[q][0].z), lo2f(uc[q][0].w), hi2f(uc[q][0].w)};
        accV[q][2] = f32x4{lo2f(uc[q][1].x), hi2f(uc[q][1].x), lo2f(uc[q][1].y), hi2f(uc[q][1].y)};
        accV[q][3] = f32x4{lo2f(uc[q][1].z), hi2f(uc[q][1].z), lo2f(uc[q][1].w), hi2f(uc[q][1].w)};
#pragma unroll
        for (int m = 0; m < 4; ++m) accO[q][m] = f32x4{0.f, 0.f, 0.f, 0.f};
      }
      constexpr int RING = 24;
      bf16x8 R[RING];
      bf16x8 Vb[2][2];
#define FOFF(i) ((i) < 16 ? (((i) & 3) * 4 + ((i) >> 2)) * 1024 : (i) < 32 ? 16384 + ((((i) - 16) & 3) * 4 + (((i) - 16) >> 2)) * 1024 : (i) < 38 ? 49152 + ((i) - 32) * 1024 : 32768 + ((i) - 38) * 1024)
#pragma unroll
      for (int i = 0; i < RING; ++i) R[i] = LFRAG(FOFF(i));
#pragma unroll
      for (int i = 0; i < 54; ++i) {
        const bf16x8 fr = R[i % RING];
        if (i < 16) {
          const int ks = i >> 2, m = i & 3;
#pragma unroll
          for (int q = 0; q < NQ; ++q) accV[q][m] = mfma16(fr, Sb[q][ks], accV[q][m]);
        } else if (i < 32) {
          const int ks = (i - 16) >> 2, m = (i - 16) & 3;
#pragma unroll
          for (int q = 0; q < NQ; ++q) accO[q][m] = mfma16(fr, Sb[q][ks], accO[q][m]);
        } else if (i < 38) {
          const int f = i - 32;
          const int m = f < 2 ? f : (f < 4 ? 2 : 3), k2 = f < 2 ? 0 : ((f - 2) & 1);
#pragma unroll
          for (int q = 0; q < NQ; ++q) accO[q][m] = mfma16(fr, Vb[q][k2], accO[q][m]);
        } else {
          const int j = i - 38, d = j >> 1, k2 = j & 1;
#pragma unroll
          for (int q = 0; q < NQ; ++q) {
            if (k2 == 0) Sacc[q][d] *= eG;
            Sacc[q][d] = mfma16(fr, Vb[q][k2], Sacc[q][d]);
          }
        }
        if (i == 15) {
#pragma unroll
          for (int q = 0; q < NQ; ++q) { Vb[q][0] = acc2frag(accV[q][0], accV[q][1], 1.f); Vb[q][1] = acc2frag(accV[q][2], accV[q][3], 1.f); }
        }
        if (i + RING < 54) R[i % RING] = LFRAG(FOFF(i + RING));
        __builtin_amdgcn_sched_barrier(0);
      }
#undef FOFF
#undef LFRAG
#pragma unroll
      for (int q = 0; q < NQ; ++q) {
        u4 o0, o1;
        o0.x = pack2(accO[q][0][0], accO[q][0][1]); o0.y = pack2(accO[q][0][2], accO[q][0][3]); o0.z = pack2(accO[q][1][0], accO[q][1][1]); o0.w = pack2(accO[q][1][2], accO[q][1][3]);
        o1.x = pack2(accO[q][2][0], accO[q][2][1]); o1.y = pack2(accO[q][2][2], accO[q][2][3]); o1.z = pack2(accO[q][3][0], accO[q][3][1]); o1.w = pack2(accO[q][3][2], accO[q][3][3]);
        op[q][0] = o0; op[q][1] = o1;
      }
    }
  }
  if (cw_) {
    const size_t pu = ((size_t)b * 128 + 127) * 4 + h;
#pragma unroll
    for (int q = 0; q < NQ; ++q) {
      u16* od = p.TQ + pu * 8192 + (half * 4 + wid * NQ + q) * 1024 + lane * 16;
      *(u4*)od = op[q][0]; *(u4*)(od + 8) = op[q][1];
    }
  }
  asm volatile("s_waitcnt vmcnt(0)" ::: "memory");
  __syncthreads();
  if (t == 256) {
    __builtin_amdgcn_fence(__ATOMIC_RELEASE, "agent");
    asm volatile("s_waitcnt vmcnt(0)" ::: "memory");
    __hip_atomic_store(p.prog + (bh * 2 + half) * 16, 128u, __ATOMIC_RELAXED, __HIP_MEMORY_SCOPE_AGENT);
  }
  __syncthreads();
}

DEVI void dn_chain_helper(const P& p, int bh, unsigned char* smem) {
  const int t = tid_l();
  const int h = bh & 3, b = bh >> 2;
  unsigned acc = 0;
#pragma unroll 1
  for (int n = 1; n < 128; ++n) {
    if (t == 0) {
      unsigned polls = 0;
      while ((int)__hip_atomic_load(p.prog + (bh * 2) * 16, __ATOMIC_RELAXED, __HIP_MEMORY_SCOPE_AGENT) + 4 < n && polls < 200000u) { __builtin_amdgcn_s_sleep(4); ++polls; }
    }
    __syncthreads();
    const size_t r0 = (size_t)b * SEQ + (size_t)n * 64;
    const size_t unit = ((size_t)b * 128 + n) * 4 + h;
    const size_t ro = (r0 + (t >> 3)) * 512 + h * 128 + (t & 7) * 16;
#pragma unroll
    for (int s3 = 0; s3 < 3; ++s3) {
      const u4 a = *(const u4*)(p.sec + (size_t)s3 * SECE + ro), c = *(const u4*)(p.sec + (size_t)s3 * SECE + ro + 8);
      acc ^= a.x ^ a.y ^ a.z ^ a.w ^ c.x ^ c.y ^ c.z ^ c.w;
    }
    {
      const u4 a = *(const u4*)(p.TQ + unit * 8192 + (size_t)t * 16), c = *(const u4*)(p.TQ + unit * 8192 + (size_t)t * 16 + 8);
      acc ^= a.x ^ a.y ^ a.z ^ a.w ^ c.x ^ c.y ^ c.z ^ c.w;
      if (t < 384) { const u4 q = *(const u4*)(p.QKF + unit * 3072 + (size_t)t * 8); acc ^= q.x ^ q.y ^ q.z ^ q.w; }
    }
  }
  if (acc == 0x9e3779b9u) p.prog[1024 - 1] = acc;
  __syncthreads();
}

DEVI void ya_unit(const P& p, int l, int u, unsigned char* smem) {
  const int t = tid_l(), lane = t & 63, wid = t >> 6, c = lane & 15, g = lane >> 4;
  const int h = u & 3, n = (u >> 2) & 127, b = u >> 9;
  const int r0 = b * SEQ + n * 64;
  float* part = (float*)smem;
  const u16* os = p.TQ + (size_t)u * 8192 + wid * 1024 + lane * 16;
  float o[16];
  unpack8(*(const u4*)os, o); unpack8(*(const u4*)(os + 8), o + 8);
#pragma unroll
  for (int i = 0; i < 16; ++i) {
    float s = o[i] * o[i];
    s += __shfl_xor(s, 1); s += __shfl_xor(s, 2); s += __shfl_xor(s, 4); s += __shfl_xor(s, 8);
    if (c == 0) part[wid * 64 + (i >> 2) * 16 + g * 4 + (i & 3)] = s;
  }
  __syncthreads();
  const int dv = wid * 16 + c;
  const float ng = p.dn_norm_g[l * 128 + dv];
  u16* zs = p.sec + 3 * SECE + (size_t)r0 * 512 + h * 128 + dv;
  u16 zv[16];
#pragma unroll
  for (int i = 0; i < 16; ++i) zv[i] = zs[(size_t)((i >> 2) * 16 + g * 4 + (i & 3)) * 512];
#pragma unroll
  for (int i = 0; i < 16; ++i) {
    const int pos = (i >> 2) * 16 + g * 4 + (i & 3);
    float ss = 0.f;
#pragma unroll
    for (int w = 0; w < 8; ++w) ss += part[w * 64 + pos];
    const float rs = rsqrtf(ss * (1.f / 128.f) + 1e-6f);
    zs[(size_t)pos * 512] = f2bf(o[i] * rs * ng * siluf(bf2f(zv[i])));
  }
  __syncthreads();
}

DEVI float ret_log2gamma(int h) { return log2f(1.f - exp2f(-5.f - (float)h)); }
DEVI void load_rope_tile(const P& p, const u16* secp, int r0, int h, float scale, u16* dst, u16* dstT, float l2g) {
  const int t = tid_l();
  const int row = t >> 2, j0 = (t & 3) * 16;
  const u16* src = secp + (size_t)(r0 + row) * 512 + h * 128;
  float x1[16], x2[16];
  unpack8(*(const u4*)(src + j0), x1); unpack8(*(const u4*)(src + j0 + 8), x1 + 8);
  unpack8(*(const u4*)(src + 64 + j0), x2); unpack8(*(const u4*)(src + 64 + j0 + 8), x2 + 8);
  const float* cs = p.ropecs + ((size_t)(r0 + row) * 64 + j0) * 2;
  float o1[16], o2[16];
#pragma unroll
  for (int j = 0; j < 16; j += 2) {
    const float4 c4 = *(const float4*)(cs + j * 2);
    o1[j] = (x1[j] * c4.x - x2[j] * c4.y) * scale;
    o2[j] = (x1[j] * c4.y + x2[j] * c4.x) * scale;
    o1[j + 1] = (x1[j + 1] * c4.z - x2[j + 1] * c4.w) * scale;
    o2[j + 1] = (x1[j + 1] * c4.w + x2[j + 1] * c4.z) * scale;
  }
  *(u4*)(dst + row * 136 + j0) = pack8(o1); *(u4*)(dst + row * 136 + j0 + 8) = pack8(o1 + 8);
  *(u4*)(dst + row * 136 + 64 + j0) = pack8(o2); *(u4*)(dst + row * 136 + 64 + j0 + 8) = pack8(o2 + 8);
  if (dstT) {
    const float z = exp2f(l2g * (float)(127 - row));
#pragma unroll
    for (int j = 0; j < 16; ++j) {
      dstT[(j0 + j) * 136 + row] = f2bf(o1[j] * z);
      dstT[(64 + j0 + j) * 136 + row] = f2bf(o2[j] * z);
    }
  }
}
DEVI void ret_d1_unit(const P& p, int u, unsigned char* smem) {
  const int t = tid_l(), lane = t & 63, wid = t >> 6;
  const int h = u & 3, n = (u >> 2) & 63, b = u >> 8;
  const int r0 = b * SEQ + n * 128;
  const float l2g = ret_log2gamma(h);
  u16* Qs = (u16*)smem;
  u16* Ks = Qs + 128 * 136;
  u16* KTz = Ks + 128 * 136;
  u16* VT = KTz + 128 * 136;
  load_rope_tile(p, p.sec + 7 * SECE, r0, h, 1.f, Qs, nullptr, 0.f);
  load_rope_tile(p, p.sec + 8 * SECE, r0, h, 0.08838834764831845f, Ks, KTz, l2g);
  {
    const int row = t >> 2, c0 = (t & 3) * 32;
    const u16* src = p.sec + 9 * SECE + (size_t)(r0 + row) * 512 + h * 128 + c0;
#pragma unroll
    for (int q = 0; q < 4; ++q) {
      const u4 v = *(const u4*)(src + q * 8);
      const u16* e = (const u16*)&v;
#pragma unroll
      for (int j = 0; j < 8; ++j) VT[(c0 + q * 8 + j) * 136 + row] = e[j];
    }
  }
  __syncthreads();
  f32x4 sacc[8];
#pragma unroll
  for (int ii = 0; ii < 8; ++ii) sacc[ii] = f32x4{0.f, 0.f, 0.f, 0.f};
#pragma unroll
  for (int k0 = 0; k0 < 128; k0 += 32) {
    const bf16x8 a = frag(Ks, 136, wid * 16, k0, lane);
#pragma unroll
    for (int ii = 0; ii < 8; ++ii) sacc[ii] = mfma16(a, frag(Qs, 136, ii * 16, k0, lane), sacc[ii]);
  }
  __syncthreads();
#pragma unroll
  for (int ii = 0; ii < 8; ++ii) {
    const int i = ii * 16 + (lane & 15), j0 = wid * 16 + (lane >> 4) * 4;
    f32x4 v;
#pragma unroll
    for (int r = 0; r < 4; ++r) v[r] = (i >= j0 + r) ? sacc[ii][r] * exp2f(l2g * (float)(i - j0 - r)) : 0.f;
    *(u2*)(Qs + i * 136 + j0) = pack4v(v);
  }
  __syncthreads();
  f32x4 oacc[8], kacc[8];
#pragma unroll
  for (int ii = 0; ii < 8; ++ii) { oacc[ii] = f32x4{0.f, 0.f, 0.f, 0.f}; kacc[ii] = f32x4{0.f, 0.f, 0.f, 0.f}; }
#pragma unroll
  for (int k0 = 0; k0 < 128; k0 += 32) {
    const bf16x8 a1 = frag(Qs, 136, wid * 16, k0, lane), a2 = frag(KTz, 136, wid * 16, k0, lane);
#pragma unroll
    for (int ii = 0; ii < 8; ++ii) {
      const bf16x8 bb = frag(VT, 136, ii * 16, k0, lane);
      oacc[ii] = mfma16(a1, bb, oacc[ii]);
      kacc[ii] = mfma16(a2, bb, kacc[ii]);
    }
  }
  u16* od = p.sec + 8 * SECE;
  u16* kd = p.sec + 9 * SECE;
#pragma unroll
  for (int ii = 0; ii < 8; ++ii) {
    const int e = ii * 16 + (lane & 15);
#pragma unroll
    for (int r = 0; r < 4; ++r) {
      const size_t o = (size_t)(r0 + wid * 16 + (lane >> 4) * 4 + r) * 512 + h * 128 + e;
      od[o] = f2bf(oacc[ii][r]);
      kd[o] = f2bf(kacc[ii][r]);
    }
  }
  __syncthreads();
}
DEVI void ret_d2_unit(const P& p, int l, int u, unsigned char* smem) {
  const int t = tid_l(), lane = t & 63, wid = t >> 6;
  const int h = u & 3, n = (u >> 2) & 63, b = u >> 8;
  const int r0 = b * SEQ + n * 128;
  const float l2g = ret_log2gamma(h);
  u16* Qs = (u16*)smem;
  u16* PT = Qs + 128 * 136;
  load_rope_tile(p, p.sec + 7 * SECE, r0, h, 1.f, Qs, nullptr, 0.f);
  {
    const int d = t >> 2, e0 = (t & 3) * 32;
    float acc[32];
#pragma unroll
    for (int j = 0; j < 32; ++j) acc[j] = 0.f;
    const float G = exp2f(l2g * 128.f);
    const u16* src = p.sec + 9 * SECE + ((size_t)b * SEQ + d) * 512 + h * 128 + e0;
    int m = 0;
#pragma unroll 1
    for (; m + 4 <= n; m += 4) {
      u4 v[4][4];
#pragma unroll
      for (int mm = 0; mm < 4; ++mm)
#pragma unroll
        for (int q = 0; q < 4; ++q) v[mm][q] = *(const u4*)(src + (size_t)(m + mm) * 128 * 512 + q * 8);
#pragma unroll
      for (int mm = 0; mm < 4; ++mm)
#pragma unroll
        for (int q = 0; q < 4; ++q) {
          float f[8];
          unpack8(v[mm][q], f);
#pragma unroll
          for (int j = 0; j < 8; ++j) acc[q * 8 + j] = acc[q * 8 + j] * G + f[j];
        }
    }
#pragma unroll 1
    for (; m < n; ++m) {
      const u16* s = src + (size_t)m * 128 * 512;
#pragma unroll
      for (int q = 0; q < 4; ++q) {
        float f[8];
        unpack8(*(const u4*)(s + q * 8), f);
#pragma unroll
        for (int j = 0; j < 8; ++j) acc[q * 8 + j] = acc[q * 8 + j] * G + f[j];
      }
    }
#pragma unroll
    for (int j = 0; j < 32; ++j) PT[(e0 + j) * 136 + d] = f2bf(acc[j]);
  }
  __syncthreads();
  f32x4 oacc[8];
#pragma unroll
  for (int ii = 0; ii < 8; ++ii) oacc[ii] = f32x4{0.f, 0.f, 0.f, 0.f};
#pragma unroll
  for (int k0 = 0; k0 < 128; k0 += 32) {
    const bf16x8 a = frag(Qs, 136, wid * 16, k0, lane);
#pragma unroll
    for (int ii = 0; ii < 8; ++ii) oacc[ii] = mfma16(a, frag(PT, 136, ii * 16, k0, lane), oacc[ii]);
  }
  const u16* oin = p.sec + 8 * SECE;
  u16* gd = p.sec + 10 * SECE;
  const int i0 = wid * 16 + (lane >> 4) * 4;
  float s1[4] = {0.f, 0.f, 0.f, 0.f}, s2[4] = {0.f, 0.f, 0.f, 0.f};
#pragma unroll
  for (int ii = 0; ii < 8; ++ii) {
    const int e = ii * 16 + (lane & 15);
#pragma unroll
    for (int r = 0; r < 4; ++r) {
      const float xi = exp2f(l2g * (float)(i0 + r + 1));
      const float o = bf2f(oin[(size_t)(r0 + i0 + r) * 512 + h * 128 + e]) + xi * oacc[ii][r];
      oacc[ii][r] = o;
      s1[r] += o; s2[r] += o * o;
    }
  }
#pragma unroll
  for (int r = 0; r < 4; ++r) {
#pragma unroll
    for (int o = 1; o < 16; o <<= 1) { s1[r] += __shfl_xor(s1[r], o); s2[r] += __shfl_xor(s2[r], o); }
  }
#pragma unroll
  for (int ii = 0; ii < 8; ++ii) {
    const int e = ii * 16 + (lane & 15);
    const float gg = p.ret_gn_g[l * 512 + h * 128 + e];
#pragma unroll
    for (int r = 0; r < 4; ++r) {
      const float mu = s1[r] * (1.f / 128.f);
      const float var = fmaxf(s2[r] * (1.f / 128.f) - mu * mu, 0.f);
      u16* gp = gd + (size_t)(r0 + i0 + r) * 512 + h * 128 + e;
      const float g = bf2f(*gp);
      *gp = f2bf(siluf(g) * (oacc[ii][r] - mu) * rsqrtf(var + 1e-6f) * gg);
    }
  }
  __syncthreads();
}

DEVI void pool_unit(const P& p, int l, int u, unsigned char* smem) {
  const int t = tid_l(), lane = t & 63, wid = t >> 6;
  const int g = u & 3, rt = u >> 2;
  const int r0 = rt * 64, spos0 = r0 & (SEQ - 1);
  const int win = 2 << g;
  u16* Al = (u16*)smem;
  u16* Wl = Al + 64 * 136;
  {
    const int row = t >> 3, c0 = (t & 7) * 16;
    const u16* base = p.sec + 4 * SECE + g * 128 + c0;
    float sum[16], own[16];
#pragma unroll
    for (int c = 0; c < 16; ++c) sum[c] = 0.f;
    const int sp = spos0 + row;
    const int cnt = min(sp + 1, win);
    for (int j = 0; j < cnt; ++j) {
      const u16* src = base + (size_t)(r0 + row - j) * 512;
      float f[16];
      unpack8(*(const u4*)src, f); unpack8(*(const u4*)(src + 8), f + 8);
#pragma unroll
      for (int c = 0; c < 16; ++c) { sum[c] += f[c]; if (j == 0) own[c] = f[c]; }
    }
    const float ic = 1.f / (float)cnt;
#pragma unroll
    for (int c = 0; c < 16; ++c) sum[c] = sum[c] * ic - own[c];
    *(u4*)(Al + row * 136 + c0) = pack8(sum); *(u4*)(Al + row * 136 + c0 + 8) = pack8(sum + 8);
    const u16* wsrc = p.PoolWT + (size_t)g * 16384;
#pragma unroll
    for (int q = 0; q < 4; ++q) {
      const int idx = t + q * 512;
      const int d = idx >> 4, cc = (idx & 15) * 8;
      *(u4*)(Wl + d * 136 + cc) = *(const u4*)(wsrc + d * 128 + cc);
    }
  }
  __syncthreads();
  const int pt = wid & 3, dh = wid >> 2;
  f32x4 acc[4];
#pragma unroll
  for (int ni = 0; ni < 4; ++ni) acc[ni] = f32x4{0.f, 0.f, 0.f, 0.f};
#pragma unroll
  for (int k0 = 0; k0 < 128; k0 += 32) {
    const bf16x8 a = frag(Al, 136, pt * 16, k0, lane);
#pragma unroll
    for (int ni = 0; ni < 4; ++ni) acc[ni] = mfma16(a, frag(Wl, 136, (dh * 4 + ni) * 16, k0, lane), acc[ni]);
  }
#pragma unroll
  for (int ni = 0; ni < 4; ++ni) {
    const int d = (dh * 4 + ni) * 16 + (lane & 15);
    const float sc = p.pool_scale[l * 512 + g * 128 + d];
#pragma unroll
    for (int r = 0; r < 4; ++r)
      p.YB[(size_t)(r0 + pt * 16 + (lane >> 4) * 4 + r) * 512 + g * 128 + d] = f2bf(acc[ni][r] * sc);
  }
  __syncthreads();
}

DEVI void sg_unit(const P& p, int l, int u, unsigned char* smem) {
  const int t = tid_l(), lane = t & 63, wid = t >> 6;
  const int g = u & 3, ch = u >> 2;
  const int r0 = ch * 128;
  u16* VT = (u16*)smem;
  u16* Ul = VT + 128 * 136;
  u16* Wl = Ul + 128 * 136;
  {
    const int row = t >> 2, q = t & 3;
    const u16* svr = p.sec + 6 * SECE + (size_t)(r0 + row) * 512;
    float s1 = 0.f, s2 = 0.f;
#pragma unroll 4
    for (int i = 0; i < 16; ++i) {
      float f[8];
      unpack8(*(const u4*)(svr + q * 128 + i * 8), f);
#pragma unroll
      for (int j = 0; j < 8; ++j) { const float gv = geluf(f[j]); s1 += gv; s2 += gv * gv; }
    }
    s1 += __shfl_xor(s1, 1); s2 += __shfl_xor(s2, 1);
    s1 += __shfl_xor(s1, 2); s2 += __shfl_xor(s2, 2);
    const float mu = s1 * (1.f / 512.f);
    const float rstd = rsqrtf(fmaxf(s2 * (1.f / 512.f) - mu * mu, 0.f) + 1e-6f);
    const int c0 = q * 32;
    const u16* sur = p.sec + 5 * SECE + (size_t)(r0 + row) * 512 + g * 128 + c0;
#pragma unroll
    for (int i = 0; i < 4; ++i) {
      float f[8], uu[8];
      unpack8(*(const u4*)(svr + g * 128 + c0 + i * 8), f);
      unpack8(*(const u4*)(sur + i * 8), uu);
#pragma unroll
      for (int j = 0; j < 8; ++j) {
        const int c = g * 128 + c0 + i * 8 + j;
        const float vv = (geluf(f[j]) - mu) * rstd * p.sg_ln_g[l * 512 + c] + p.sg_ln_b[l * 512 + c];
        VT[(c0 + i * 8 + j) * 136 + row] = f2bf(vv);
        uu[j] = geluf(uu[j]);
      }
      *(u4*)(Ul + row * 136 + c0 + i * 8) = pack8(uu);
    }
    const float* wsrc = p.sg_w + ((size_t)(l * 4 + g) * 128 + row) * 128 + c0;
#pragma unroll
    for (int i = 0; i < 4; ++i) {
      const float4 a = *(const float4*)(wsrc + i * 8), bq = *(const float4*)(wsrc + i * 8 + 4);
      float f[8] = {a.x, a.y, a.z, a.w, bq.x, bq.y, bq.z, bq.w};
#pragma unroll
      for (int j = 0; j < 8; ++j) f[j] = (c0 + i * 8 + j <= row) ? f[j] : 0.f;
      *(u4*)(Wl + row * 136 + c0 + i * 8) = pack8(f);
    }
  }
  __syncthreads();
  f32x4 acc[8];
#pragma unroll
  for (int ii = 0; ii < 8; ++ii) acc[ii] = f32x4{0.f, 0.f, 0.f, 0.f};
#pragma unroll
  for (int k0 = 0; k0 < 128; k0 += 32) {
    if (k0 <= wid * 16 + 15) {
      const bf16x8 a = frag(Wl, 136, wid * 16, k0, lane);
#pragma unroll
      for (int ii = 0; ii < 8; ++ii) acc[ii] = mfma16(a, frag(VT, 136, ii * 16, k0, lane), acc[ii]);
    }
  }
  u16* dst = p.sec + 5 * SECE;
  const int t0 = wid * 16 + (lane >> 4) * 4;
#pragma unroll
  for (int r = 0; r < 4; ++r) {
    const float bias = p.sg_b[(l * 4 + g) * 128 + t0 + r];
#pragma unroll
    for (int ii = 0; ii < 8; ++ii) {
      const int c = ii * 16 + (lane & 15);
      dst[(size_t)(r0 + t0 + r) * 512 + g * 128 + c] = f2bf(bf2f(Ul[(t0 + r) * 136 + c]) * (acc[ii][r] + bias));
    }
  }
  __syncthreads();
}

DEVI void final_norm_phase(const P& p) {
  const int t = tid_l(), lane = t & 63, wid = t >> 6;
  for (int u = blockIdx.x; u < 2048; u += gridDim.x) {
    const int row = u * 8 + wid;
    float* xr = p.out + (size_t)row * 1024;
    float4 xv[4];
    float ss = 0.f;
#pragma unroll
    for (int i = 0; i < 4; ++i) {
      xv[i] = *(const float4*)(xr + i * 256 + lane * 4);
      ss += xv[i].x * xv[i].x + xv[i].y * xv[i].y + xv[i].z * xv[i].z + xv[i].w * xv[i].w;
    }
    ss = wave_sum(ss);
    const float rstd = rsqrtf(ss * (1.f / 1024.f) + 1e-6f);
#pragma unroll
    for (int i = 0; i < 4; ++i) {
      const float4 g = *(const float4*)(p.final_g + i * 256 + lane * 4);
      float4 o;
      o.x = xv[i].x * rstd * g.x; o.y = xv[i].y * rstd * g.y; o.z = xv[i].z * rstd * g.z; o.w = xv[i].w * rstd * g.w;
      *(float4*)(xr + i * 256 + lane * 4) = o;
    }
  }
}


#define XB_TMO      128
#define XB_XCNT(j)  (256  + 64 * (j))
#define XB_XSUB(j)  (1280 + 64 * (j))
#define XB_XGEN(j)  (2304 + 64 * (j))
#define XB_TOP      3328
#define XB_TOPGEN   3392
#define XCD_BAR_WORDS 3456
#define XB_SPIN_CAP (1u << 20)
#define XLAS __attribute__((address_space(3)))
DEVI unsigned xb_ld(unsigned* p) { return __hip_atomic_load(p, __ATOMIC_RELAXED, __HIP_MEMORY_SCOPE_AGENT); }
DEVI unsigned xb_add(unsigned* p, unsigned v) { return __hip_atomic_fetch_add(p, v, __ATOMIC_RELAXED, __HIP_MEMORY_SCOPE_AGENT); }
DEVI unsigned xb_xcc_id() { return (unsigned)__builtin_amdgcn_s_getreg((3 << 11) | 20) & 0xFu; }
#define XB_SPIN(cond, bar) do { unsigned _sp = 0; while (cond) { __builtin_amdgcn_s_sleep(1); \
    if ((++_sp & 255u) == 0u) { if (xb_ld(&(bar)[XB_TMO])) break; if (_sp > XB_SPIN_CAP) { atomicAdd(&(bar)[XB_TMO], 1u); break; } } } } while (0)
struct XcdBarrier { unsigned* bar; unsigned x; volatile XLAS unsigned* st; };
DEVI XcdBarrier xcd_barrier_post(unsigned* bar, volatile XLAS unsigned* st) {
  XcdBarrier b; b.bar = bar; b.x = xb_xcc_id(); b.st = st;
  if (threadIdx.x == 0) (void)xb_add(&bar[XB_XCNT(b.x)], 1u);
  return b;
}
DEVI void xcd_barrier_complete(unsigned* bar, unsigned x, unsigned& nloc, unsigned& nx) {
  const unsigned G = gridDim.x * gridDim.y * gridDim.z;
  unsigned sum, cnt, mine, sp = 0u;
  for (;;) {
    sum = 0u; cnt = 0u; mine = 0u;
#pragma unroll
    for (unsigned j = 0; j < 16; ++j) { const unsigned c = xb_ld(&bar[XB_XCNT(j)]); sum += c; cnt += (c > 0u) ? 1u : 0u; mine = (j == x) ? c : mine; }
    if (sum == G) break;
    __builtin_amdgcn_s_sleep(1);
    if ((++sp & 255u) == 0u) { if (xb_ld(&bar[XB_TMO])) break; if (sp > XB_SPIN_CAP) { atomicAdd(&bar[XB_TMO], 1u); break; } }
  }
  nloc = mine > 0u ? mine : 1u; nx = cnt > 0u ? cnt : 1u;
}
DEVI void xcd_barrier(const XcdBarrier& b) {
  asm volatile("s_waitcnt vmcnt(0)" ::: "memory");
  __syncthreads();
  if (threadIdx.x == 0) {
    unsigned* bar = b.bar;
    __builtin_amdgcn_s_waitcnt(0);
    unsigned nloc = b.st[0], nx = b.st[1];
    if (nloc == 0u) { xcd_barrier_complete(bar, b.x, nloc, nx); b.st[0] = nloc; b.st[1] = nx; }
    const unsigned old = xb_add(&bar[XB_XSUB(b.x)], 1u);
    const unsigned gen = old / nloc;
    if (old + 1u == (gen + 1u) * nloc) {
      __builtin_amdgcn_fence(__ATOMIC_RELEASE, "agent");
      asm volatile("s_waitcnt vmcnt(0)" ::: "memory");
      const unsigned og = xb_add(&bar[XB_TOP], 1u);
      const unsigned tg = og / nx;
      if (og + 1u == (tg + 1u) * nx) xb_add(&bar[XB_TOPGEN], 1u);
      else XB_SPIN(xb_ld(&bar[XB_TOPGEN]) == tg, bar);
      __builtin_amdgcn_fence(__ATOMIC_ACQUIRE, "agent");
      xb_add(&bar[XB_XGEN(b.x)], 1u);
      asm volatile("s_waitcnt vmcnt(0)" ::: "memory");
    } else {
      XB_SPIN(xb_ld(&bar[XB_XGEN(b.x)]) == gen, bar);
      __builtin_amdgcn_fence(__ATOMIC_ACQUIRE, "agent");
      asm volatile("s_waitcnt vmcnt(0)" ::: "memory");
    }
  }
  __syncthreads();
}

#ifndef PHMASK
#define PHMASK 0xffffffffu
#endif
#define EN(x) (((PHMASK) >> (x)) & 1u)
typedef const __attribute__((address_space(4))) P* KP;
DEVI P load_params(KP vp) {
  const __attribute__((address_space(4))) P& v = *vp;
  P q;
  q.x = v.x; q.c = v.c; q.pos = v.pos; q.norm1_g = v.norm1_g; q.norm2_g = v.norm2_g; q.ada_w = v.ada_w; q.ada_b = v.ada_b;
  q.w_in = v.w_in; q.dn_conv_w = v.dn_conv_w; q.dn_a_log = v.dn_a_log; q.dn_dt_bias = v.dn_dt_bias; q.dn_norm_g = v.dn_norm_g;
  q.pool_w = v.pool_w; q.pool_scale = v.pool_scale; q.sg_ln_g = v.sg_ln_g; q.sg_ln_b = v.sg_ln_b; q.sg_w = v.sg_w; q.sg_b = v.sg_b;
  q.ret_gn_g = v.ret_gn_g; q.w_br0 = v.w_br0; q.w_br1 = v.w_br1; q.w_br2 = v.w_br2; q.w_br3 = v.w_br3;
  q.w_out = v.w_out; q.mlp_w1 = v.mlp_w1; q.mlp_w2 = v.mlp_w2; q.final_g = v.final_g; q.out = v.out;
  q.WinT = v.WinT; q.WbrT = v.WbrT; q.WoutT = v.WoutT; q.W1T = v.W1T; q.W2T = v.W2T; q.PoolWT = v.PoolWT; q.h = v.h; q.sec = v.sec;
  q.TQ = v.TQ; q.YB = v.YB; q.halo = v.halo; q.QKF = v.QKF; q.modp = v.modp; q.beta = v.beta; q.glog = v.glog; q.EG = v.EG; q.ropecs = v.ropecs; q.prog = v.prog; q.rowss = v.rowss; q.xbar = v.xbar;
  q.phase_lo = 0; q.phase_hi = 0;
  return q;
}
#define LP() KP k2_ = kp; asm volatile("" : "+s"(k2_)); const P p = load_params(k2_)
DEVI void run_phase(int ph, unsigned char* smem) {
  KP kp = (KP)__builtin_amdgcn_kernarg_segment_ptr();
  int bid = blockIdx.x; asm volatile("" : "+s"(bid));
  const int nb = gridDim.x;
  if (ph == 0) {
    for (int u = bid; u < 96 + 2048 + NWCONV; u += nb) {
      if (u < 96) { if (EN(0)) { LP(); mod_unit(p, u, smem); } }
      else if (u < 96 + 2048) { if (EN(1)) { LP(); rope_unit(p, u - 96); } }
      else { if (EN(2)) { LP(); wconv_unit(p, 0, u - 96 - 2048, smem); } }
    }
    return;
  }
  if (ph == NPHASE - 1) { if (EN(15)) { LP(); final_norm_phase(p); } return; }
  const int l = (ph - 1) / 10, s = (ph - 1) % 10;
  switch (s) {
    case 0:
      if (l == 1 && EN(2)) for (int u = bid; u < NWCONV; u += nb) { LP(); wconv_unit(p, 1, u, smem); }
      __syncthreads();
      if (EN(3)) { LP(); norm_phase(p, l, 0, smem); }
      break;
    case 1:
      if (EN(3)) for (int u = bid; u < 64; u += nb) { LP(); bias2_unit(p, l, u); }
      if (EN(4)) { LP(); proj_phase(p, smem); }
      break;
    case 2:
      if (bid == 0 && threadIdx.x < 17) { LP(); p.prog[threadIdx.x * 16] = 0u; }
      for (int u = bid; u < 1024; u += nb) { if (EN(5)) { LP(); dn_prep_unit(p, l, u, smem); } }
      break;
    case 3:
      if (bid < 16) { if (EN(9)) { LP(); dn_chain(p, l, bid & 7, bid >> 3, smem); } }
      else if (bid < 24) { if (EN(9)) { LP(); dn_chain_helper(p, bid - 16, smem); } }
      else {
        const int nw = nb - 24, wb = bid - 24;
        for (int u = wb; u < 512 + 512 + 1024; u += nw) {
          if (u < 512) { if (EN(6)) { LP(); ret_d1_unit(p, u, smem); } }
          else if (u < 1024) { if (EN(7)) { LP(); sg_unit(p, l, u - 512, smem); } }
          else { if (EN(8)) { LP(); pool_unit(p, l, u - 1024, smem); } }
        }
        {
          LP();
          unsigned* cnt = p.prog + 16 * 16;
          asm volatile("s_waitcnt vmcnt(0)" ::: "memory");
          __syncthreads();
          if (threadIdx.x == 0) {
            __builtin_amdgcn_fence(__ATOMIC_RELEASE, "agent");
            asm volatile("s_waitcnt vmcnt(0)" ::: "memory");
            __hip_atomic_fetch_add(cnt, 1u, __ATOMIC_RELAXED, __HIP_MEMORY_SCOPE_AGENT);
            unsigned polls = 0;
            while (__hip_atomic_load(cnt, __ATOMIC_RELAXED, __HIP_MEMORY_SCOPE_AGENT) < (unsigned)nw && polls < 4000000u) { __builtin_amdgcn_s_sleep(2); ++polls; }
            __builtin_amdgcn_fence(__ATOMIC_ACQUIRE, "agent");
            asm volatile("s_waitcnt vmcnt(0)" ::: "memory");
          }
          __syncthreads();
        }
        if (EN(10)) for (int u = wb; u < 512; u += nw) { LP(); ret_d2_unit(p, l, u, smem); }
        if (EN(9)) for (int k = wb; k < 1024; k += nw) {
          LP();
          const int n = k >> 3, bh = k & 7;
          if (threadIdx.x == 0) {
            unsigned polls = 0;
            while ((__hip_atomic_load(p.prog + (bh * 2) * 16, __ATOMIC_RELAXED, __HIP_MEMORY_SCOPE_AGENT) <= (unsigned)n ||
                    __hip_atomic_load(p.prog + (bh * 2 + 1) * 16, __ATOMIC_RELAXED, __HIP_MEMORY_SCOPE_AGENT) <= (unsigned)n) && polls < 8000000u) { __builtin_amdgcn_s_sleep(8); ++polls; }
            __builtin_amdgcn_fence(__ATOMIC_ACQUIRE, "agent");
            asm volatile("s_waitcnt vmcnt(0)" ::: "memory");
          }
          __syncthreads();
          ya_unit(p, l, (((bh >> 2) * 128 + n) << 2) | (bh & 3), smem);
        }
      }
      break;
    case 4: break;
    case 5: if (EN(12)) { LP(); merge_phase(p, smem); } break;
    case 6: if (EN(13)) { LP(); resid_gemm_phase(p, l, 0, smem); } break;
    case 7: break;
    case 8: if (EN(14)) { LP(); mlp1_phase(p, smem); } break;
    case 9: if (EN(13)) { LP(); resid_gemm_phase(p, l, 1, smem); } break;
  }
}

__global__ void __launch_bounds__(NT) mega(P p) {
  extern __shared__ __attribute__((aligned(16))) unsigned char smem[];
#ifdef PROBE_A
  unsigned long long* stamps = (unsigned long long*)(smem + 159000);
  if (threadIdx.x == 0) { stamps[0] = __builtin_amdgcn_s_memrealtime(); stamps[23] = 0; }
#endif
  volatile XLAS unsigned* xst = (volatile XLAS unsigned*)((XLAS unsigned char*)smem + (SMEM_BYTES - 16));
  if (threadIdx.x == 0) { xst[0] = 0u; xst[1] = 0u; }
  __syncthreads();
  const XcdBarrier xb = xcd_barrier_post(p.xbar, xst);
  for (int ph = p.phase_lo; ph < p.phase_hi; ++ph) {
    if (ph > 0 && ph < NPHASE - 1 && ((ph - 1) % 10 == 7 || (ph - 1) % 10 == 4)) continue;
    run_phase(ph, smem);
    if (ph + 1 < p.phase_hi) {
      if (ph == 0) cg::this_grid().sync();
      else xcd_barrier(xb);
    }
  }
#ifdef PROBE_A
  cg::this_grid().sync();
  if (blockIdx.x == 0) {
    __syncthreads();
    auto dur = [&](int code) -> unsigned long long {
      if (code == 100) return stamps[1] - stamps[0];
      if (code == 101) return stamps[23];
      if (code == 102) return stamps[NPHASE - 1] - stamps[0];
      return (stamps[1 + code + 1] - stamps[1 + code]) + (stamps[11 + code + 1] - stamps[11 + code]);
    };
    const unsigned N = (unsigned)(dur(PROBE_A) * 4096ull / 100ull);
    for (unsigned i = threadIdx.x; i < N && i < 16384u * 1024u; i += NT) p.out[i] += 0.0078125f;
  }
#endif
}

extern "C" void kernel_launch(void* const* d_in, const int* in_sizes, int n_in, void* d_out, int out_size, void* d_ws,
                              size_t ws_size, hipStream_t stream) {
  static int grid = 0;
  constexpr size_t MiB = 1024 * 1024;
  constexpr size_t WS_NEED = 304 * MiB;
  if (grid == 0) {
    if (ws_size < WS_NEED || n_in != 27) {
      fprintf(stderr, "kernel_launch: ws_size %zu < %zu or n_in %d != 27\n", ws_size, WS_NEED, n_in);
      grid = -1;
      return;
    }
    int dev = 0, cus = 0, per_cu = 0;
    hipGetDevice(&dev);
    hipDeviceGetAttribute(&cus, hipDeviceAttributeMultiprocessorCount, dev);
    hipFuncSetAttribute((const void*)mega, hipFuncAttributeMaxDynamicSharedMemorySize, SMEM_BYTES);
    hipOccupancyMaxActiveBlocksPerMultiprocessor(&per_cu, (const void*)mega, NT, SMEM_BYTES);
    if (per_cu < 1) per_cu = 1;
    grid = cus * per_cu;
    (void)hipGetLastError();
  }
  if (grid < 0) return;
  P p{};
  p.x = (const float*)d_in[0]; p.c = (const float*)d_in[1]; p.pos = (const int*)d_in[2];
  p.norm1_g = (const float*)d_in[3]; p.norm2_g = (const float*)d_in[4];
  p.ada_w = (const float*)d_in[5]; p.ada_b = (const float*)d_in[6]; p.w_in = (const float*)d_in[7];
  p.dn_conv_w = (const float*)d_in[8]; p.dn_a_log = (const float*)d_in[9]; p.dn_dt_bias = (const float*)d_in[10];
  p.dn_norm_g = (const float*)d_in[11]; p.pool_w = (const float*)d_in[12]; p.pool_scale = (const float*)d_in[13];
  p.sg_ln_g = (const float*)d_in[14]; p.sg_ln_b = (const float*)d_in[15]; p.sg_w = (const float*)d_in[16];
  p.sg_b = (const float*)d_in[17]; p.ret_gn_g = (const float*)d_in[18];
  p.w_br0 = (const float*)d_in[19]; p.w_br1 = (const float*)d_in[20]; p.w_br2 = (const float*)d_in[21];
  p.w_br3 = (const float*)d_in[22];
  p.w_out = (const float*)d_in[23]; p.mlp_w1 = (const float*)d_in[24]; p.mlp_w2 = (const float*)d_in[25];
  p.final_g = (const float*)d_in[26];
  p.out = (float*)d_out;
  unsigned char* ws = (unsigned char*)d_ws;
  size_t o = 0;
  p.WinT = (u16*)(ws + o); o += (size_t)9728 * 1024 * 2;
  p.WbrT = (u16*)(ws + o); o += (size_t)4 * 1024 * 512 * 2;
  p.WoutT = (u16*)(ws + o); o += (size_t)1024 * 1024 * 2;
  p.W1T = (u16*)(ws + o); o += (size_t)4096 * 1024 * 2;
  p.W2T = (u16*)(ws + o); o += (size_t)4096 * 1024 * 2;
  p.PoolWT = (u16*)(ws + o); o += (size_t)4 * 128 * 128 * 2;
  o = 44 * MiB;
  p.h = (u16*)(ws + o); o += 32 * MiB;
  p.sec = (u16*)(ws + o); o += 176 * MiB;
  p.TQ = (u16*)(ws + o); o += 16 * MiB;
  p.YB = (u16*)(ws + o); o += 16 * MiB;
  p.halo = (u16*)(ws + o); o += 3 * MiB;
  p.modp = (float*)(ws + o); o += 1 * MiB;
  p.beta = (float*)(ws + o); o += 262144;
  p.glog = (float*)(ws + o); o += 262144;
  p.EG = (float*)(ws + o); o += 262144;
  p.ropecs = (float*)(ws + o); o += 8 * MiB;
  p.QKF = (u16*)(ws + o); o += (size_t)1024 * 3072 * 2;
  p.prog = (unsigned*)(ws + o); o += 4096;
  p.rowss = (float*)(ws + o); o += (size_t)16384 * 16 * 4;
  p.xbar = (unsigned*)(ws + o); o += 16384;
#if COOP
  (void)hipMemsetAsync(p.xbar, 0, 16384, stream);
  p.phase_lo = 0; p.phase_hi = NPHASE;
  void* args[] = {&p};
  hipError_t e = hipLaunchCooperativeKernel((const void*)mega, dim3(grid), dim3(NT), args, SMEM_BYTES, stream);
  if (e != hipSuccess) fprintf(stderr, "cooperative launch failed: %s (grid %d)\n", hipGetErrorString(e), grid);
#else
  for (int ph = 0; ph < NPHASE; ++ph) {
    p.phase_lo = ph; p.phase_hi = ph + 1;
    hipLaunchKernelGGL(mega, dim3(grid), dim3(NT), SMEM_BYTES, stream, p);
  }
#endif
}
```

```cpp
#include <hip/hip_runtime.h>
#include <hip/hip_bf16.h>
#include <hip/hip_cooperative_groups.h>
#include <cstdio>
namespace cg = cooperative_groups;

#ifndef COOP
#define COOP 1
#endif

typedef unsigned short u16;
using bf16x8 = __attribute__((ext_vector_type(8))) short;
using f32x4 = __attribute__((ext_vector_type(4))) float;
using u4 = __attribute__((ext_vector_type(4))) unsigned;
using u2 = __attribute__((ext_vector_type(2))) unsigned;
#define DEVI __device__ __forceinline__

constexpr int NT = 512;
constexpr int SEQ = 8192;
constexpr size_t SECE = (size_t)16384 * 512;
constexpr int SMEM_BYTES = 156 * 1024;
constexpr int NPHASE = 22;

struct P {
  const float *x, *c;
  const int* pos;
  const float *norm1_g, *norm2_g, *ada_w, *ada_b, *w_in, *dn_conv_w, *dn_a_log, *dn_dt_bias, *dn_norm_g, *pool_w,
      *pool_scale, *sg_ln_g, *sg_ln_b, *sg_w, *sg_b, *ret_gn_g, *w_br0, *w_br1, *w_br2, *w_br3, *w_out, *mlp_w1, *mlp_w2, *final_g;
  float* out;
  u16 *WinT, *WbrT, *WoutT, *W1T, *W2T, *PoolWT, *h, *sec, *TQ, *YB, *halo, *QKF;
  float *modp, *beta, *glog, *EG, *ropecs;
  unsigned* prog;
  float* rowss;
  unsigned* xbar;
  int phase_lo, phase_hi;
};

DEVI int tid_l() { int t = threadIdx.x; asm volatile("" : "+v"(t)); return t; }
template <class T> DEVI void lnd(T*& q) { asm volatile("" : "+s"(q)); }
typedef float f32x2_t __attribute__((ext_vector_type(2)));
typedef __bf16 bf16x2_t __attribute__((ext_vector_type(2)));
DEVI unsigned pack2(float a, float b) { const f32x2_t v = {a, b}; const bf16x2_t r = __builtin_convertvector(v, bf16x2_t); return __builtin_bit_cast(unsigned, r); }
DEVI u16 f2bf(float f) { return (u16)(pack2(f, f) & 0xffffu); }
DEVI float bf2f(u16 h) { return __uint_as_float(((unsigned)h) << 16); }
DEVI float lo2f(unsigned u) { return __uint_as_float(u << 16); }
DEVI float hi2f(unsigned u) { return __uint_as_float(u & 0xffff0000u); }
DEVI void unpack8(u4 v, float* f) {
  f[0] = lo2f(v.x); f[1] = hi2f(v.x); f[2] = lo2f(v.y); f[3] = hi2f(v.y);
  f[4] = lo2f(v.z); f[5] = hi2f(v.z); f[6] = lo2f(v.w); f[7] = hi2f(v.w);
}
DEVI u4 pack8(const float* f) {
  u4 v; v.x = pack2(f[0], f[1]); v.y = pack2(f[2], f[3]); v.z = pack2(f[4], f[5]); v.w = pack2(f[6], f[7]);
  return v;
}
DEVI float wave_sum(float v) {
#pragma unroll
  for (int o = 32; o > 0; o >>= 1) v += __shfl_xor(v, o);
  return v;
}
DEVI float siluf(float x) { return x * __builtin_amdgcn_rcpf(1.f + __expf(-x)); }
DEVI float sigmf(float x) { return __builtin_amdgcn_rcpf(1.f + __expf(-x)); }
DEVI float geluf(float v) {
  const float av = fabsf(v), t = __builtin_amdgcn_rcpf(av * 0.2316418882f + 1.0f);
  float q = t * 0.5307027145f + (-0.7265760135f); q = q * t + 0.7107068705f; q = q * t + (-0.142248368f); q = q * t + 0.127414796f; q = q * t;
  const float e = __builtin_amdgcn_exp2f((v * v) * (-0.72134752044f));
  const float m = v * (q * e);
  return v < 0.f ? m : v - m;
}
DEVI f32x4 mfma16(bf16x8 a, bf16x8 b, f32x4 c) { return __builtin_amdgcn_mfma_f32_16x16x32_bf16(a, b, c, 0, 0, 0); }
DEVI bf16x8 frag(const u16* base, int ld, int r0, int k0, int lane) {
  return *(const bf16x8*)(base + (r0 + (lane & 15)) * ld + k0 + 8 * (lane >> 4));
}
DEVI u2 pack4v(f32x4 v) { u2 r; r.x = pack2(v[0], v[1]); r.y = pack2(v[2], v[3]); return r; }

DEVI float modval(const P& p, int l, int b, int j) { return p.modp[(size_t)(l * 2 + b) * 6144 + j]; }

DEVI void gemm_kloop(const u16* __restrict__ A, int lda, const u16* __restrict__ Bt, int ldb, int K,
                     f32x4 (&acc)[4][4], u16* sm) {
  const int t = tid_l(), lane = t & 63, wid = t >> 6, wr = wid >> 1, wc = wid & 1;
  u16* As = sm;
  u16* Bs = sm + 2 * 256 * 64;
  const int lrow = t >> 3, lch = t & 7;
  const u16* ag = A + (size_t)lrow * lda + lch * 8;
  const u16* bg = Bt + (size_t)lrow * ldb + lch * 8;
  const int soff = lrow * 64 + ((lch ^ (lrow & 7)) * 8);
  u4 ra[4], rb[2];
#pragma unroll
  for (int i = 0; i < 4; ++i) ra[i] = *(const u4*)(ag + (size_t)i * 64 * lda);
#pragma unroll
  for (int i = 0; i < 2; ++i) rb[i] = *(const u4*)(bg + (size_t)i * 64 * ldb);
  __syncthreads();
#pragma unroll
  for (int i = 0; i < 4; ++i) *(u4*)(As + i * 64 * 64 + soff) = ra[i];
#pragma unroll
  for (int i = 0; i < 2; ++i) *(u4*)(Bs + i * 64 * 64 + soff) = rb[i];
  __syncthreads();
  const int nt = K >> 6;
  const int arow = (wr * 64 + (lane & 15)) * 64, brow = (wc * 64 + (lane & 15)) * 64;
  for (int kt = 0; kt < nt; ++kt) {
    const int cur = kt & 1;
    if (kt + 1 < nt) {
      const int ko = (kt + 1) * 64;
#pragma unroll
      for (int i = 0; i < 4; ++i) ra[i] = *(const u4*)(ag + (size_t)i * 64 * lda + ko);
#pragma unroll
      for (int i = 0; i < 2; ++i) rb[i] = *(const u4*)(bg + (size_t)i * 64 * ldb + ko);
    }
    const u16* Ac = As + cur * 256 * 64 + arow;
    const u16* Bc = Bs + cur * 128 * 64 + brow;
#pragma unroll
    for (int kk = 0; kk < 2; ++kk) {
      const int ch = (((kk * 4 + (lane >> 4)) ^ (lane & 7)) * 8);
      bf16x8 af[4], bfr[4];
#pragma unroll
      for (int mi = 0; mi < 4; ++mi) af[mi] = *(const bf16x8*)(Ac + mi * 16 * 64 + ch);
#pragma unroll
      for (int ni = 0; ni < 4; ++ni) bfr[ni] = *(const bf16x8*)(Bc + ni * 16 * 64 + ch);
#pragma unroll
      for (int mi = 0; mi < 4; ++mi)
#pragma unroll
        for (int ni = 0; ni < 4; ++ni) acc[mi][ni] = mfma16(af[mi], bfr[ni], acc[mi][ni]);
    }
    if (kt + 1 < nt) {
      const int nb = cur ^ 1;
#pragma unroll
      for (int i = 0; i < 4; ++i) *(u4*)(As + nb * 256 * 64 + i * 64 * 64 + soff) = ra[i];
#pragma unroll
      for (int i = 0; i < 2; ++i) *(u4*)(Bs + nb * 128 * 64 + i * 64 * 64 + soff) = rb[i];
    }
    __syncthreads();
  }
}
DEVI void zero_acc(f32x4 (&acc)[4][4]) {
#pragma unroll
  for (int i = 0; i < 4; ++i)
#pragma unroll
    for (int j = 0; j < 4; ++j) acc[i][j] = f32x4{0.f, 0.f, 0.f, 0.f};
}
template <class F>
DEVI void epi_foreach(f32x4 (&acc)[4][4], int row0, int col0, F f) {
  const int t = tid_l(), lane = t & 63, wid = t >> 6, wr = wid >> 1, wc = wid & 1;
#pragma unroll
  for (int mi = 0; mi < 4; ++mi)
#pragma unroll
    for (int ni = 0; ni < 4; ++ni)
#pragma unroll
      for (int r = 0; r < 4; ++r)
        f(row0 + wr * 64 + mi * 16 + (lane >> 4) * 4 + r, col0 + wc * 64 + ni * 16 + (lane & 15), acc[mi][ni][r]);
}

DEVI void mod_unit(const P& p, int u, unsigned char* smem) {
  const int t = tid_l();
  const int l = u / 48, jb = u % 48;
  float* cond = (float*)smem;
  float* red = cond + 2048;
  for (int i = t; i < 2048; i += NT) cond[i] = siluf(p.c[i]);
  __syncthreads();
  const int kq = t >> 7, jj = t & 127;
  const float* w = p.ada_w + ((size_t)l * 1024 + kq * 256) * 6144 + jb * 128 + jj;
  float a0 = 0.f, a1 = 0.f;
#pragma unroll 16
  for (int k = 0; k < 256; ++k) {
    const float wv = w[(size_t)k * 6144];
    a0 += cond[kq * 256 + k] * wv;
    a1 += cond[1024 + kq * 256 + k] * wv;
  }
  red[(kq * 2 + 0) * 128 + jj] = a0;
  red[(kq * 2 + 1) * 128 + jj] = a1;
  __syncthreads();
  if (t < 256) {
    const int bb = t >> 7;
    const int j = jb * 128 + jj;
    float sacc = p.ada_b[l * 6144 + j];
#pragma unroll
    for (int q = 0; q < 4; ++q) sacc += red[(q * 2 + bb) * 128 + jj];
    p.modp[(size_t)(l * 2 + bb) * 6144 + j] = sacc;
  }
  __syncthreads();
}
DEVI void rope_unit(const P& p, int u) {
  const int idx = u * 512 + tid_l();
  const int tok = idx >> 6, j = idx & 63;
  const float inv = exp2f(-(float)j * (13.287712379549449f / 64.f));
  const float ang = (float)p.pos[tok] * inv;
  double rev = (double)ang * 0.15915494309189535;
  rev -= rint(rev);
  const float r = (float)(rev * 6.283185307179586);
  p.ropecs[(size_t)idx * 2] = __cosf(r);
  p.ropecs[(size_t)idx * 2 + 1] = __sinf(r);
}
template <int NTL>
DEVI void conv_tiles(const float* __restrict__ src, int ld, int K, int kt, int nt0, int col0, u16* __restrict__ dst, unsigned char* smem, int dkt = -1) {
  if (dkt < 0) dkt = kt;
  float* ls = (float*)smem;
  const int t = tid_l();
  float4 v[NTL][2];
#pragma unroll
  for (int q = 0; q < NTL; ++q)
#pragma unroll
    for (int ps = 0; ps < 2; ++ps) {
      const int kk = ps * 32 + (t >> 4), n4 = (t & 15) * 4;
      v[q][ps] = *(const float4*)(src + (size_t)(kt * 64 + kk) * ld + col0 + q * 64 + n4);
    }
#pragma unroll
  for (int q = 0; q < NTL; ++q)
#pragma unroll
    for (int ps = 0; ps < 2; ++ps) {
      const int kk = ps * 32 + (t >> 4), n4 = (t & 15) * 4;
      float* d = ls + q * 64 * 65 + kk * 65 + n4;
      d[0] = v[q][ps].x; d[1] = v[q][ps].y; d[2] = v[q][ps].z; d[3] = v[q][ps].w;
    }
  __syncthreads();
  const int n = t >> 3, kc = (t & 7) * 8;
#pragma unroll
  for (int q = 0; q < NTL; ++q) {
    float f[8];
#pragma unroll
    for (int j = 0; j < 8; ++j) f[j] = ls[q * 64 * 65 + (kc + j) * 65 + n];
    *(u4*)(dst + (size_t)((nt0 + q) * 64 + n) * K + dkt * 64 + kc) = pack8(f);
  }
  __syncthreads();
}
constexpr int NWCONV = 608 + 128 + 64 + 256 + 256 + 8;
DEVI void wconv_unit(const P& p, int l, int w, unsigned char* smem) {
  if (w < 608) {
    const int kt = w & 15, ng = w >> 4, n0 = ng * 256;
    conv_tiles<4>(p.w_in + (size_t)l * 1024 * 9736, 9736, 512, kt, ng * 4, n0 + (n0 >= 2048 ? 8 : 0), p.WinT + (size_t)(kt >> 3) * 9728 * 512, smem, kt & 7);
    return;
  }
  w -= 608;
  if (w < 128) {
    const int b = w >> 5, r = w & 31, kt = r & 7, ng = r >> 3;
    const float* b0 = p.w_br0; const float* b1 = p.w_br1; const float* b2 = p.w_br2; const float* b3 = p.w_br3;
    asm volatile("" : "+s"(b0)); asm volatile("" : "+s"(b1)); asm volatile("" : "+s"(b2)); asm volatile("" : "+s"(b3));
    conv_tiles<4>((b == 0 ? b0 : b == 1 ? b1 : b == 2 ? b2 : b3) + (size_t)l * 512 * 1024, 1024, 512, kt, ng * 4, ng * 256, p.WbrT + (size_t)b * 1024 * 512, smem);
    return;
  }
  w -= 128;
  if (w < 64) {
    conv_tiles<4>(p.w_out + (size_t)l * 1024 * 1024, 1024, 1024, w & 15, (w >> 4) * 4, (w >> 4) * 256, p.WoutT, smem);
    return;
  }
  w -= 64;
  if (w < 256) {
    conv_tiles<4>(p.mlp_w1 + (size_t)l * 1024 * 4096, 4096, 1024, w & 15, (w >> 4) * 4, (w >> 4) * 256, p.W1T, smem);
    return;
  }
  w -= 256;
  if (w < 256) {
    conv_tiles<4>(p.mlp_w2 + (size_t)l * 4096 * 1024, 1024, 4096, w & 63, (w >> 6) * 4, (w >> 6) * 256, p.W2T, smem);
    return;
  }
  w -= 256;
  {
    const int g = w >> 1, kt = w & 1;
    conv_tiles<2>(p.pool_w + (size_t)(l * 4 + g) * 16384, 128, 128, kt, 0, 0, p.PoolWT + (size_t)g * 16384, smem);
  }
}

DEVI void norm_phase(const P& p, int l, int which, unsigned char* smem) {
  const int t = tid_l(), lane = t & 63, wid = t >> 6;
  float* ssh = (float*)smem;
  float* ssc = ssh + 2048;
  float* w8 = ssc + 2048;
  const float* gsrc = (which == 0 ? p.norm1_g : p.norm2_g) + l * 1024;
  const int ish = which == 0 ? 0 : 3;
#pragma unroll 1
  for (int i = t; i < 2048; i += NT) {
    const int b = i >> 10, c = i & 1023;
    ssh[i] = modval(p, l, b, ish * 1024 + c);
    ssc[i] = gsrc[c] * (1.f + modval(p, l, b, (ish + 1) * 1024 + c));
  }
  if (which == 0) {
#pragma unroll 1
    for (int i = t; i < 2048; i += NT) {
      const int k = i >> 1, hf = i & 1;
      *(float4*)(w8 + k * 8 + hf * 4) = *(const float4*)(p.w_in + ((size_t)l * 1024 + k) * 9736 + 2048 + hf * 4);
    }
  }
  __syncthreads();
  const float* xs = (l == 0 && which == 0) ? p.x : p.out;
  float4 xv[4];
  {
    const int u0 = blockIdx.x;
    if (u0 < 2048) {
      const float* xr = xs + (size_t)(u0 * 8 + wid) * 1024;
#pragma unroll
      for (int i = 0; i < 4; ++i) xv[i] = *(const float4*)(xr + i * 256 + lane * 4);
    }
  }
#pragma unroll 1
  for (int u = blockIdx.x; u < 2048; u += gridDim.x) {
    const int row = u * 8 + wid, b = row >> 13;
    float4 xn[4];
    {
      const int un = u + gridDim.x;
      const float* xr = xs + (size_t)((un < 2048 ? un : u) * 8 + wid) * 1024;
#pragma unroll
      for (int i = 0; i < 4; ++i) xn[i] = *(const float4*)(xr + i * 256 + lane * 4);
    }
    float ss = 0.f;
#pragma unroll
    for (int i = 0; i < 4; ++i) {
      ss += xv[i].x * xv[i].x + xv[i].y * xv[i].y + xv[i].z * xv[i].z + xv[i].w * xv[i].w;
    }
    ss = wave_sum(ss);
    const float rstd = rsqrtf(ss * (1.f / 1024.f) + 1e-6f);
    float a8[8];
#pragma unroll
    for (int j = 0; j < 8; ++j) a8[j] = 0.f;
#pragma unroll
    for (int i = 0; i < 4; ++i) {
      const int c = i * 256 + lane * 4;
      const float4 sc = *(const float4*)(ssc + b * 1024 + c);
      const float4 sh = *(const float4*)(ssh + b * 1024 + c);
      float hv[4];
      hv[0] = xv[i].x * rstd * sc.x + sh.x;
      hv[1] = xv[i].y * rstd * sc.y + sh.y;
      hv[2] = xv[i].z * rstd * sc.z + sh.z;
      hv[3] = xv[i].w * rstd * sc.w + sh.w;
      u2 o; o.x = pack2(hv[0], hv[1]); o.y = pack2(hv[2], hv[3]);
      *(u2*)(p.h + (size_t)(c >> 9) * 8388608 + (size_t)row * 512 + (c & 511)) = o;
      if (which == 0) {
#pragma unroll
        for (int e = 0; e < 4; ++e) {
          const float4 wa = *(const float4*)(w8 + (c + e) * 8);
          const float4 wb = *(const float4*)(w8 + (c + e) * 8 + 4);
          a8[0] += hv[e] * wa.x; a8[1] += hv[e] * wa.y; a8[2] += hv[e] * wa.z; a8[3] += hv[e] * wa.w;
          a8[4] += hv[e] * wb.x; a8[5] += hv[e] * wb.y; a8[6] += hv[e] * wb.z; a8[7] += hv[e] * wb.w;
        }
      }
    }
    if (which == 0) {
#pragma unroll
      for (int j = 0; j < 8; ++j) a8[j] = wave_sum(a8[j]);
      float mine = 0.f;
#pragma unroll
      for (int j = 0; j < 8; ++j) mine = (lane == j) ? a8[j] : mine;
      if (lane < 4) {
        p.beta[(size_t)row * 4 + lane] = sigmf(mine);
      } else if (lane < 8) {
        const int hh = lane - 4;
        const float xx = mine + p.dn_dt_bias[l * 4 + hh];
        const float sp = xx > 20.f ? xx : log1pf(expf(xx));
        p.glog[(size_t)row * 4 + hh] = -expf(p.dn_a_log[l * 4 + hh]) * sp;
      }
    }
#pragma unroll
    for (int i = 0; i < 4; ++i) xv[i] = xn[i];
  }
}

DEVI int gate_sec(int gs) { return gs < 3 ? gs : (gs == 3 ? 4 : (gs == 4 ? 6 : gs + 2)); }


namespace pg8 {
#define PG8_LAS __attribute__((address_space(3)))
constexpr int BM = 256, BK = 64, HALF = 128, HTB = HALF * BK * 2, STAGE_BYTES = 8 * HTB, NXCD = 8, WGM = 8;
DEVI int lds_byte(int r, int c) { const int st = (r >> 4) * 2 + (c >> 5), rr = r & 15, cc = c & 31, ob = rr * 64 + cc * 2; return st * 1024 + (ob ^ (((ob >> 9) & 1) << 5)); }
DEVI void stage_rc(int b, int& R, int& C) { const int st = b / 1024, sb = b % 1024, swz = sb ^ (((sb >> 9) & 1) << 5); R = (st >> 1) * 16 + swz / 64; C = (st & 1) * 32 + (swz % 64) / 2; }
DEVI int perm32(int rho) { const int n = rho >> 4, i = rho & 15; return 8 * (i >> 2) + 4 * n + (i & 3); }
struct Unit { int pm, pn, br, keep; const u16* A; const u16* Bt; };
struct Gemm { const u16* A; const u16* Bt; int M, N, K; };
struct StaticOrder {
  int nM, nN, nwg, G, c; const u16* gA; const u16* gB;
  DEVI void init(int M, int N, int G_, int c_, const u16* A_, const u16* B_) { nM = M / BM; nN = N / BM; nwg = nM * nN; G = G_; c = c_; gA = A_; gB = B_; }
  DEVI bool next(int i, Unit& u) const {
    const long L = (long)i * G + c; if (L >= nwg) return false;
    int wgid = (int)L; { const int q = nwg / NXCD, r = nwg % NXCD, xcd = wgid % NXCD, off = wgid / NXCD; wgid = (xcd < r ? xcd * (q + 1) : r * (q + 1) + (xcd - r) * q) + off; }
    const int nig = WGM * nN, gid = wgid / nig, fm = gid * WGM, gsz = (nM - fm) < WGM ? (nM - fm) : WGM;
    u.pm = fm + ((wgid % nig) % gsz); u.pn = (wgid % nig) / gsz; u.br = 0; u.keep = 0; u.A = gA; u.Bt = gB; return true;
  }
};
DEVI unsigned cvt_pk_bf16(float lo, float hi) { return pack2(lo, hi); }

template <class Epi, class Sched>
DEVI void gemm_phase(PG8_LAS unsigned char* lds, const Gemm g, const Sched& S, const Epi& E) {
  const int tid = tid_l(), wid = __builtin_amdgcn_readfirstlane(tid >> 6), lane = tid & 63, wr = wid >> 2, wc = wid & 3, fr = lane & 15, fq = lane >> 4;
  const int K = g.K, nt = K / BK;
  unsigned voffA[2], voffB[2];
#pragma unroll
  for (int i = 0; i < 2; ++i) { int R, C; stage_rc(tid * 16 + i * 8192, R, C); const int Rb = Epi::PERM ? ((R & ~31) + perm32(R & 31)) : R;
    voffA[i] = (unsigned)(R * K + C) * 2u; voffB[i] = (unsigned)(Rb * K + C) * 2u; }
  const size_t kstep = (size_t)(BK * 2);
  const size_t hstep = (size_t)HALF * K * 2;
  const size_t tstep = 2 * hstep;
  const unsigned ldsw = (unsigned)wid * 1024u;
  const int aoff = lds_byte(wr * 64 + fr, fq * 8), boff = lds_byte(wc * 32 + fr, fq * 8);
#define PG8_SA(b, h) (((b) * 2 + (h)) * HTB)
#define PG8_SB(b, h) ((4 + (b) * 2 + (h)) * HTB)
#define PG8_STAGE(bufoff, gbase, voff) do { _Pragma("unroll") for (int _i = 0; _i < 2; ++_i) \
    __builtin_amdgcn_global_load_lds((const unsigned*)((const char*)(gbase) + (voff)[_i]), (PG8_LAS unsigned*)(lds + (bufoff) + ldsw + _i * 8192), 16, 0, 0); } while (0)
#define PG8_LDA(dst, b, h) do { _Pragma("unroll") for (int m = 0; m < 4; ++m) _Pragma("unroll") for (int k = 0; k < 2; ++k) dst[m][k] = *(const PG8_LAS bf16x8*)(lds + PG8_SA(b, h) + aoff + m * 2048 + k * 1024); } while (0)
#define PG8_LDB(dst, b, h) do { _Pragma("unroll") for (int n = 0; n < 2; ++n) _Pragma("unroll") for (int k = 0; k < 2; ++k) dst[n][k] = *(const PG8_LAS bf16x8*)(lds + PG8_SB(b, h) + boff + n * 2048 + k * 1024); } while (0)
#define PG8_MMA(ai, bj, At, Bt) do { __builtin_amdgcn_s_setprio(1); _Pragma("unroll") for (int m = 0; m < 4; ++m) _Pragma("unroll") for (int n = 0; n < 2; ++n) _Pragma("unroll") for (int k = 0; k < 2; ++k) \
    acc[ai][bj][m][n] = __builtin_amdgcn_mfma_f32_16x16x32_bf16(Bt[n][k], At[m][k], acc[ai][bj][m][n], 0, 0, 0); __builtin_amdgcn_s_setprio(0); } while (0)
#define PG8_WAIT_V(n) asm volatile("s_waitcnt vmcnt(" #n ")" ::: "memory")
#define PG8_WAIT_L(n) asm volatile("s_waitcnt lgkmcnt(" #n ")" ::: "memory")
#define PG8_BAR __builtin_amdgcn_s_barrier()
#define PG8_SCHED __builtin_amdgcn_sched_barrier(0)
  Unit cur, nxt; int ui = 0;
  if (!S.next(0, cur)) return;
  f32x4 acc[2][2][4][2];
#pragma unroll
  for (int a = 0; a < 2; ++a)
#pragma unroll
    for (int b = 0; b < 2; ++b)
#pragma unroll
      for (int m = 0; m < 4; ++m)
#pragma unroll
        for (int n = 0; n < 2; ++n) acc[a][b][m][n] = (f32x4){0.f, 0.f, 0.f, 0.f};
  bf16x8 At[4][2], B0[2][2], B1[2][2];
  const char* cA = (const char*)cur.A + (size_t)cur.pm * tstep; const char* cB = (const char*)cur.Bt + (size_t)cur.pn * tstep;
  PG8_STAGE(PG8_SB(0, 0), cB, voffB); PG8_STAGE(PG8_SA(0, 0), cA, voffA); PG8_STAGE(PG8_SB(0, 1), cB + hstep, voffB); PG8_STAGE(PG8_SA(0, 1), cA + hstep, voffA);
  if (wr == 1) PG8_BAR;
  PG8_WAIT_V(4); PG8_BAR;
  PG8_STAGE(PG8_SB(1, 0), cB + kstep, voffB); PG8_STAGE(PG8_SA(1, 0), cA + kstep, voffA); PG8_STAGE(PG8_SB(1, 1), cB + hstep + kstep, voffB);
  PG8_WAIT_V(6); PG8_BAR;
  for (;;) {
    const bool has_next = S.next(ui + 1, nxt);
    const char* nA = has_next ? (const char*)nxt.A + (size_t)nxt.pm * tstep : cA; const char* nB = has_next ? (const char*)nxt.Bt + (size_t)nxt.pn * tstep : cB;
    for (int t = 0; t < nt; t += 2) {
      const bool last = (t == nt - 2);
      const char* a1 = cA + (size_t)(t + 1) * kstep;
      const char* a2 = last ? nA : cA + (size_t)(t + 2) * kstep; const char* b2 = last ? nB : cB + (size_t)(t + 2) * kstep;
      const char* a3 = a2 + kstep; const char* b3 = b2 + kstep;
      PG8_LDB(B0, 0, 0); PG8_SCHED; PG8_LDA(At, 0, 0); PG8_STAGE(PG8_SA(1, 1), a1 + hstep, voffA);
      PG8_WAIT_L(8); PG8_BAR; PG8_WAIT_L(0); PG8_MMA(0, 0, At, B0); PG8_BAR; PG8_SCHED;
      PG8_LDB(B1, 0, 1); PG8_STAGE(PG8_SB(0, 0), b2, voffB);
      PG8_BAR; PG8_WAIT_L(0); PG8_MMA(0, 1, At, B1); PG8_BAR;
      PG8_LDA(At, 0, 1); PG8_STAGE(PG8_SA(0, 0), a2, voffA);
      PG8_BAR; PG8_WAIT_L(0); PG8_MMA(1, 0, At, B0); PG8_BAR; PG8_SCHED;
      PG8_STAGE(PG8_SB(0, 1), b2 + hstep, voffB);
      PG8_WAIT_V(6); PG8_BAR; PG8_MMA(1, 1, At, B1); PG8_BAR;
      PG8_LDB(B0, 1, 0); PG8_SCHED; PG8_LDA(At, 1, 0); PG8_STAGE(PG8_SA(0, 1), a2 + hstep, voffA);
      PG8_WAIT_L(8); PG8_BAR; PG8_WAIT_L(0); PG8_MMA(0, 0, At, B0); PG8_BAR; PG8_SCHED;
      PG8_LDB(B1, 1, 1); PG8_STAGE(PG8_SB(1, 0), b3, voffB);
      PG8_BAR; PG8_WAIT_L(0); PG8_MMA(0, 1, At, B1); PG8_BAR;
      PG8_LDA(At, 1, 1); PG8_STAGE(PG8_SA(1, 0), a3, voffA);
      PG8_BAR; PG8_WAIT_L(0); PG8_MMA(1, 0, At, B0); PG8_BAR; PG8_SCHED;
      PG8_STAGE(PG8_SB(1, 1), b3 + hstep, voffB);
      PG8_WAIT_V(6); PG8_BAR; PG8_MMA(1, 1, At, B1); PG8_BAR;
    }
    if (!cur.keep) E(acc, cur, wr, wc, fr, fq);
    if (!has_next) break;
    if (!cur.keep) {
#pragma unroll
      for (int a = 0; a < 2; ++a)
#pragma unroll
        for (int b = 0; b < 2; ++b)
#pragma unroll
          for (int m = 0; m < 4; ++m)
#pragma unroll
            for (int n = 0; n < 2; ++n) acc[a][b][m][n] = (f32x4){0.f, 0.f, 0.f, 0.f};
    }
    cur = nxt; cA = nA; cB = nB; ++ui;
  }
  PG8_WAIT_V(0);
  if (wr == 0) PG8_BAR;
  PG8_BAR;
#undef PG8_SA
#undef PG8_SB
#undef PG8_STAGE
#undef PG8_LDA
#undef PG8_LDB
#undef PG8_MMA
#undef PG8_WAIT_V
#undef PG8_WAIT_L
#undef PG8_BAR
#undef PG8_SCHED
}

DEVI u4 pack8acc(f32x4 v0, f32x4 v1) { u4 o; o.x = cvt_pk_bf16(v0[0], v0[1]); o.y = cvt_pk_bf16(v0[2], v0[3]); o.z = cvt_pk_bf16(v1[0], v1[1]); o.w = cvt_pk_bf16(v1[2], v1[3]); return o; }
struct EpiProj {
  static constexpr bool PERM = true;
  u16* sec; u16* halo;
  DEVI void operator()(const f32x4 (&acc)[2][2][4][2], const Unit& u, int wr, int wc, int fr, int fq) const {
    const int s = u.pn >> 1, cb = (u.pn & 1) * 256 + wc * 32 + 8 * fq;
    u16* dst = sec + (size_t)s * SECE;
#pragma unroll
    for (int ai = 0; ai < 2; ++ai)
#pragma unroll
      for (int m = 0; m < 4; ++m) {
        const int row = u.pm * 256 + ai * 128 + wr * 64 + m * 16 + fr;
        const bool hl = (s < 3) && ((row & 63) >= 61);
#pragma unroll
        for (int bj = 0; bj < 2; ++bj) {
          const u4 o = pack8acc(acc[ai][bj][m][0], acc[ai][bj][m][1]);
          *(u4*)(dst + (size_t)row * 512 + cb + bj * 128) = o;
          if (hl) *(u4*)(halo + ((size_t)(row >> 6) * 3 + ((row & 63) - 61)) * 1536 + s * 512 + cb + bj * 128) = o;
        }
      }
  }
};
struct EpiGates {
  static constexpr bool PERM = true;
  u16* sec;
  DEVI void operator()(const f32x4 (&acc)[2][2][4][2], const Unit& u, int wr, int wc, int fr, int fq) const {
    const int cb = (u.pn & 1) * 256 + wc * 32 + 8 * fq;
    u16* dst = sec + (size_t)gate_sec(u.pn >> 1) * SECE;
#pragma unroll
    for (int ai = 0; ai < 2; ++ai)
#pragma unroll
      for (int m = 0; m < 4; ++m) {
        const int row = u.pm * 256 + ai * 128 + wr * 64 + m * 16 + fr;
#pragma unroll
        for (int bj = 0; bj < 2; ++bj) {
          f32x4 v0 = acc[ai][bj][m][0], v1 = acc[ai][bj][m][1];
#pragma unroll
          for (int e = 0; e < 4; ++e) { v0[e] = __builtin_amdgcn_rcpf(1.f + __expf(-v0[e])); v1[e] = __builtin_amdgcn_rcpf(1.f + __expf(-v1[e])); }
          *(u4*)(dst + (size_t)row * 512 + cb + bj * 128) = pack8acc(v0, v1);
        }
      }
  }
};
struct EpiMlp1 {
  static constexpr bool PERM = true;
  u16* hid; const float* rowss; const float* bias2;
  DEVI void operator()(const f32x4 (&acc)[2][2][4][2], const Unit& u, int wr, int wc, int fr, int fq) const {
    const int cb = u.pn * 256 + wc * 32 + 8 * fq;
    const int b = (u.pm * 256) >> 13;
    const int lane = fq * 16 + fr;
    float rs[2];
#pragma unroll
    for (int ai = 0; ai < 2; ++ai) {
      const float* rp = rowss + (size_t)(u.pm * 256 + ai * 128 + wr * 64 + lane) * 16;
      const f32x4 p0 = *(const f32x4*)rp, p1 = *(const f32x4*)(rp + 4), p2 = *(const f32x4*)(rp + 8), p3 = *(const f32x4*)(rp + 12);
      const float ssum = (p0[0] + p0[1] + p0[2] + p0[3]) + (p1[0] + p1[1] + p1[2] + p1[3]) + (p2[0] + p2[1] + p2[2] + p2[3]) + (p3[0] + p3[1] + p3[2] + p3[3]);
      rs[ai] = rsqrtf(ssum * (1.f / 1024.f) + 1e-6f);
    }
    f32x4 bv[2][2];
#pragma unroll
    for (int bj = 0; bj < 2; ++bj)
#pragma unroll
      for (int n = 0; n < 2; ++n) bv[bj][n] = *(const f32x4*)(bias2 + (size_t)b * 4096 + cb + bj * 128 + 4 * n);
#pragma unroll
    for (int ai = 0; ai < 2; ++ai)
#pragma unroll
      for (int m = 0; m < 4; ++m) {
        const int row = u.pm * 256 + ai * 128 + wr * 64 + m * 16 + fr;
        const float r = __shfl(rs[ai], m * 16 + fr);
#pragma unroll
        for (int bj = 0; bj < 2; ++bj) {
          f32x4 v0 = acc[ai][bj][m][0] * r + bv[bj][0], v1 = acc[ai][bj][m][1] * r + bv[bj][1];
#pragma unroll
          for (int e = 0; e < 4; ++e) { const float a = fmaxf(v0[e], 0.f), c = fmaxf(v1[e], 0.f); v0[e] = a * a; v1[e] = c * c; }
          *(u4*)(hid + (size_t)row * 4096 + cb + bj * 128) = pack8acc(v0, v1);
        }
      }
  }
};
struct EpiResidXs {
  static constexpr bool PERM = false;
  const float* xin; float* out; const float* gate; const float* sc2g; const float* sc2s; u16* xs; float* rowss;
  DEVI void operator()(const f32x4 (&acc)[2][2][4][2], const Unit& u, int wr, int wc, int fr, int fq) const {
    const int b = (u.pm * 256) >> 13;
    const int cb = u.pn * 256 + wc * 32 + 4 * fq;
    f32x4 gv[2][2], sc[2][2];
#pragma unroll
    for (int bj = 0; bj < 2; ++bj)
#pragma unroll
      for (int n = 0; n < 2; ++n) {
        gv[bj][n] = *(const f32x4*)(gate + (size_t)b * 6144 + cb + bj * 128 + n * 16);
        sc[bj][n] = *(const f32x4*)(sc2g + cb + bj * 128 + n * 16) * (*(const f32x4*)(sc2s + (size_t)b * 6144 + cb + bj * 128 + n * 16) + 1.f);
      }
#pragma unroll
    for (int am = 0; am < 8; ++am) {
      const int ai = am >> 2, m = am & 3;
      const int row = u.pm * 256 + ai * 128 + wr * 64 + m * 16 + fr;
      const size_t ro = (size_t)row * 1024 + cb;
      f32x4 xv[2][2];
#pragma unroll
      for (int bj = 0; bj < 2; ++bj)
#pragma unroll
        for (int n = 0; n < 2; ++n) xv[bj][n] = *(const f32x4*)(xin + ro + bj * 128 + n * 16);
      float ssq = 0.f;
#pragma unroll
      for (int bj = 0; bj < 2; ++bj)
#pragma unroll
        for (int n = 0; n < 2; ++n) {
          const f32x4 v = xv[bj][n] + gv[bj][n] * acc[ai][bj][m][n];
          *(f32x4*)(out + ro + bj * 128 + n * 16) = v;
          ssq += v[0] * v[0] + v[1] * v[1] + v[2] * v[2] + v[3] * v[3];
          const f32x4 w = v * sc[bj][n];
          u2 o; o.x = cvt_pk_bf16(w[0], w[1]); o.y = cvt_pk_bf16(w[2], w[3]);
          *(u2*)(xs + ro + bj * 128 + n * 16) = o;
        }
      ssq += __shfl_xor(ssq, 16); ssq += __shfl_xor(ssq, 32);
      if (fq == 0) rowss[(size_t)row * 16 + u.pn * 4 + wc] = ssq;
    }
  }
};
struct EpiResid {
  static constexpr bool PERM = false;
  const float* xin; float* out; const float* gate;
  DEVI void operator()(const f32x4 (&acc)[2][2][4][2], const Unit& u, int wr, int wc, int fr, int fq) const {
    const int b = (u.pm * 256) >> 13;
    const int cb = u.pn * 256 + wc * 32 + 4 * fq;
    f32x4 gv[2][2];
#pragma unroll
    for (int bj = 0; bj < 2; ++bj)
#pragma unroll
      for (int n = 0; n < 2; ++n) gv[bj][n] = *(const f32x4*)(gate + (size_t)b * 6144 + cb + bj * 128 + n * 16);
#pragma unroll
    for (int am = 0; am < 4; ++am) {
      const int ai = am >> 1, m0 = (am & 1) * 2;
      f32x4 xv[2][2][2];
#pragma unroll
      for (int mm = 0; mm < 2; ++mm) {
        const size_t ro = (size_t)(u.pm * 256 + ai * 128 + wr * 64 + (m0 + mm) * 16 + fr) * 1024 + cb;
#pragma unroll
        for (int bj = 0; bj < 2; ++bj)
#pragma unroll
          for (int n = 0; n < 2; ++n) xv[mm][bj][n] = *(const f32x4*)(xin + ro + bj * 128 + n * 16);
      }
#pragma unroll
      for (int mm = 0; mm < 2; ++mm) {
        const size_t ro = (size_t)(u.pm * 256 + ai * 128 + wr * 64 + (m0 + mm) * 16 + fr) * 1024 + cb;
#pragma unroll
        for (int bj = 0; bj < 2; ++bj)
#pragma unroll
          for (int n = 0; n < 2; ++n) *(f32x4*)(out + ro + bj * 128 + n * 16) = xv[mm][bj][n] + gv[bj][n] * acc[ai][bj][m0 + mm][n];
      }
    }
  }
};

struct HalfKOrder {
  StaticOrder base; size_t aPlane, bPlane;
  DEVI bool next(int i, Unit& u) const {
    if (!base.next(i >> 1, u)) return false;
    const int hf = i & 1;
    u.A += (size_t)hf * aPlane; u.Bt += (size_t)hf * bPlane; u.keep = hf == 0;
    return true;
  }
};
struct FusedOrder {
  int G, c; const u16 *y0, *y1, *Wbr, *hA, *Wg;
  static constexpr size_t aPlane = 8388608, bPlane = (size_t)9728 * 512;
  DEVI bool next(int i, Unit& u) const {
    const int tile = c + (i / 12) * G; if (tile >= 256) return false;
    const int sub = i % 12, b = sub / 3, r = sub % 3;
    u.pm = tile >> 2; u.pn = tile & 3;
    if (r < 2) { u.A = hA + (size_t)r * aPlane; u.Bt = Wg + (size_t)r * bPlane + (size_t)b * 1024 * 512; u.keep = r == 0; u.br = b * 2; }
    else {
      const u16* sb = y0; const u16* yb = y1;
      asm volatile("" : "+s"(sb)); asm volatile("" : "+s"(yb));
      const size_t so = b == 0 ? 0 : (b == 2 ? 2 * SECE : 7 * SECE);
      u.A = (b == 1) ? yb : sb + so;
      u.Bt = Wbr + (size_t)b * 1024 * 512; u.keep = 0; u.br = b * 2 + 1;
    }
    return true;
  }
};
struct EpiFused {
  static constexpr bool PERM = true;
  u16* scratch; u16* mg;
  DEVI void operator()(const f32x4 (&acc)[2][2][4][2], const Unit& u, int wr, int wc, int fr_, int fq_) const {
    int ln_ = fq_ * 16 + fr_; asm volatile("" : "+v"(ln_));
    const int fr = ln_ & 15, fq = ln_ >> 4;
    const int tid = (wr * 4 + wc) * 64 + fq * 16 + fr;
    u16* sp = scratch + (size_t)blockIdx.x * 65536 + tid * 8;
    if ((u.br & 1) == 0) {
#pragma unroll
      for (int ai = 0; ai < 2; ++ai)
#pragma unroll
        for (int m = 0; m < 4; ++m)
#pragma unroll
          for (int bj = 0; bj < 2; ++bj) {
            f32x4 v0 = acc[ai][bj][m][0], v1 = acc[ai][bj][m][1];
#pragma unroll
            for (int e2 = 0; e2 < 4; ++e2) { v0[e2] = sigmf(v0[e2]); v1[e2] = sigmf(v1[e2]); }
            *(u4*)(sp + ((ai * 4 + m) * 2 + bj) * 4096) = pack8acc(v0, v1);
          }
    } else {
      const int cg0 = u.pn * 256 + wc * 32 + 8 * fq;
      const bool first = (u.br >> 1) == 0;
#pragma unroll
      for (int am = 0; am < 4; ++am) {
        const int ai = am >> 1, m0 = (am & 1) * 2;
        u4 gq[2][2], hq[2][2];
#pragma unroll
        for (int mm = 0; mm < 2; ++mm) {
          const size_t ro = (size_t)(u.pm * 256 + ai * 128 + wr * 64 + (m0 + mm) * 16 + fr) * 1024 + cg0;
#pragma unroll
          for (int bj = 0; bj < 2; ++bj) {
            gq[mm][bj] = *(const u4*)(sp + ((ai * 4 + m0 + mm) * 2 + bj) * 4096);
            hq[mm][bj] = u4{0, 0, 0, 0};
            if (!first) hq[mm][bj] = *(const u4*)(mg + ro + bj * 128);
          }
        }
#pragma unroll
        for (int mm = 0; mm < 2; ++mm) {
          const int m = m0 + mm;
          const size_t ro = (size_t)(u.pm * 256 + ai * 128 + wr * 64 + m * 16 + fr) * 1024 + cg0;
#pragma unroll
          for (int bj = 0; bj < 2; ++bj) {
            float gv[8], hv[8];
            unpack8(gq[mm][bj], gv); unpack8(hq[mm][bj], hv);
            f32x4 v0 = acc[ai][bj][m][0], v1 = acc[ai][bj][m][1];
#pragma unroll
            for (int e2 = 0; e2 < 4; ++e2) { v0[e2] = hv[e2] + gv[e2] * v0[e2]; v1[e2] = hv[4 + e2] + gv[4 + e2] * v1[e2]; }
            *(u4*)(mg + ro + bj * 128) = pack8acc(v0, v1);
          }
        }
      }
    }
  }
};
struct MergeOrder {
  int G, c; const u16* yA[4]; const u16* Wbr;
  DEVI bool next(int i, Unit& u) const {
    const int tile = c + (i >> 2) * G; if (tile >= 256) return false;
    const int b = i & 3;
    u.pm = tile >> 2; u.pn = tile & 3; u.br = b; u.keep = 0;
    u.A = b == 0 ? yA[0] : (b == 1 ? yA[1] : (b == 2 ? yA[2] : yA[3]));
    u.Bt = Wbr + (size_t)b * 1024 * 512;
    return true;
  }
};
struct EpiMerge {
  static constexpr bool PERM = true;
  const u16* sec; u16* hb;
  DEVI void operator()(const f32x4 (&acc)[2][2][4][2], const Unit& u, int wr, int wc, int fr, int fq) const {
    const int cg0 = u.pn * 256 + wc * 32 + 8 * fq;
    const u16* gs = sec + (size_t)gate_sec(u.br * 2 + (cg0 >> 9)) * SECE + (cg0 & 511);
    const bool first = (u.br == 0);
#pragma unroll
    for (int am = 0; am < 4; ++am) {
      const int ai = am >> 1, m0 = (am & 1) * 2;
      u4 gq[2][2], hq[2][2];
#pragma unroll
      for (int mm = 0; mm < 2; ++mm) {
        const int row = u.pm * 256 + ai * 128 + wr * 64 + (m0 + mm) * 16 + fr;
#pragma unroll
        for (int bj = 0; bj < 2; ++bj) {
          gq[mm][bj] = *(const u4*)(gs + (size_t)row * 512 + bj * 128);
          hq[mm][bj] = u4{0, 0, 0, 0};
          if (!first) hq[mm][bj] = *(const u4*)(hb + (size_t)row * 1024 + cg0 + bj * 128);
        }
      }
#pragma unroll
      for (int mm = 0; mm < 2; ++mm) {
        const int m = m0 + mm;
        const int row = u.pm * 256 + ai * 128 + wr * 64 + m * 16 + fr;
#pragma unroll
        for (int bj = 0; bj < 2; ++bj) {
          float gv[8], hv[8];
          unpack8(gq[mm][bj], gv); unpack8(hq[mm][bj], hv);
          f32x4 v0 = acc[ai][bj][m][0], v1 = acc[ai][bj][m][1];
#pragma unroll
          for (int e = 0; e < 4; ++e) { v0[e] = hv[e] + gv[e] * v0[e]; v1[e] = hv[4 + e] + gv[4 + e] * v1[e]; }
          *(u4*)(hb + (size_t)row * 1024 + cg0 + bj * 128) = pack8acc(v0, v1);
        }
      }
    }
  }
};
}

DEVI void proj_phase(const P& p, unsigned char* smem) {
  pg8::HalfKOrder S; S.base.init(16384, 5632, gridDim.x, blockIdx.x, p.h, p.WinT); S.aPlane = 8388608; S.bPlane = (size_t)9728 * 512;
  const pg8::Gemm g{p.h, p.WinT, 16384, 5632, 512};
  const pg8::EpiProj E{p.sec, p.halo};
  pg8::gemm_phase((PG8_LAS unsigned char*)smem, g, S, E);
}
DEVI void gates_phase(const P& p, unsigned char* smem) {
  pg8::StaticOrder S; S.init(16384, 4096, gridDim.x, blockIdx.x, p.h, p.WinT + (size_t)5632 * 1024);
  const pg8::Gemm g{p.h, p.WinT + (size_t)5632 * 1024, 16384, 4096, 1024};
  const pg8::EpiGates E{p.sec};
  pg8::gemm_phase((PG8_LAS unsigned char*)smem, g, S, E);
}
DEVI void merge_phase(const P& p, unsigned char* smem) {
  pg8::FusedOrder S;
  S.G = gridDim.x; S.c = blockIdx.x; S.y0 = p.sec + 3 * SECE; S.y1 = p.YB; S.Wbr = p.WbrT;
  S.hA = p.h; S.Wg = p.WinT + (size_t)5632 * 512;
  const pg8::Gemm g{p.YB, p.WbrT, 16384, 1024, 512};
  const pg8::EpiFused E{p.sec + 6 * SECE, p.sec};
  pg8::gemm_phase((PG8_LAS unsigned char*)smem, g, S, E);
}
DEVI void resid_gemm_phase(const P& p, int l, int which, unsigned char* smem) {
  pg8::StaticOrder S; S.init(16384, 1024, gridDim.x, blockIdx.x, p.sec, which == 0 ? p.WoutT : p.W2T);
  const pg8::Gemm g{p.sec, which == 0 ? p.WoutT : p.W2T, 16384, 1024, which == 0 ? 1024 : 4096};
  const float* modl = p.modp + (size_t)l * 2 * 6144;
  if (which == 0) {
    const pg8::EpiResidXs E{l == 0 ? p.x : p.out, p.out, modl + 2 * 1024, p.norm2_g + l * 1024, modl + 4 * 1024, p.sec + 8 * SECE, p.rowss};
    pg8::gemm_phase((PG8_LAS unsigned char*)smem, g, S, E);
  } else {
    const pg8::EpiResid E{p.out, p.out, modl + 5 * 1024};
    pg8::gemm_phase((PG8_LAS unsigned char*)smem, g, S, E);
  }
}
DEVI void mlp1_phase(const P& p, unsigned char* smem) {
  pg8::StaticOrder S; S.init(16384, 4096, gridDim.x, blockIdx.x, p.sec + 8 * SECE, p.W1T);
  const pg8::Gemm g{p.sec + 8 * SECE, p.W1T, 16384, 4096, 1024};
  const pg8::EpiMlp1 E{p.sec, p.rowss, p.modp + 32768};
  pg8::gemm_phase((PG8_LAS unsigned char*)smem, g, S, E);
}
DEVI void bias2_unit(const P& p, int l, int u) {
  const int t = tid_l(), lane = t & 63, wid = t >> 6;
  float sh0[16], sh1[16];
#pragma unroll
  for (int j = 0; j < 16; ++j) { sh0[j] = modval(p, l, 0, 3 * 1024 + lane * 16 + j); sh1[j] = modval(p, l, 1, 3 * 1024 + lane * 16 + j); }
#pragma unroll 1
  for (int c = 0; c < 8; ++c) {
    const int n = u * 64 + wid * 8 + c;
    float w[16];
    const u16* wp = p.W1T + (size_t)n * 1024 + lane * 16;
    unpack8(*(const u4*)wp, w); unpack8(*(const u4*)(wp + 8), w + 8);
    float a0 = 0.f, a1 = 0.f;
#pragma unroll
    for (int j = 0; j < 16; ++j) { a0 += sh0[j] * w[j]; a1 += sh1[j] * w[j]; }
    a0 = wave_sum(a0); a1 = wave_sum(a1);
    if (lane == 0) { p.modp[32768 + n] = a0; p.modp[32768 + 4096 + n] = a1; }
  }
}

DEVI bf16x8 acc2frag(f32x4 t0, f32x4 t1, float sgn) {
  u4 o; o.x = pack2(sgn * t0[0], sgn * t0[1]); o.y = pack2(sgn * t0[2], sgn * t0[3]); o.z = pack2(sgn * t1[0], sgn * t1[1]); o.w = pack2(sgn * t1[2], sgn * t1[3]);
  return *(bf16x8*)&o;
}
DEVI void dn_prep_unit(const P& p, int l, int u, unsigned char* smem) {
  const int t = tid_l(), lane = t & 63, wid = t >> 6, mr = lane & 15, g = lane >> 4;
  const int h = u & 3, n = (u >> 2) & 127, b = u >> 9;
  const int r0 = b * SEQ + n * 64;
  float* Lm = (float*)smem;
  float* cw = Lm + 64 * 64;
  float* gcs = cw + 1536;
  u16* Qs = (u16*)(gcs + 128);
  u16* Ks = Qs + 64 * 136;
  u16* KTl = Ks + 64 * 136;
  u16* VTl = KTl + 128 * 72;
  u16* TB = VTl + 128 * 72;
  u16* TBe = TB + 64 * 72;
  float* bs = gcs + 64;
  for (int i = t; i < 1536; i += NT) {
    const int s = i >> 9, j = (i >> 7) & 3, c = i & 127;
    cw[i] = p.dn_conv_w[(size_t)(l * 4 + j) * 1536 + s * 512 + h * 128 + c];
  }
  if (wid == 0) {
    float gg = p.glog[(size_t)(r0 + lane) * 4 + h];
#pragma unroll
    for (int o = 1; o < 64; o <<= 1) {
      const float v = __shfl_up(gg, o);
      if (lane >= o) gg += v;
    }
    gcs[lane] = gg;
    bs[lane] = p.beta[(size_t)(r0 + lane) * 4 + h];
  }
  __syncthreads();
  const int row = t >> 3, c0 = (t & 7) * 16;
#pragma unroll
  for (int s = 0; s < 3; ++s) {
    const u16* sp = p.sec + (size_t)s * SECE;
    float y[16];
#pragma unroll
    for (int c = 0; c < 16; ++c) y[c] = 0.f;
#pragma unroll
    for (int j = 0; j < 4; ++j) {
      const int tt = row - 3 + j;
      u4 v0 = {0, 0, 0, 0}, v1 = {0, 0, 0, 0};
      if (tt >= 0) {
        const u16* src = sp + (size_t)(r0 + tt) * 512 + h * 128 + c0;
        v0 = *(const u4*)src; v1 = *(const u4*)(src + 8);
      } else if (n > 0) {
        const u16* src = p.halo + ((size_t)((r0 >> 6) - 1) * 3 + (tt + 3)) * 1536 + s * 512 + h * 128 + c0;
        v0 = *(const u4*)src; v1 = *(const u4*)(src + 8);
      }
      float f[16];
      unpack8(v0, f); unpack8(v1, f + 8);
#pragma unroll
      for (int c = 0; c < 16; ++c) y[c] += cw[(s * 4 + j) * 128 + c0 + c] * f[c];
    }
    float ss = 0.f;
#pragma unroll
    for (int c = 0; c < 16; ++c) { y[c] = siluf(y[c]); ss += y[c] * y[c]; }
    if (s < 2) {
      ss += __shfl_xor(ss, 1); ss += __shfl_xor(ss, 2); ss += __shfl_xor(ss, 4);
      const float sc = rsqrtf(ss + 1e-6f) * (s == 0 ? 0.08838834764831845f : 1.f);
#pragma unroll
      for (int c = 0; c < 16; ++c) y[c] *= sc;
    }
    if (s < 2) {
      u16* dl = (s == 0 ? Qs : Ks) + row * 136 + c0;
      *(u4*)dl = pack8(y); *(u4*)(dl + 8) = pack8(y + 8);
    }
    if (s >= 1) {
      u16* dT = (s == 1 ? KTl : VTl);
#pragma unroll
      for (int c = 0; c < 16; ++c) dT[(c0 + c) * 72 + row] = f2bf(y[c]);
    }
  }
  __syncthreads();
#pragma unroll 1
  for (int idx = wid; idx < 10; idx += 8) {
    const int ti = idx >= 6 ? 3 : (idx >= 3 ? 2 : (idx >= 1 ? 1 : 0)), tj = idx - ti * (ti + 1) / 2;
    f32x4 akk = {0.f, 0.f, 0.f, 0.f};
#pragma unroll
    for (int k0 = 0; k0 < 128; k0 += 32) akk = mfma16(frag(Ks, 136, ti * 16, k0, lane), frag(Ks, 136, tj * 16, k0, lane), akk);
    const int j = tj * 16 + mr;
#pragma unroll
    for (int r = 0; r < 4; ++r) {
      const int i = ti * 16 + g * 4 + r;
      Lm[i * 64 + j] = (i > j) ? bs[i] * akk[r] * __expf(gcs[i] - gcs[j]) : 0.f;
    }
  }
  if (wid < 6) {
    const int m = wid < 2 ? wid : (wid < 4 ? 2 : 3), ks2 = wid < 2 ? 0 : ((wid - 2) & 1);
    f32x4 t0 = {0.f, 0.f, 0.f, 0.f}, t1 = {0.f, 0.f, 0.f, 0.f};
#pragma unroll
    for (int k0 = 0; k0 < 128; k0 += 32) {
      const bf16x8 bq = frag(Qs, 136, m * 16, k0, lane);
      t0 = mfma16(frag(Ks, 136, (2 * ks2) * 16, k0, lane), bq, t0);
      t1 = mfma16(frag(Ks, 136, (2 * ks2 + 1) * 16, k0, lane), bq, t1);
    }
    const int i = m * 16 + mr;
    const float gi = gcs[i];
#pragma unroll
    for (int r = 0; r < 4; ++r) {
      const int j0 = 32 * ks2 + 4 * g + r, j1 = j0 + 16;
      t0[r] = (i >= j0) ? t0[r] * __expf(gi - gcs[j0]) : 0.f;
      t1[r] = (i >= j1) ? t1[r] * __expf(gi - gcs[j1]) : 0.f;
    }
    *(bf16x8*)(p.QKF + (size_t)u * 3072 + wid * 512 + lane * 8) = acc2frag(t0, t1, 1.f);
  }
  __syncthreads();
  {
    typedef float f32x16 __attribute__((ext_vector_type(16)));
    float* Tf = (float*)(TBe + 64 * 72);
    float* Xf = Tf + 2048;
    if (wid < 2 && lane < 32) {
      const int o = wid * 32;
      float T[32];
#pragma unroll
      for (int i = 0; i < 32; ++i) {
        float sv = (i == lane) ? 1.f : 0.f;
#pragma unroll
        for (int j = 0; j < i; ++j) sv -= Lm[(o + i) * 64 + o + j] * T[j];
        T[i] = sv;
      }
#pragma unroll
      for (int i = 0; i < 32; ++i) Tf[wid * 1024 + i * 32 + lane] = T[i];
    }
    __syncthreads();
    if (wid == 0) {
      const int li = lane & 31, lh = lane >> 5;
      f32x16 acc;
#pragma unroll
      for (int r = 0; r < 16; ++r) acc[r] = 0.f;
#pragma unroll
      for (int kk = 0; kk < 16; ++kk)
        acc = __builtin_amdgcn_mfma_f32_32x32x2f32(Lm[(32 + li) * 64 + 2 * kk + lh], Tf[(2 * kk + lh) * 32 + li], acc, 0, 0, 0);
#pragma unroll
      for (int r = 0; r < 16; ++r) Xf[((r & 3) + 8 * (r >> 2) + 4 * lh) * 32 + li] = acc[r];
      asm volatile("s_waitcnt lgkmcnt(0)" ::: "memory");
      f32x16 acc2;
#pragma unroll
      for (int r = 0; r < 16; ++r) acc2[r] = 0.f;
#pragma unroll
      for (int kk = 0; kk < 16; ++kk)
        acc2 = __builtin_amdgcn_mfma_f32_32x32x2f32(Tf[1024 + li * 32 + 2 * kk + lh], Xf[(2 * kk + lh) * 32 + li], acc2, 0, 0, 0);
#pragma unroll
      for (int r = 0; r < 16; ++r) Lm[(32 + (r & 3) + 8 * (r >> 2) + 4 * lh) * 64 + li] = -acc2[r];
    }
    __syncthreads();
#pragma unroll
    for (int q = 0; q < 8; ++q) {
      const int idx = t + q * NT, i = idx >> 6, j = idx & 63;
      float val = 0.f;
      if (i < 32) { if (j < 32) val = Tf[i * 32 + j]; }
      else if (j >= 32) val = Tf[1024 + (i - 32) * 32 + (j - 32)];
      else val = Lm[i * 64 + j];
      const float bl = bs[j];
      TB[i * 72 + j] = f2bf(val * bl);
      TBe[i * 72 + j] = f2bf(val * bl * __expf(gcs[j]));
    }
  }
  __syncthreads();
  const size_t rbase = (size_t)r0 * 512 + h * 128;
  u16* secQ = p.sec + rbase;
  u16* secW = p.sec + SECE + rbase;
  u16* secK = p.sec + 2 * SECE + rbase;
  const size_t fo = (size_t)(lane >> 4) * 512 + (lane & 15) * 8;
#pragma unroll
  for (int rep = 0; rep < 2; ++rep) {
    const int f = wid + rep * 8;
    {
      const int m = f >> 2, ks = f & 3;
      f32x4 t0 = {0.f, 0.f, 0.f, 0.f}, t1 = {0.f, 0.f, 0.f, 0.f};
#pragma unroll
      for (int k0 = 0; k0 < 64; k0 += 32) {
        const bf16x8 bt = frag(TBe, 72, m * 16, k0, lane);
        t0 = mfma16(frag(KTl, 72, (2 * ks) * 16, k0, lane), bt, t0);
        t1 = mfma16(frag(KTl, 72, (2 * ks + 1) * 16, k0, lane), bt, t1);
      }
      *(bf16x8*)(secW + (size_t)(4 * f) * 512 + fo) = acc2frag(t0, t1, -1.f);
    }
    {
      const int m = f >> 2, ks = f & 3, pos = m * 16 + mr;
      const float eg = __expf(gcs[pos]);
      const u2 a = *(const u2*)(Qs + pos * 136 + 32 * ks + 4 * g), c = *(const u2*)(Qs + pos * 136 + 32 * ks + 16 + 4 * g);
      u4 o;
      o.x = pack2(eg * lo2f(a.x), eg * hi2f(a.x)); o.y = pack2(eg * lo2f(a.y), eg * hi2f(a.y));
      o.z = pack2(eg * lo2f(c.x), eg * hi2f(c.x)); o.w = pack2(eg * lo2f(c.y), eg * hi2f(c.y));
      *(u4*)(secQ + (size_t)(4 * f) * 512 + fo) = o;
    }
    {
      const int d = f >> 1, ks2 = f & 1, dk = d * 16 + mr;
      const float G = gcs[63];
      const u2 a = *(const u2*)(KTl + dk * 72 + 32 * ks2 + 4 * g), c = *(const u2*)(KTl + dk * 72 + 32 * ks2 + 16 + 4 * g);
      const int p0 = 32 * ks2 + 4 * g, p1 = p0 + 16;
      u4 o;
      o.x = pack2(__expf(G - gcs[p0]) * lo2f(a.x), __expf(G - gcs[p0 + 1]) * hi2f(a.x));
      o.y = pack2(__expf(G - gcs[p0 + 2]) * lo2f(a.y), __expf(G - gcs[p0 + 3]) * hi2f(a.y));
      o.z = pack2(__expf(G - gcs[p1]) * lo2f(c.x), __expf(G - gcs[p1 + 1]) * hi2f(c.x));
      o.w = pack2(__expf(G - gcs[p1 + 2]) * lo2f(c.y), __expf(G - gcs[p1 + 3]) * hi2f(c.y));
      *(u4*)(secK + (size_t)(4 * f) * 512 + fo) = o;
    }
  }
  {
    u16* ud = p.TQ + (size_t)u * 8192 + wid * 1024 + lane * 16;
#pragma unroll
    for (int m = 0; m < 4; ++m) {
      f32x4 a = {0.f, 0.f, 0.f, 0.f};
#pragma unroll
      for (int k0 = 0; k0 < 64; k0 += 32) a = mfma16(frag(TB, 72, m * 16, k0, lane), frag(VTl, 72, wid * 16, k0, lane), a);
      *(u2*)(ud + m * 4) = pack4v(a);
    }
  }
  if (t == 0) p.EG[u] = __expf(gcs[63]);
  __syncthreads();
}

DEVI void dn_chain(const P& p, int l, int bh, int half, unsigned char* smem) {
  constexpr int NQ = 1;
  const int t = tid_l(), lane = t & 63, wid = __builtin_amdgcn_readfirstlane(t >> 6);
  const int h = bh & 3, b = bh >> 2;
  typedef __attribute__((address_space(3))) unsigned char* LP_;
  LP_ lds = (LP_)smem;
  constexpr int BUFB = 55296;
  const size_t lo = (size_t)(lane >> 4) * 512 + (lane & 15) * 8;
  auto issue = [&](int n, int bi) __attribute__((always_inline)) {
    if (wid >= 4) {
      const int w4 = wid - 4;
      const size_t rbase = ((size_t)b * SEQ + (size_t)n * 64) * 512 + h * 128;
      const size_t unit = ((size_t)b * 128 + n) * 4 + h;
#pragma unroll
      for (int rep = 0; rep < 4; ++rep) {
        const int f = w4 + rep * 4;
        const size_t go = rbase + (size_t)(4 * f) * 512 + lo;
        __builtin_amdgcn_global_load_lds((const unsigned*)(p.sec + SECE + go), (__attribute__((address_space(3))) unsigned*)(lds + bi * BUFB + f * 1024), 16, 0, 0);
        __builtin_amdgcn_global_load_lds((const unsigned*)(p.sec + go), (__attribute__((address_space(3))) unsigned*)(lds + bi * BUFB + 16384 + f * 1024), 16, 0, 0);
        __builtin_amdgcn_global_load_lds((const unsigned*)(p.sec + 2 * SECE + go), (__attribute__((address_space(3))) unsigned*)(lds + bi * BUFB + 32768 + f * 1024), 16, 0, 0);
      }
#pragma unroll
      for (int rep = 0; rep < 2; ++rep) {
        const int f = w4 + rep * 4;
        if (f < 6)
          __builtin_amdgcn_global_load_lds((const unsigned*)(p.QKF + unit * 3072 + f * 512 + lane * 8), (__attribute__((address_space(3))) unsigned*)(lds + bi * BUFB + 49152 + f * 1024), 16, 0, 0);
      }
    }
  };
  const bool cw_ = wid < 4;
  f32x4 Sacc[2][8];
#pragma unroll
  for (int q = 0; q < NQ; ++q)
#pragma unroll
    for (int j = 0; j < 8; ++j) Sacc[q][j] = f32x4{0.f, 0.f, 0.f, 0.f};
  u4 ur[2][2];
  u4 op[2][2];
  float eGn;
  {
    const size_t unit = ((size_t)b * 128) * 4 + h;
    issue(0, 0);
    if (cw_) {
#pragma unroll
      for (int q = 0; q < NQ; ++q) {
        const u16* us = p.TQ + unit * 8192 + (half * 4 + wid * NQ + q) * 1024 + lane * 16;
        ur[q][0] = *(const u4*)us; ur[q][1] = *(const u4*)(us + 8);
      }
    }
    eGn = p.EG[unit];
  }
#pragma unroll 1
  for (int n = 0; n < 128; ++n) {
    asm volatile("s_waitcnt vmcnt(0)" ::: "memory");
    __syncthreads();
    if (t == 256 && (n & 3) == 0) {
      __builtin_amdgcn_fence(__ATOMIC_RELEASE, "agent");
      asm volatile("s_waitcnt vmcnt(0)" ::: "memory");
      __hip_atomic_store(p.prog + (bh * 2 + half) * 16, (unsigned)(n > 0 ? n - 1 : 0), __ATOMIC_RELAXED, __HIP_MEMORY_SCOPE_AGENT);
    }
    if (cw_ && n > 0) {
      const size_t pu = ((size_t)b * 128 + (n - 1)) * 4 + h;
#pragma unroll
      for (int q = 0; q < NQ; ++q) {
        u16* od = p.TQ + pu * 8192 + (half * 4 + wid * NQ + q) * 1024 + lane * 16;
        *(u4*)od = op[q][0]; *(u4*)(od + 8) = op[q][1];
      }
    }
    u4 uc[2][2];
#pragma unroll
    for (int q = 0; q < NQ; ++q) { uc[q][0] = ur[q][0]; uc[q][1] = ur[q][1]; }
    const float eG = eGn;
    const size_t unit = ((size_t)b * 128 + n) * 4 + h;
    if (n + 1 < 128) {
      issue(n + 1, (n + 1) & 1);
      if (cw_) {
#pragma unroll
        for (int q = 0; q < NQ; ++q) {
          const u16* us = p.TQ + (unit + 4) * 8192 + (half * 4 + wid * NQ + q) * 1024 + lane * 16;
          ur[q][0] = *(const u4*)us; ur[q][1] = *(const u4*)(us + 8);
        }
      }
      eGn = p.EG[unit + 4];
    }
    if (cw_) {
      const __attribute__((address_space(3))) unsigned char* bb = lds + (n & 1) * BUFB + lane * 16;
#define LFRAG(off) (*(const __attribute__((address_space(3))) bf16x8*)(bb + (off)))
      bf16x8 Sb[2][4];
#pragma unroll
      for (int q = 0; q < NQ; ++q)
#pragma unroll
        for (int ks = 0; ks < 4; ++ks) Sb[q][ks] = acc2frag(Sacc[q][2 * ks], Sacc[q][2 * ks + 1], 1.f);
      f32x4 accV[2][4], accO[2][4];
#pragma unroll
      for (int q = 0; q < NQ; ++q) {
        accV[q][0] = f32x4{lo2f(uc[q][0].x), hi2f(uc[q][0].x), lo2f(uc[q][0].y), hi2f(uc[q][0].y)};
        accV[q][1] = f32x4{lo2f(uc[q][0].z), hi2f(uc[q][0].z), lo2f(uc[q][0].w), hi2f(uc[q][0].w)};
        accV[q][2] = f32x4{lo2f(uc[q][1].x), hi2f(uc[q][1].x), lo2f(uc[q][1].y), hi2f(uc[q][1].y)};
        accV[q][3] = f32x4{lo2f(uc[q][1].z), hi2f(uc[q][1].z), lo2f(uc[q][1].w), hi2f(uc[q][1].w)};
#pragma unroll
        for (int m = 0; m < 4; ++m) accO[q][m] = f32x4{0.f, 0.f, 0.f, 0.f};
      }
      constexpr int RING = 24;
      bf16x8 R[RING];
      bf16x8 Vb[2][2];
#define FOFF(i) ((i) < 16 ? (((i) & 3) * 4 + ((i) >> 2)) * 1024 : (i) < 32 ? 16384 + ((((i) - 16) & 3) * 4 + (((i) - 16) >> 2)) * 1024 : (i) < 38 ? 49152 + ((i) - 32) * 1024 : 32768 + ((i) - 38) * 1024)
#pragma unroll
      for (int i = 0; i < RING; ++i) R[i] = LFRAG(FOFF(i));
#pragma unroll
      for (int i = 0; i < 54; ++i) {
        const bf16x8 fr = R[i % RING];
        if (i < 16) {
          const int ks = i >> 2, m = i & 3;
#pragma unroll
          for (int q = 0; q < NQ; ++q) accV[q][m] = mfma16(fr, Sb[q][ks], accV[q][m]);
        } else if (i < 32) {
          const int ks = (i - 16) >> 2, m = (i - 16) & 3;
#pragma unroll
          for (int q = 0; q < NQ; ++q) accO[q][m] = mfma16(fr, Sb[q][ks], accO[q][m]);
        } else if (i < 38) {
          const int f = i - 32;
          const int m = f < 2 ? f : (f < 4 ? 2 : 3), k2 = f < 2 ? 0 : ((f - 2) & 1);
#pragma unroll
          for (int q = 0; q < NQ; ++q) accO[q][m] = mfma16(fr, Vb[q][k2], accO[q][m]);
        } else {
          const int j = i - 38, d = j >> 1, k2 = j & 1;
#pragma unroll
          for (int q = 0; q < NQ; ++q) {
            if (k2 == 0) Sacc[q][d] *= eG;
            Sacc[q][d] = mfma16(fr, Vb[q][k2], Sacc[q][d]);
          }
        }
        if (i == 15) {
#pragma unroll
          for (int q = 0; q < NQ; ++q) { Vb[q][0] = acc2frag(accV[q][0], accV[q][1], 1.f); Vb[q][1] = acc2frag(accV[q][2], accV[q][3], 1.f); }
        }
        if (i + RING < 54) R[i % RING] = LFRAG(FOFF(i + RING));
        __builtin_amdgcn_sched_barrier(0);
      }
#undef FOFF
#undef LFRAG
#pragma unroll
      for (int q = 0; q < NQ; ++q) {
        u4 o0, o1;
        o0.x = pack2(accO[q][0][0], accO[q][0][1]); o0.y = pack2(accO[q][0][2], accO[q][0][3]); o0.z = pack2(accO[q][1][0], accO[q][1][1]); o0.w = pack2(accO[q][1][2], accO[q][1][3]);
        o1.x = pack2(accO[q][2][0], accO[q][2][1]); o1.y = pack2(accO[q][2][2], accO[q][2][3]); o1.z = pack2(accO[q][3][0], accO[q][3][1]); o1.w = pack2(accO[q][3][2], accO[q][3][3]);
        op[q][0] = o0; op[q][1] = o1;
      }
    }
  }
  if (cw_) {
    const size_t pu = ((size_t)b * 128 + 127) * 4 + h;
#pragma unroll
    for (int q = 0; q < NQ; ++q) {
      u16* od = p.TQ + pu * 8192 + (half * 4 + wid * NQ + q) * 1024 + lane * 16;
      *(u4*)od = op[q][0]; *(u4*)(od + 8) = op[q][1];
    }
  }
  asm volatile("s_waitcnt vmcnt(0)" ::: "memory");
  __syncthreads();
  if (t == 256) {
    __builtin_amdgcn_fence(__ATOMIC_RELEASE, "agent");
    asm volatile("s_waitcnt vmcnt(0)" ::: "memory");
    __hip_atomic_store(p.prog + (bh * 2 + half) * 16, 128u, __ATOMIC_RELAXED, __HIP_MEMORY_SCOPE_AGENT);
  }
  __syncthreads();
}

DEVI void dn_chain_helper(const P& p, int bh, unsigned char* smem) {
  const int t = tid_l();
  const int h = bh & 3, b = bh >> 2;
  unsigned acc = 0;
#pragma unroll 1
  for (int n = 1; n < 128; ++n) {
    if (t == 0) {
      unsigned polls = 0;
      while ((int)__hip_atomic_load(p.prog + (bh * 2) * 16, __ATOMIC_RELAXED, __HIP_MEMORY_SCOPE_AGENT) + 4 < n && polls < 200000u) { __builtin_amdgcn_s_sleep(4); ++polls; }
    }
    __syncthreads();
    const size_t r0 = (size_t)b * SEQ + (size_t)n * 64;
    const size_t unit = ((size_t)b * 128 + n) * 4 + h;
    const size_t ro = (r0 + (t >> 3)) * 512 + h * 128 + (t & 7) * 16;
#pragma unroll
    for (int s3 = 0; s3 < 3; ++s3) {
      const u4 a = *(const u4*)(p.sec + (size_t)s3 * SECE + ro), c = *(const u4*)(p.sec + (size_t)s3 * SECE + ro + 8);
      acc ^= a.x ^ a.y ^ a.z ^ a.w ^ c.x ^ c.y ^ c.z ^ c.w;
    }
    {
      const u4 a = *(const u4*)(p.TQ + unit * 8192 + (size_t)t * 16), c = *(const u4*)(p.TQ + unit * 8192 + (size_t)t * 16 + 8);
      acc ^= a.x ^ a.y ^ a.z ^ a.w ^ c.x ^ c.y ^ c.z ^ c.w;
      if (t < 384) { const u4 q = *(const u4*)(p.QKF + unit * 3072 + (size_t)t * 8); acc ^= q.x ^ q.y ^ q.z ^ q.w; }
    }
  }
  if (acc == 0x9e3779b9u) p.prog[1024 - 1] = acc;
  __syncthreads();
}

DEVI void ya_unit(const P& p, int l, int u, unsigned char* smem) {
  const int t = tid_l(), lane = t & 63, wid = t >> 6, c = lane & 15, g = lane >> 4;
  const int h = u & 3, n = (u >> 2) & 127, b = u >> 9;
  const int r0 = b * SEQ + n * 64;
  float* part = (float*)smem;
  const u16* os = p.TQ + (size_t)u * 8192 + wid * 1024 + lane * 16;
  float o[16];
  unpack8(*(const u4*)os, o); unpack8(*(const u4*)(os + 8), o + 8);
#pragma unroll
  for (int i = 0; i < 16; ++i) {
    float s = o[i] * o[i];
    s += __shfl_xor(s, 1); s += __shfl_xor(s, 2); s += __shfl_xor(s, 4); s += __shfl_xor(s, 8);
    if (c == 0) part[wid * 64 + (i >> 2) * 16 + g * 4 + (i & 3)] = s;
  }
  __syncthreads();
  const int dv = wid * 16 + c;
  const float ng = p.dn_norm_g[l * 128 + dv];
  u16* zs = p.sec + 3 * SECE + (size_t)r0 * 512 + h * 128 + dv;
  u16 zv[16];
#pragma unroll
  for (int i = 0; i < 16; ++i) zv[i] = zs[(size_t)((i >> 2) * 16 + g * 4 + (i & 3)) * 512];
#pragma unroll
  for (int i = 0; i < 16; ++i) {
    const int pos = (i >> 2) * 16 + g * 4 + (i & 3);
    float ss = 0.f;
#pragma unroll
    for (int w = 0; w < 8; ++w) ss += part[w * 64 + pos];
    const float rs = rsqrtf(ss * (1.f / 128.f) + 1e-6f);
    zs[(size_t)pos * 512] = f2bf(o[i] * rs * ng * siluf(bf2f(zv[i])));
  }
  __syncthreads();
}

DEVI float ret_log2gamma(int h) { return log2f(1.f - exp2f(-5.f - (float)h)); }
DEVI void load_rope_tile(const P& p, const u16* secp, int r0, int h, float scale, u16* dst, u16* dstT, float l2g) {
  const int t = tid_l();
  const int row = t >> 2, j0 = (t & 3) * 16;
  const u16* src = secp + (size_t)(r0 + row) * 512 + h * 128;
  float x1[16], x2[16];
  unpack8(*(const u4*)(src + j0), x1); unpack8(*(const u4*)(src + j0 + 8), x1 + 8);
  unpack8(*(const u4*)(src + 64 + j0), x2); unpack8(*(const u4*)(src + 64 + j0 + 8), x2 + 8);
  const float* cs = p.ropecs + ((size_t)(r0 + row) * 64 + j0) * 2;
  float o1[16], o2[16];
#pragma unroll
  for (int j = 0; j < 16; j += 2) {
    const float4 c4 = *(const float4*)(cs + j * 2);
    o1[j] = (x1[j] * c4.x - x2[j] * c4.y) * scale;
    o2[j] = (x1[j] * c4.y + x2[j] * c4.x) * scale;
    o1[j + 1] = (x1[j + 1] * c4.z - x2[j + 1] * c4.w) * scale;
    o2[j + 1] = (x1[j + 1] * c4.w + x2[j + 1] * c4.z) * scale;
  }
  *(u4*)(dst + row * 136 + j0) = pack8(o1); *(u4*)(dst + row * 136 + j0 + 8) = pack8(o1 + 8);
  *(u4*)(dst + row * 136 + 64 + j0) = pack8(o2); *(u4*)(dst + row * 136 + 64 + j0 + 8) = pack8(o2 + 8);
  if (dstT) {
    const float z = exp2f(l2g * (float)(127 - row));
#pragma unroll
    for (int j = 0; j < 16; ++j) {
      dstT[(j0 + j) * 136 + row] = f2bf(o1[j] * z);
      dstT[(64 + j0 + j) * 136 + row] = f2bf(o2[j] * z);
    }
  }
}
DEVI void ret_d1_unit(const P& p, int u, unsigned char* smem) {
  const int t = tid_l(), lane = t & 63, wid = t >> 6;
  const int h = u & 3, n = (u >> 2) & 63, b = u >> 8;
  const int r0 = b * SEQ + n * 128;
  const float l2g = ret_log2gamma(h);
  u16* Qs = (u16*)smem;
  u16* Ks = Qs + 128 * 136;
  u16* KTz = Ks + 128 * 136;
  u16* VT = KTz + 128 * 136;
  load_rope_tile(p, p.sec + 7 * SECE, r0, h, 1.f, Qs, nullptr, 0.f);
  load_rope_tile(p, p.sec + 8 * SECE, r0, h, 0.08838834764831845f, Ks, KTz, l2g);
  {
    const int row = t >> 2, c0 = (t & 3) * 32;
    const u16* src = p.sec + 9 * SECE + (size_t)(r0 + row) * 512 + h * 128 + c0;
#pragma unroll
    for (int q = 0; q < 4; ++q) {
      const u4 v = *(const u4*)(src + q * 8);
      const u16* e = (const u16*)&v;
#pragma unroll
      for (int j = 0; j < 8; ++j) VT[(c0 + q * 8 + j) * 136 + row] = e[j];
    }
  }
  __syncthreads();
  f32x4 sacc[8];
#pragma unroll
  for (int ii = 0; ii < 8; ++ii) sacc[ii] = f32x4{0.f, 0.f, 0.f, 0.f};
#pragma unroll
  for (int k0 = 0; k0 < 128; k0 += 32) {
    const bf16x8 a = frag(Ks, 136, wid * 16, k0, lane);
#pragma unroll
    for (int ii = 0; ii < 8; ++ii) sacc[ii] = mfma16(a, frag(Qs, 136, ii * 16, k0, lane), sacc[ii]);
  }
  __syncthreads();
#pragma unroll
  for (int ii = 0; ii < 8; ++ii) {
    const int i = ii * 16 + (lane & 15), j0 = wid * 16 + (lane >> 4) * 4;
    f32x4 v;
#pragma unroll
    for (int r = 0; r < 4; ++r) v[r] = (i >= j0 + r) ? sacc[ii][r] * exp2f(l2g * (float)(i - j0 - r)) : 0.f;
    *(u2*)(Qs + i * 136 + j0) = pack4v(v);
  }
  __syncthreads();
  f32x4 oacc[8], kacc[8];
#pragma unroll
  for (int ii = 0; ii < 8; ++ii) { oacc[ii] = f32x4{0.f, 0.f, 0.f, 0.f}; kacc[ii] = f32x4{0.f, 0.f, 0.f, 0.f}; }
#pragma unroll
  for (int k0 = 0; k0 < 128; k0 += 32) {
    const bf16x8 a1 = frag(Qs, 136, wid * 16, k0, lane), a2 = frag(KTz, 136, wid * 16, k0, lane);
#pragma unroll
    for (int ii = 0; ii < 8; ++ii) {
      const bf16x8 bb = frag(VT, 136, ii * 16, k0, lane);
      oacc[ii] = mfma16(a1, bb, oacc[ii]);
      kacc[ii] = mfma16(a2, bb, kacc[ii]);
    }
  }
  u16* od = p.sec + 8 * SECE;
  u16* kd = p.sec + 9 * SECE;
#pragma unroll
  for (int ii = 0; ii < 8; ++ii) {
    const int e = ii * 16 + (lane & 15);
#pragma unroll
    for (int r = 0; r < 4; ++r) {
      const size_t o = (size_t)(r0 + wid * 16 + (lane >> 4) * 4 + r) * 512 + h * 128 + e;
      od[o] = f2bf(oacc[ii][r]);
      kd[o] = f2bf(kacc[ii][r]);
    }
  }
  __syncthreads();
}
DEVI void ret_d2_unit(const P& p, int l, int b, int h, int n, float (&acc)[32], bool carry, unsigned char* smem) {
  const int t = tid_l(), lane = t & 63, wid = t >> 6;
  const int r0 = b * SEQ + n * 128;
  const float l2g = ret_log2gamma(h);
  u16* Qs = (u16*)smem;
  u16* PT = Qs + 128 * 136;
  load_rope_tile(p, p.sec + 7 * SECE, r0, h, 1.f, Qs, nullptr, 0.f);
  {
    const int d = t >> 2, e0 = (t & 3) * 32;
    const float G = exp2f(l2g * 128.f);
    const u16* src = p.sec + 9 * SECE + ((size_t)b * SEQ + d) * 512 + h * 128 + e0;
    int m = 0;
    if (carry) m = n - 1;
    else {
#pragma unroll
      for (int j = 0; j < 32; ++j) acc[j] = 0.f;
    }
#pragma unroll 1
    for (; m + 4 <= n; m += 4) {
      u4 v[4][4];
#pragma unroll
      for (int mm = 0; mm < 4; ++mm)
#pragma unroll
        for (int q = 0; q < 4; ++q) v[mm][q] = *(const u4*)(src + (size_t)(m + mm) * 128 * 512 + q * 8);
#pragma unroll
      for (int mm = 0; mm < 4; ++mm)
#pragma unroll
        for (int q = 0; q < 4; ++q) {
          float f[8];
          unpack8(v[mm][q], f);
#pragma unroll
          for (int j = 0; j < 8; ++j) acc[q * 8 + j] = acc[q * 8 + j] * G + f[j];
        }
    }
#pragma unroll 1
    for (; m < n; ++m) {
      const u16* s = src + (size_t)m * 128 * 512;
#pragma unroll
      for (int q = 0; q < 4; ++q) {
        float f[8];
        unpack8(*(const u4*)(s + q * 8), f);
#pragma unroll
        for (int j = 0; j < 8; ++j) acc[q * 8 + j] = acc[q * 8 + j] * G + f[j];
      }
    }
#pragma unroll
    for (int j = 0; j < 32; ++j) PT[(e0 + j) * 136 + d] = f2bf(acc[j]);
  }
  __syncthreads();
  f32x4 oacc[8];
#pragma unroll
  for (int ii = 0; ii < 8; ++ii) oacc[ii] = f32x4{0.f, 0.f, 0.f, 0.f};
#pragma unroll
  for (int k0 = 0; k0 < 128; k0 += 32) {
    const bf16x8 a = frag(Qs, 136, wid * 16, k0, lane);
#pragma unroll
    for (int ii = 0; ii < 8; ++ii) oacc[ii] = mfma16(a, frag(PT, 136, ii * 16, k0, lane), oacc[ii]);
  }
  const u16* oin = p.sec + 8 * SECE;
  u16* gd = p.sec + 10 * SECE;
  const int i0 = wid * 16 + (lane >> 4) * 4;
  float s1[4] = {0.f, 0.f, 0.f, 0.f}, s2[4] = {0.f, 0.f, 0.f, 0.f};
#pragma unroll
  for (int ii = 0; ii < 8; ++ii) {
    const int e = ii * 16 + (lane & 15);
#pragma unroll
    for (int r = 0; r < 4; ++r) {
      const float xi = exp2f(l2g * (float)(i0 + r + 1));
      const float o = bf2f(oin[(size_t)(r0 + i0 + r) * 512 + h * 128 + e]) + xi * oacc[ii][r];
      oacc[ii][r] = o;
      s1[r] += o; s2[r] += o * o;
    }
  }
#pragma unroll
  for (int r = 0; r < 4; ++r) {
#pragma unroll
    for (int o = 1; o < 16; o <<= 1) { s1[r] += __shfl_xor(s1[r], o); s2[r] += __shfl_xor(s2[r], o); }
  }
#pragma unroll
  for (int ii = 0; ii < 8; ++ii) {
    const int e = ii * 16 + (lane & 15);
    const float gg = p.ret_gn_g[l * 512 + h * 128 + e];
#pragma unroll
    for (int r = 0; r < 4; ++r) {
      const float mu = s1[r] * (1.f / 128.f);
      const float var = fmaxf(s2[r] * (1.f / 128.f) - mu * mu, 0.f);
      u16* gp = gd + (size_t)(r0 + i0 + r) * 512 + h * 128 + e;
      const float g = bf2f(*gp);
      *gp = f2bf(siluf(g) * (oacc[ii][r] - mu) * rsqrtf(var + 1e-6f) * gg);
    }
  }
  __syncthreads();
}

DEVI void pool_unit(const P& p, int l, int u, unsigned char* smem) {
  const int t = tid_l(), lane = t & 63, wid = t >> 6;
  const int g = u & 3, rt = u >> 2;
  const int r0 = rt * 64, spos0 = r0 & (SEQ - 1);
  const int win = 2 << g;
  u16* Al = (u16*)smem;
  u16* Wl = Al + 64 * 136;
  {
    const int row = t >> 3, c0 = (t & 7) * 16;
    const u16* base = p.sec + 4 * SECE + g * 128 + c0;
    float sum[16], own[16];
#pragma unroll
    for (int c = 0; c < 16; ++c) sum[c] = 0.f;
    const int sp = spos0 + row;
    const int cnt = min(sp + 1, win);
    for (int j = 0; j < cnt; ++j) {
      const u16* src = base + (size_t)(r0 + row - j) * 512;
      float f[16];
      unpack8(*(const u4*)src, f); unpack8(*(const u4*)(src + 8), f + 8);
#pragma unroll
      for (int c = 0; c < 16; ++c) { sum[c] += f[c]; if (j == 0) own[c] = f[c]; }
    }
    const float ic = 1.f / (float)cnt;
#pragma unroll
    for (int c = 0; c < 16; ++c) sum[c] = sum[c] * ic - own[c];
    *(u4*)(Al + row * 136 + c0) = pack8(sum); *(u4*)(Al + row * 136 + c0 + 8) = pack8(sum + 8);
    const u16* wsrc = p.PoolWT + (size_t)g * 16384;
#pragma unroll
    for (int q = 0; q < 4; ++q) {
      const int idx = t + q * 512;
      const int d = idx >> 4, cc = (idx & 15) * 8;
      *(u4*)(Wl + d * 136 + cc) = *(const u4*)(wsrc + d * 128 + cc);
    }
  }
  __syncthreads();
  const int pt = wid & 3, dh = wid >> 2;
  f32x4 acc[4];
#pragma unroll
  for (int ni = 0; ni < 4; ++ni) acc[ni] = f32x4{0.f, 0.f, 0.f, 0.f};
#pragma unroll
  for (int k0 = 0; k0 < 128; k0 += 32) {
    const bf16x8 a = frag(Al, 136, pt * 16, k0, lane);
#pragma unroll
    for (int ni = 0; ni < 4; ++ni) acc[ni] = mfma16(a, frag(Wl, 136, (dh * 4 + ni) * 16, k0, lane), acc[ni]);
  }
#pragma unroll
  for (int ni = 0; ni < 4; ++ni) {
    const int d = (dh * 4 + ni) * 16 + (lane & 15);
    const float sc = p.pool_scale[l * 512 + g * 128 + d];
#pragma unroll
    for (int r = 0; r < 4; ++r)
      p.YB[(size_t)(r0 + pt * 16 + (lane >> 4) * 4 + r) * 512 + g * 128 + d] = f2bf(acc[ni][r] * sc);
  }
  __syncthreads();
}

DEVI void sg_unit(const P& p, int l, int u, unsigned char* smem) {
  const int t = tid_l(), lane = t & 63, wid = t >> 6;
  const int g = u & 3, ch = u >> 2;
  const int r0 = ch * 128;
  u16* VT = (u16*)smem;
  u16* Ul = VT + 128 * 136;
  u16* Wl = Ul + 128 * 136;
  {
    const int row = t >> 2, q = t & 3;
    const u16* svr = p.sec + 6 * SECE + (size_t)(r0 + row) * 512;
    float s1 = 0.f, s2 = 0.f;
#pragma unroll 4
    for (int i = 0; i < 16; ++i) {
      float f[8];
      unpack8(*(const u4*)(svr + q * 128 + i * 8), f);
#pragma unroll
      for (int j = 0; j < 8; ++j) { const float gv = geluf(f[j]); s1 += gv; s2 += gv * gv; }
    }
    s1 += __shfl_xor(s1, 1); s2 += __shfl_xor(s2, 1);
    s1 += __shfl_xor(s1, 2); s2 += __shfl_xor(s2, 2);
    const float mu = s1 * (1.f / 512.f);
    const float rstd = rsqrtf(fmaxf(s2 * (1.f / 512.f) - mu * mu, 0.f) + 1e-6f);
    const int c0 = q * 32;
    const u16* sur = p.sec + 5 * SECE + (size_t)(r0 + row) * 512 + g * 128 + c0;
#pragma unroll
    for (int i = 0; i < 4; ++i) {
      float f[8], uu[8];
      unpack8(*(const u4*)(svr + g * 128 + c0 + i * 8), f);
      unpack8(*(const u4*)(sur + i * 8), uu);
#pragma unroll
      for (int j = 0; j < 8; ++j) {
        const int c = g * 128 + c0 + i * 8 + j;
        const float vv = (geluf(f[j]) - mu) * rstd * p.sg_ln_g[l * 512 + c] + p.sg_ln_b[l * 512 + c];
        VT[(c0 + i * 8 + j) * 136 + row] = f2bf(vv);
        uu[j] = geluf(uu[j]);
      }
      *(u4*)(Ul + row * 136 + c0 + i * 8) = pack8(uu);
    }
    const float* wsrc = p.sg_w + ((size_t)(l * 4 + g) * 128 + row) * 128 + c0;
#pragma unroll
    for (int i = 0; i < 4; ++i) {
      const float4 a = *(const float4*)(wsrc + i * 8), bq = *(const float4*)(wsrc + i * 8 + 4);
      float f[8] = {a.x, a.y, a.z, a.w, bq.x, bq.y, bq.z, bq.w};
#pragma unroll
      for (int j = 0; j < 8; ++j) f[j] = (c0 + i * 8 + j <= row) ? f[j] : 0.f;
      *(u4*)(Wl + row * 136 + c0 + i * 8) = pack8(f);
    }
  }
  __syncthreads();
  f32x4 acc[8];
#pragma unroll
  for (int ii = 0; ii < 8; ++ii) acc[ii] = f32x4{0.f, 0.f, 0.f, 0.f};
#pragma unroll
  for (int k0 = 0; k0 < 128; k0 += 32) {
    if (k0 <= wid * 16 + 15) {
      const bf16x8 a = frag(Wl, 136, wid * 16, k0, lane);
#pragma unroll
      for (int ii = 0; ii < 8; ++ii) acc[ii] = mfma16(a, frag(VT, 136, ii * 16, k0, lane), acc[ii]);
    }
  }
  u16* dst = p.sec + 5 * SECE;
  const int t0 = wid * 16 + (lane >> 4) * 4;
#pragma unroll
  for (int r = 0; r < 4; ++r) {
    const float bias = p.sg_b[(l * 4 + g) * 128 + t0 + r];
#pragma unroll
    for (int ii = 0; ii < 8; ++ii) {
      const int c = ii * 16 + (lane & 15);
      dst[(size_t)(r0 + t0 + r) * 512 + g * 128 + c] = f2bf(bf2f(Ul[(t0 + r) * 136 + c]) * (acc[ii][r] + bias));
    }
  }
  __syncthreads();
}

DEVI void final_norm_phase(const P& p) {
  const int t = tid_l(), lane = t & 63, wid = t >> 6;
  for (int u = blockIdx.x; u < 2048; u += gridDim.x) {
    const int row = u * 8 + wid;
    float* xr = p.out + (size_t)row * 1024;
    float4 xv[4];
    float ss = 0.f;
#pragma unroll
    for (int i = 0; i < 4; ++i) {
      xv[i] = *(const float4*)(xr + i * 256 + lane * 4);
      ss += xv[i].x * xv[i].x + xv[i].y * xv[i].y + xv[i].z * xv[i].z + xv[i].w * xv[i].w;
    }
    ss = wave_sum(ss);
    const float rstd = rsqrtf(ss * (1.f / 1024.f) + 1e-6f);
#pragma unroll
    for (int i = 0; i < 4; ++i) {
      const float4 g = *(const float4*)(p.final_g + i * 256 + lane * 4);
      float4 o;
      o.x = xv[i].x * rstd * g.x; o.y = xv[i].y * rstd * g.y; o.z = xv[i].z * rstd * g.z; o.w = xv[i].w * rstd * g.w;
      *(float4*)(xr + i * 256 + lane * 4) = o;
    }
  }
}


#define XB_TMO      128
#define XB_XCNT(j)  (256  + 64 * (j))
#define XB_XSUB(j)  (1280 + 64 * (j))
#define XB_XGEN(j)  (2304 + 64 * (j))
#define XB_TOP      3328
#define XB_TOPGEN   3392
#define XCD_BAR_WORDS 3456
#define XB_SPIN_CAP (1u << 20)
#define XLAS __attribute__((address_space(3)))
DEVI unsigned xb_ld(unsigned* p) { return __hip_atomic_load(p, __ATOMIC_RELAXED, __HIP_MEMORY_SCOPE_AGENT); }
DEVI unsigned xb_add(unsigned* p, unsigned v) { return __hip_atomic_fetch_add(p, v, __ATOMIC_RELAXED, __HIP_MEMORY_SCOPE_AGENT); }
DEVI unsigned xb_xcc_id() { return (unsigned)__builtin_amdgcn_s_getreg((3 << 11) | 20) & 0xFu; }
#define XB_SPIN(cond, bar) do { unsigned _sp = 0; while (cond) { __builtin_amdgcn_s_sleep(1); \
    if ((++_sp & 255u) == 0u) { if (xb_ld(&(bar)[XB_TMO])) break; if (_sp > XB_SPIN_CAP) { atomicAdd(&(bar)[XB_TMO], 1u); break; } } } } while (0)
struct XcdBarrier { unsigned* bar; unsigned x; volatile XLAS unsigned* st; };
DEVI XcdBarrier xcd_barrier_post(unsigned* bar, volatile XLAS unsigned* st) {
  XcdBarrier b; b.bar = bar; b.x = xb_xcc_id(); b.st = st;
  if (threadIdx.x == 0) (void)xb_add(&bar[XB_XCNT(b.x)], 1u);
  return b;
}
DEVI void xcd_barrier_complete(unsigned* bar, unsigned x, unsigned& nloc, unsigned& nx) {
  const unsigned G = gridDim.x * gridDim.y * gridDim.z;
  unsigned sum, cnt, mine, sp = 0u;
  for (;;) {
    sum = 0u; cnt = 0u; mine = 0u;
#pragma unroll
    for (unsigned j = 0; j < 16; ++j) { const unsigned c = xb_ld(&bar[XB_XCNT(j)]); sum += c; cnt += (c > 0u) ? 1u : 0u; mine = (j == x) ? c : mine; }
    if (sum == G) break;
    __builtin_amdgcn_s_sleep(1);
    if ((++sp & 255u) == 0u) { if (xb_ld(&bar[XB_TMO])) break; if (sp > XB_SPIN_CAP) { atomicAdd(&bar[XB_TMO], 1u); break; } }
  }
  nloc = mine > 0u ? mine : 1u; nx = cnt > 0u ? cnt : 1u;
}
DEVI void xcd_barrier(const XcdBarrier& b) {
  asm volatile("s_waitcnt vmcnt(0)" ::: "memory");
  __syncthreads();
  if (threadIdx.x == 0) {
    unsigned* bar = b.bar;
    __builtin_amdgcn_s_waitcnt(0);
    unsigned nloc = b.st[0], nx = b.st[1];
    if (nloc == 0u) { xcd_barrier_complete(bar, b.x, nloc, nx); b.st[0] = nloc; b.st[1] = nx; }
    const unsigned old = xb_add(&bar[XB_XSUB(b.x)], 1u);
    const unsigned gen = old / nloc;
    if (old + 1u == (gen + 1u) * nloc) {
      __builtin_amdgcn_fence(__ATOMIC_RELEASE, "agent");
      asm volatile("s_waitcnt vmcnt(0)" ::: "memory");
      const unsigned og = xb_add(&bar[XB_TOP], 1u);
      const unsigned tg = og / nx;
      if (og + 1u == (tg + 1u) * nx) xb_add(&bar[XB_TOPGEN], 1u);
      else XB_SPIN(xb_ld(&bar[XB_TOPGEN]) == tg, bar);
      __builtin_amdgcn_fence(__ATOMIC_ACQUIRE, "agent");
      xb_add(&bar[XB_XGEN(b.x)], 1u);
      asm volatile("s_waitcnt vmcnt(0)" ::: "memory");
    } else {
      XB_SPIN(xb_ld(&bar[XB_XGEN(b.x)]) == gen, bar);
      __builtin_amdgcn_fence(__ATOMIC_ACQUIRE, "agent");
      asm volatile("s_waitcnt vmcnt(0)" ::: "memory");
    }
  }
  __syncthreads();
}

#ifndef PHMASK
#define PHMASK 0xffffffffu
#endif
#define EN(x) (((PHMASK) >> (x)) & 1u)
typedef const __attribute__((address_space(4))) P* KP;
DEVI P load_params(KP vp) {
  const __attribute__((address_space(4))) P& v = *vp;
  P q;
  q.x = v.x; q.c = v.c; q.pos = v.pos; q.norm1_g = v.norm1_g; q.norm2_g = v.norm2_g; q.ada_w = v.ada_w; q.ada_b = v.ada_b;
  q.w_in = v.w_in; q.dn_conv_w = v.dn_conv_w; q.dn_a_log = v.dn_a_log; q.dn_dt_bias = v.dn_dt_bias; q.dn_norm_g = v.dn_norm_g;
  q.pool_w = v.pool_w; q.pool_scale = v.pool_scale; q.sg_ln_g = v.sg_ln_g; q.sg_ln_b = v.sg_ln_b; q.sg_w = v.sg_w; q.sg_b = v.sg_b;
  q.ret_gn_g = v.ret_gn_g; q.w_br0 = v.w_br0; q.w_br1 = v.w_br1; q.w_br2 = v.w_br2; q.w_br3 = v.w_br3;
  q.w_out = v.w_out; q.mlp_w1 = v.mlp_w1; q.mlp_w2 = v.mlp_w2; q.final_g = v.final_g; q.out = v.out;
  q.WinT = v.WinT; q.WbrT = v.WbrT; q.WoutT = v.WoutT; q.W1T = v.W1T; q.W2T = v.W2T; q.PoolWT = v.PoolWT; q.h = v.h; q.sec = v.sec;
  q.TQ = v.TQ; q.YB = v.YB; q.halo = v.halo; q.QKF = v.QKF; q.modp = v.modp; q.beta = v.beta; q.glog = v.glog; q.EG = v.EG; q.ropecs = v.ropecs; q.prog = v.prog; q.rowss = v.rowss; q.xbar = v.xbar;
  q.phase_lo = 0; q.phase_hi = 0;
  return q;
}
#define LP() KP k2_ = kp; asm volatile("" : "+s"(k2_)); const P p = load_params(k2_)
DEVI void run_phase(int ph, unsigned char* smem) {
  KP kp = (KP)__builtin_amdgcn_kernarg_segment_ptr();
  int bid = blockIdx.x; asm volatile("" : "+s"(bid));
  const int nb = gridDim.x;
  if (ph == 0) {
    for (int u = bid; u < 96 + 2048 + NWCONV; u += nb) {
      if (u < 96) { if (EN(0)) { LP(); mod_unit(p, u, smem); } }
      else if (u < 96 + 2048) { if (EN(1)) { LP(); rope_unit(p, u - 96); } }
      else { if (EN(2)) { LP(); wconv_unit(p, 0, u - 96 - 2048, smem); } }
    }
    return;
  }
  if (ph == NPHASE - 1) { if (EN(15)) { LP(); final_norm_phase(p); } return; }
  const int l = (ph - 1) / 10, s = (ph - 1) % 10;
  switch (s) {
    case 0:
      if (l == 1 && EN(2)) for (int u = bid; u < NWCONV; u += nb) { LP(); wconv_unit(p, 1, u, smem); }
      __syncthreads();
      if (EN(3)) { LP(); norm_phase(p, l, 0, smem); }
      break;
    case 1:
      if (EN(3)) for (int u = bid; u < 64; u += nb) { LP(); bias2_unit(p, l, u); }
      if (EN(4)) { LP(); proj_phase(p, smem); }
      break;
    case 2:
      if (bid == 0 && threadIdx.x < 17) { LP(); p.prog[threadIdx.x * 16] = 0u; }
      for (int u = bid; u < 1024; u += nb) { if (EN(5)) { LP(); dn_prep_unit(p, l, u, smem); } }
      break;
    case 3:
      if (bid < 16) { if (EN(9)) { LP(); dn_chain(p, l, bid & 7, bid >> 3, smem); } }
      else if (bid < 24) { if (EN(9)) { LP(); dn_chain_helper(p, bid - 16, smem); } }
      else {
        const int nw = nb - 24, wb = bid - 24;
        for (int u = wb; u < 512 + 512 + 1024; u += nw) {
          if (u < 512) { if (EN(6)) { LP(); ret_d1_unit(p, u, smem); } }
          else if (u < 1024) { if (EN(7)) { LP(); sg_unit(p, l, u - 512, smem); } }
          else { if (EN(8)) { LP(); pool_unit(p, l, u - 1024, smem); } }
        }
        {
          LP();
          unsigned* cnt = p.prog + 16 * 16;
          asm volatile("s_waitcnt vmcnt(0)" ::: "memory");
          __syncthreads();
          if (threadIdx.x == 0) {
            __builtin_amdgcn_fence(__ATOMIC_RELEASE, "agent");
            asm volatile("s_waitcnt vmcnt(0)" ::: "memory");
            __hip_atomic_fetch_add(cnt, 1u, __ATOMIC_RELAXED, __HIP_MEMORY_SCOPE_AGENT);
            unsigned polls = 0;
            while (__hip_atomic_load(cnt, __ATOMIC_RELAXED, __HIP_MEMORY_SCOPE_AGENT) < (unsigned)nw && polls < 4000000u) { __builtin_amdgcn_s_sleep(2); ++polls; }
            __builtin_amdgcn_fence(__ATOMIC_ACQUIRE, "agent");
            asm volatile("s_waitcnt vmcnt(0)" ::: "memory");
          }
          __syncthreads();
        }
        if (EN(10)) {
          LP();
          const int k0 = (wb * 512) / nw, k1 = ((wb + 1) * 512) / nw;
          float racc[32];
#pragma unroll
          for (int j = 0; j < 32; ++j) racc[j] = 0.f;
          int pbh = -1;
#pragma unroll 1
          for (int k = k0; k < k1; ++k) {
            const int bh = k >> 6, n = k & 63;
            ret_d2_unit(p, l, bh >> 2, bh & 3, n, racc, bh == pbh, smem);
            pbh = bh;
          }
        }
        if (EN(9)) for (int k = wb; k < 1024; k += nw) {
          LP();
          const int n = k >> 3, bh = k & 7;
          if (threadIdx.x == 0) {
            unsigned polls = 0;
            while ((__hip_atomic_load(p.prog + (bh * 2) * 16, __ATOMIC_RELAXED, __HIP_MEMORY_SCOPE_AGENT) <= (unsigned)n ||
                    __hip_atomic_load(p.prog + (bh * 2 + 1) * 16, __ATOMIC_RELAXED, __HIP_MEMORY_SCOPE_AGENT) <= (unsigned)n) && polls < 8000000u) { __builtin_amdgcn_s_sleep(8); ++polls; }
            __builtin_amdgcn_fence(__ATOMIC_ACQUIRE, "agent");
            asm volatile("s_waitcnt vmcnt(0)" ::: "memory");
          }
          __syncthreads();
          ya_unit(p, l, (((bh >> 2) * 128 + n) << 2) | (bh & 3), smem);
        }
      }
      break;
    case 4: break;
    case 5: if (EN(12)) { LP(); merge_phase(p, smem); } break;
    case 6: if (EN(13)) { LP(); resid_gemm_phase(p, l, 0, smem); } break;
    case 7: break;
    case 8: if (EN(14)) { LP(); mlp1_phase(p, smem); } break;
    case 9: if (EN(13)) { LP(); resid_gemm_phase(p, l, 1, smem); } break;
  }
}

__global__ void __launch_bounds__(NT) mega(P p) {
  extern __shared__ __attribute__((aligned(16))) unsigned char smem[];
#ifdef PROBE_A
  unsigned long long* stamps = (unsigned long long*)(smem + 159000);
  if (threadIdx.x == 0) { stamps[0] = __builtin_amdgcn_s_memrealtime(); stamps[23] = 0; }
#endif
  volatile XLAS unsigned* xst = (volatile XLAS unsigned*)((XLAS unsigned char*)smem + (SMEM_BYTES - 16));
  if (threadIdx.x == 0) { xst[0] = 0u; xst[1] = 0u; }
  __syncthreads();
  const XcdBarrier xb = xcd_barrier_post(p.xbar, xst);
  for (int ph = p.phase_lo; ph < p.phase_hi; ++ph) {
    if (ph > 0 && ph < NPHASE - 1 && ((ph - 1) % 10 == 7 || (ph - 1) % 10 == 4)) continue;
    run_phase(ph, smem);
    if (ph + 1 < p.phase_hi) {
      if (ph == 0) cg::this_grid().sync();
      else xcd_barrier(xb);
    }
  }
#ifdef PROBE_A
  cg::this_grid().sync();
  if (blockIdx.x == 0) {
    __syncthreads();
    auto dur = [&](int code) -> unsigned long long {
      if (code == 100) return stamps[1] - stamps[0];
      if (code == 101) return stamps[23];
      if (code == 102) return stamps[NPHASE - 1] - stamps[0];
      return (stamps[1 + code + 1] - stamps[1 + code]) + (stamps[11 + code + 1] - stamps[11 + code]);
    };
    const unsigned N = (unsigned)(dur(PROBE_A) * 4096ull / 100ull);
    for (unsigned i = threadIdx.x; i < N && i < 16384u * 1024u; i += NT) p.out[i] += 0.0078125f;
  }
#endif
}

extern "C" void kernel_launch(void* const* d_in, const int* in_sizes, int n_in, void* d_out, int out_size, void* d_ws,
                              size_t ws_size, hipStream_t stream) {
  static int grid = 0;
  constexpr size_t MiB = 1024 * 1024;
  constexpr size_t WS_NEED = 304 * MiB;
  if (grid == 0) {
    if (ws_size < WS_NEED || n_in != 27) {
      fprintf(stderr, "kernel_launch: ws_size %zu < %zu or n_in %d != 27\n", ws_size, WS_NEED, n_in);
      grid = -1;
      return;
    }
    int dev = 0, cus = 0, per_cu = 0;
    hipGetDevice(&dev);
    hipDeviceGetAttribute(&cus, hipDeviceAttributeMultiprocessorCount, dev);
    hipFuncSetAttribute((const void*)mega, hipFuncAttributeMaxDynamicSharedMemorySize, SMEM_BYTES);
    hipOccupancyMaxActiveBlocksPerMultiprocessor(&per_cu, (const void*)mega, NT, SMEM_BYTES);
    if (per_cu < 1) per_cu = 1;
    grid = cus * per_cu;
    (void)hipGetLastError();
  }
  if (grid < 0) return;
  P p{};
  p.x = (const float*)d_in[0]; p.c = (const float*)d_in[1]; p.pos = (const int*)d_in[2];
  p.norm1_g = (const float*)d_in[3]; p.norm2_g = (const float*)d_in[4];
  p.ada_w = (const float*)d_in[5]; p.ada_b = (const float*)d_in[6]; p.w_in = (const float*)d_in[7];
  p.dn_conv_w = (const float*)d_in[8]; p.dn_a_log = (const float*)d_in[9]; p.dn_dt_bias = (const float*)d_in[10];
  p.dn_norm_g = (const float*)d_in[11]; p.pool_w = (const float*)d_in[12]; p.pool_scale = (const float*)d_in[13];
  p.sg_ln_g = (const float*)d_in[14]; p.sg_ln_b = (const float*)d_in[15]; p.sg_w = (const float*)d_in[16];
  p.sg_b = (const float*)d_in[17]; p.ret_gn_g = (const float*)d_in[18];
  p.w_br0 = (const float*)d_in[19]; p.w_br1 = (const float*)d_in[20]; p.w_br2 = (const float*)d_in[21];
  p.w_br3 = (const float*)d_in[22];
  p.w_out = (const float*)d_in[23]; p.mlp_w1 = (const float*)d_in[24]; p.mlp_w2 = (const float*)d_in[25];
  p.final_g = (const float*)d_in[26];
  p.out = (float*)d_out;
  unsigned char* ws = (unsigned char*)d_ws;
  size_t o = 0;
  p.WinT = (u16*)(ws + o); o += (size_t)9728 * 1024 * 2;
  p.WbrT = (u16*)(ws + o); o += (size_t)4 * 1024 * 512 * 2;
  p.WoutT = (u16*)(ws + o); o += (size_t)1024 * 1024 * 2;
  p.W1T = (u16*)(ws + o); o += (size_t)4096 * 1024 * 2;
  p.W2T = (u16*)(ws + o); o += (size_t)4096 * 1024 * 2;
  p.PoolWT = (u16*)(ws + o); o += (size_t)4 * 128 * 128 * 2;
  o = 44 * MiB;
  p.h = (u16*)(ws + o); o += 32 * MiB;
  p.sec = (u16*)(ws + o); o += 176 * MiB;
  p.TQ = (u16*)(ws + o); o += 16 * MiB;
  p.YB = (u16*)(ws + o); o += 16 * MiB;
  p.halo = (u16*)(ws + o); o += 3 * MiB;
  p.modp = (float*)(ws + o); o += 1 * MiB;
  p.beta = (float*)(ws + o); o += 262144;
  p.glog = (float*)(ws + o); o += 262144;
  p.EG = (float*)(ws + o); o += 262144;
  p.ropecs = (float*)(ws + o); o += 8 * MiB;
  p.QKF = (u16*)(ws + o); o += (size_t)1024 * 3072 * 2;
  p.prog = (unsigned*)(ws + o); o += 4096;
  p.rowss = (float*)(ws + o); o += (size_t)16384 * 16 * 4;
  p.xbar = (unsigned*)(ws + o); o += 16384;
#if COOP
  (void)hipMemsetAsync(p.xbar, 0, 16384, stream);
  p.phase_lo = 0; p.phase_hi = NPHASE;
  void* args[] = {&p};
  hipError_t e = hipLaunchCooperativeKernel((const void*)mega, dim3(grid), dim3(NT), args, SMEM_BYTES, stream);
  if (e != hipSuccess) fprintf(stderr, "cooperative launch failed: %s (grid %d)\n", hipGetErrorString(e), grid);
#else
  for (int ph = 0; ph < NPHASE; ++ph) {
    p.phase_lo = ph; p.phase_hi = ph + 1;
    hipLaunchKernelGGL(mega, dim3(grid), dim3(NT), SMEM_BYTES, stream, p);
  }
#endif
}
```

```cpp
#include <hip/hip_runtime.h>
#include <hip/hip_bf16.h>
#include <hip/hip_cooperative_groups.h>
#include <cstdio>
namespace cg = cooperative_groups;

#ifndef COOP
#define COOP 1
#endif

typedef unsigned short u16;
using bf16x8 = __attribute__((ext_vector_type(8))) short;
using f32x4 = __attribute__((ext_vector_type(4))) float;
using u4 = __attribute__((ext_vector_type(4))) unsigned;
using u2 = __attribute__((ext_vector_type(2))) unsigned;
#define DEVI __device__ __forceinline__

constexpr int NT = 512;
constexpr int SEQ = 8192;
constexpr size_t SECE = (size_t)16384 * 512;
constexpr int SMEM_BYTES = 156 * 1024;
constexpr int NPHASE = 22;

struct P {
  const float *x, *c;
  const int* pos;
  const float *norm1_g, *norm2_g, *ada_w, *ada_b, *w_in, *dn_conv_w, *dn_a_log, *dn_dt_bias, *dn_norm_g, *pool_w,
      *pool_scale, *sg_ln_g, *sg_ln_b, *sg_w, *sg_b, *ret_gn_g, *w_br0, *w_br1, *w_br2, *w_br3, *w_out, *mlp_w1, *mlp_w2, *final_g;
  float* out;
  u16 *WinT, *WbrT, *WoutT, *W1T, *W2T, *PoolWT, *h, *sec, *TQ, *YB, *halo, *QKF;
  float *modp, *beta, *glog, *EG, *ropecs;
  unsigned* prog;
  float* rowss;
  unsigned* xbar;
  int phase_lo, phase_hi;
};

DEVI int tid_l() { int t = threadIdx.x; asm volatile("" : "+v"(t)); return t; }
template <class T> DEVI void lnd(T*& q) { asm volatile("" : "+s"(q)); }
typedef float f32x2_t __attribute__((ext_vector_type(2)));
typedef __bf16 bf16x2_t __attribute__((ext_vector_type(2)));
DEVI unsigned pack2(float a, float b) { const f32x2_t v = {a, b}; const bf16x2_t r = __builtin_convertvector(v, bf16x2_t); return __builtin_bit_cast(unsigned, r); }
DEVI u16 f2bf(float f) { return (u16)(pack2(f, f) & 0xffffu); }
DEVI float bf2f(u16 h) { return __uint_as_float(((unsigned)h) << 16); }
DEVI float lo2f(unsigned u) { return __uint_as_float(u << 16); }
DEVI float hi2f(unsigned u) { return __uint_as_float(u & 0xffff0000u); }
DEVI void unpack8(u4 v, float* f) {
  f[0] = lo2f(v.x); f[1] = hi2f(v.x); f[2] = lo2f(v.y); f[3] = hi2f(v.y);
  f[4] = lo2f(v.z); f[5] = hi2f(v.z); f[6] = lo2f(v.w); f[7] = hi2f(v.w);
}
DEVI u4 pack8(const float* f) {
  u4 v; v.x = pack2(f[0], f[1]); v.y = pack2(f[2], f[3]); v.z = pack2(f[4], f[5]); v.w = pack2(f[6], f[7]);
  return v;
}
DEVI float wave_sum(float v) {
#pragma unroll
  for (int o = 32; o > 0; o >>= 1) v += __shfl_xor(v, o);
  return v;
}
DEVI float siluf(float x) { return x * __builtin_amdgcn_rcpf(1.f + __expf(-x)); }
DEVI float sigmf(float x) { return __builtin_amdgcn_rcpf(1.f + __expf(-x)); }
DEVI float geluf(float v) {
  const float av = fabsf(v), t = __builtin_amdgcn_rcpf(av * 0.2316418882f + 1.0f);
  float q = t * 0.5307027145f + (-0.7265760135f); q = q * t + 0.7107068705f; q = q * t + (-0.142248368f); q = q * t + 0.127414796f; q = q * t;
  const float e = __builtin_amdgcn_exp2f((v * v) * (-0.72134752044f));
  const float m = v * (q * e);
  return v < 0.f ? m : v - m;
}
DEVI f32x4 mfma16(bf16x8 a, bf16x8 b, f32x4 c) { return __builtin_amdgcn_mfma_f32_16x16x32_bf16(a, b, c, 0, 0, 0); }
DEVI bf16x8 frag(const u16* base, int ld, int r0, int k0, int lane) {
  return *(const bf16x8*)(base + (r0 + (lane & 15)) * ld + k0 + 8 * (lane >> 4));
}
DEVI u2 pack4v(f32x4 v) { u2 r; r.x = pack2(v[0], v[1]); r.y = pack2(v[2], v[3]); return r; }

DEVI float modval(const P& p, int l, int b, int j) { return p.modp[(size_t)(l * 2 + b) * 6144 + j]; }

DEVI void gemm_kloop(const u16* __restrict__ A, int lda, const u16* __restrict__ Bt, int ldb, int K,
                     f32x4 (&acc)[4][4], u16* sm) {
  const int t = tid_l(), lane = t & 63, wid = t >> 6, wr = wid >> 1, wc = wid & 1;
  u16* As = sm;
  u16* Bs = sm + 2 * 256 * 64;
  const int lrow = t >> 3, lch = t & 7;
  const u16* ag = A + (size_t)lrow * lda + lch * 8;
  const u16* bg = Bt + (size_t)lrow * ldb + lch * 8;
  const int soff = lrow * 64 + ((lch ^ (lrow & 7)) * 8);
  u4 ra[4], rb[2];
#pragma unroll
  for (int i = 0; i < 4; ++i) ra[i] = *(const u4*)(ag + (size_t)i * 64 * lda);
#pragma unroll
  for (int i = 0; i < 2; ++i) rb[i] = *(const u4*)(bg + (size_t)i * 64 * ldb);
  __syncthreads();
#pragma unroll
  for (int i = 0; i < 4; ++i) *(u4*)(As + i * 64 * 64 + soff) = ra[i];
#pragma unroll
  for (int i = 0; i < 2; ++i) *(u4*)(Bs + i * 64 * 64 + soff) = rb[i];
  __syncthreads();
  const int nt = K >> 6;
  const int arow = (wr * 64 + (lane & 15)) * 64, brow = (wc * 64 + (lane & 15)) * 64;
  for (int kt = 0; kt < nt; ++kt) {
    const int cur = kt & 1;
    if (kt + 1 < nt) {
      const int ko = (kt + 1) * 64;
#pragma unroll
      for (int i = 0; i < 4; ++i) ra[i] = *(const u4*)(ag + (size_t)i * 64 * lda + ko);
#pragma unroll
      for (int i = 0; i < 2; ++i) rb[i] = *(const u4*)(bg + (size_t)i * 64 * ldb + ko);
    }
    const u16* Ac = As + cur * 256 * 64 + arow;
    const u16* Bc = Bs + cur * 128 * 64 + brow;
#pragma unroll
    for (int kk = 0; kk < 2; ++kk) {
      const int ch = (((kk * 4 + (lane >> 4)) ^ (lane & 7)) * 8);
      bf16x8 af[4], bfr[4];
#pragma unroll
      for (int mi = 0; mi < 4; ++mi) af[mi] = *(const bf16x8*)(Ac + mi * 16 * 64 + ch);
#pragma unroll
      for (int ni = 0; ni < 4; ++ni) bfr[ni] = *(const bf16x8*)(Bc + ni * 16 * 64 + ch);
#pragma unroll
      for (int mi = 0; mi < 4; ++mi)
#pragma unroll
        for (int ni = 0; ni < 4; ++ni) acc[mi][ni] = mfma16(af[mi], bfr[ni], acc[mi][ni]);
    }
    if (kt + 1 < nt) {
      const int nb = cur ^ 1;
#pragma unroll
      for (int i = 0; i < 4; ++i) *(u4*)(As + nb * 256 * 64 + i * 64 * 64 + soff) = ra[i];
#pragma unroll
      for (int i = 0; i < 2; ++i) *(u4*)(Bs + nb * 128 * 64 + i * 64 * 64 + soff) = rb[i];
    }
    __syncthreads();
  }
}
DEVI void zero_acc(f32x4 (&acc)[4][4]) {
#pragma unroll
  for (int i = 0; i < 4; ++i)
#pragma unroll
    for (int j = 0; j < 4; ++j) acc[i][j] = f32x4{0.f, 0.f, 0.f, 0.f};
}
template <class F>
DEVI void epi_foreach(f32x4 (&acc)[4][4], int row0, int col0, F f) {
  const int t = tid_l(), lane = t & 63, wid = t >> 6, wr = wid >> 1, wc = wid & 1;
#pragma unroll
  for (int mi = 0; mi < 4; ++mi)
#pragma unroll
    for (int ni = 0; ni < 4; ++ni)
#pragma unroll
      for (int r = 0; r < 4; ++r)
        f(row0 + wr * 64 + mi * 16 + (lane >> 4) * 4 + r, col0 + wc * 64 + ni * 16 + (lane & 15), acc[mi][ni][r]);
}

DEVI void mod_unit(const P& p, int u, unsigned char* smem) {
  const int t = tid_l();
  const int l = u / 48, jb = u % 48;
  float* cond = (float*)smem;
  float* red = cond + 2048;
  for (int i = t; i < 2048; i += NT) cond[i] = siluf(p.c[i]);
  __syncthreads();
  const int kq = t >> 7, jj = t & 127;
  const float* w = p.ada_w + ((size_t)l * 1024 + kq * 256) * 6144 + jb * 128 + jj;
  float a0 = 0.f, a1 = 0.f;
#pragma unroll 16
  for (int k = 0; k < 256; ++k) {
    const float wv = w[(size_t)k * 6144];
    a0 += cond[kq * 256 + k] * wv;
    a1 += cond[1024 + kq * 256 + k] * wv;
  }
  red[(kq * 2 + 0) * 128 + jj] = a0;
  red[(kq * 2 + 1) * 128 + jj] = a1;
  __syncthreads();
  if (t < 256) {
    const int bb = t >> 7;
    const int j = jb * 128 + jj;
    float sacc = p.ada_b[l * 6144 + j];
#pragma unroll
    for (int q = 0; q < 4; ++q) sacc += red[(q * 2 + bb) * 128 + jj];
    p.modp[(size_t)(l * 2 + bb) * 6144 + j] = sacc;
  }
  __syncthreads();
}
DEVI void rope_unit(const P& p, int u) {
  const int idx = u * 512 + tid_l();
  const int tok = idx >> 6, j = idx & 63;
  const float inv = exp2f(-(float)j * (13.287712379549449f / 64.f));
  const float ang = (float)p.pos[tok] * inv;
  double rev = (double)ang * 0.15915494309189535;
  rev -= rint(rev);
  const float r = (float)(rev * 6.283185307179586);
  p.ropecs[(size_t)idx * 2] = __cosf(r);
  p.ropecs[(size_t)idx * 2 + 1] = __sinf(r);
}
template <int NTL>
DEVI void conv_tiles(const float* __restrict__ src, int ld, int K, int kt, int nt0, int col0, u16* __restrict__ dst, unsigned char* smem, int dkt = -1) {
  if (dkt < 0) dkt = kt;
  float* ls = (float*)smem;
  const int t = tid_l();
  float4 v[NTL][2];
#pragma unroll
  for (int q = 0; q < NTL; ++q)
#pragma unroll
    for (int ps = 0; ps < 2; ++ps) {
      const int kk = ps * 32 + (t >> 4), n4 = (t & 15) * 4;
      v[q][ps] = *(const float4*)(src + (size_t)(kt * 64 + kk) * ld + col0 + q * 64 + n4);
    }
#pragma unroll
  for (int q = 0; q < NTL; ++q)
#pragma unroll
    for (int ps = 0; ps < 2; ++ps) {
      const int kk = ps * 32 + (t >> 4), n4 = (t & 15) * 4;
      float* d = ls + q * 64 * 65 + kk * 65 + n4;
      d[0] = v[q][ps].x; d[1] = v[q][ps].y; d[2] = v[q][ps].z; d[3] = v[q][ps].w;
    }
  __syncthreads();
  const int n = t >> 3, kc = (t & 7) * 8;
#pragma unroll
  for (int q = 0; q < NTL; ++q) {
    float f[8];
#pragma unroll
    for (int j = 0; j < 8; ++j) f[j] = ls[q * 64 * 65 + (kc + j) * 65 + n];
    *(u4*)(dst + (size_t)((nt0 + q) * 64 + n) * K + dkt * 64 + kc) = pack8(f);
  }
  __syncthreads();
}
constexpr int NWCONV = 608 + 128 + 64 + 256 + 256 + 8;
DEVI void wconv_unit(const P& p, int l, int w, unsigned char* smem) {
  if (w < 608) {
    const int kt = w & 15, ng = w >> 4, n0 = ng * 256;
    conv_tiles<4>(p.w_in + (size_t)l * 1024 * 9736, 9736, 512, kt, ng * 4, n0 + (n0 >= 2048 ? 8 : 0), p.WinT + (size_t)(kt >> 3) * 9728 * 512, smem, kt & 7);
    return;
  }
  w -= 608;
  if (w < 128) {
    const int b = w >> 5, r = w & 31, kt = r & 7, ng = r >> 3;
    const float* b0 = p.w_br0; const float* b1 = p.w_br1; const float* b2 = p.w_br2; const float* b3 = p.w_br3;
    asm volatile("" : "+s"(b0)); asm volatile("" : "+s"(b1)); asm volatile("" : "+s"(b2)); asm volatile("" : "+s"(b3));
    conv_tiles<4>((b == 0 ? b0 : b == 1 ? b1 : b == 2 ? b2 : b3) + (size_t)l * 512 * 1024, 1024, 512, kt, ng * 4, ng * 256, p.WbrT + (size_t)b * 1024 * 512, smem);
    return;
  }
  w -= 128;
  if (w < 64) {
    conv_tiles<4>(p.w_out + (size_t)l * 1024 * 1024, 1024, 1024, w & 15, (w >> 4) * 4, (w >> 4) * 256, p.WoutT, smem);
    return;
  }
  w -= 64;
  if (w < 256) {
    conv_tiles<4>(p.mlp_w1 + (size_t)l * 1024 * 4096, 4096, 1024, w & 15, (w >> 4) * 4, (w >> 4) * 256, p.W1T, smem);
    return;
  }
  w -= 256;
  if (w < 256) {
    conv_tiles<4>(p.mlp_w2 + (size_t)l * 4096 * 1024, 1024, 4096, w & 63, (w >> 6) * 4, (w >> 6) * 256, p.W2T, smem);
    return;
  }
  w -= 256;
  {
    const int g = w >> 1, kt = w & 1;
    conv_tiles<2>(p.pool_w + (size_t)(l * 4 + g) * 16384, 128, 128, kt, 0, 0, p.PoolWT + (size_t)g * 16384, smem);
  }
}

DEVI void norm_phase(const P& p, int l, int which, unsigned char* smem) {
  const int t = tid_l(), lane = t & 63, wid = t >> 6;
  float* ssh = (float*)smem;
  float* ssc = ssh + 2048;
  float* w8 = ssc + 2048;
  const float* gsrc = (which == 0 ? p.norm1_g : p.norm2_g) + l * 1024;
  const int ish = which == 0 ? 0 : 3;
#pragma unroll 1
  for (int i = t; i < 2048; i += NT) {
    const int b = i >> 10, c = i & 1023;
    ssh[i] = modval(p, l, b, ish * 1024 + c);
    ssc[i] = gsrc[c] * (1.f + modval(p, l, b, (ish + 1) * 1024 + c));
  }
  if (which == 0) {
#pragma unroll 1
    for (int i = t; i < 2048; i += NT) {
      const int k = i >> 1, hf = i & 1;
      *(float4*)(w8 + k * 8 + hf * 4) = *(const float4*)(p.w_in + ((size_t)l * 1024 + k) * 9736 + 2048 + hf * 4);
    }
  }
  __syncthreads();
  const float* xs = (l == 0 && which == 0) ? p.x : p.out;
  float4 xv[4];
  {
    const int u0 = blockIdx.x;
    if (u0 < 2048) {
      const float* xr = xs + (size_t)(u0 * 8 + wid) * 1024;
#pragma unroll
      for (int i = 0; i < 4; ++i) xv[i] = *(const float4*)(xr + i * 256 + lane * 4);
    }
  }
#pragma unroll 1
  for (int u = blockIdx.x; u < 2048; u += gridDim.x) {
    const int row = u * 8 + wid, b = row >> 13;
    float4 xn[4];
    {
      const int un = u + gridDim.x;
      const float* xr = xs + (size_t)((un < 2048 ? un : u) * 8 + wid) * 1024;
#pragma unroll
      for (int i = 0; i < 4; ++i) xn[i] = *(const float4*)(xr + i * 256 + lane * 4);
    }
    float ss = 0.f;
#pragma unroll
    for (int i = 0; i < 4; ++i) {
      ss += xv[i].x * xv[i].x + xv[i].y * xv[i].y + xv[i].z * xv[i].z + xv[i].w * xv[i].w;
    }
    ss = wave_sum(ss);
    const float rstd = rsqrtf(ss * (1.f / 1024.f) + 1e-6f);
    float a8[8];
#pragma unroll
    for (int j = 0; j < 8; ++j) a8[j] = 0.f;
#pragma unroll
    for (int i = 0; i < 4; ++i) {
      const int c = i * 256 + lane * 4;
      const float4 sc = *(const float4*)(ssc + b * 1024 + c);
      const float4 sh = *(const float4*)(ssh + b * 1024 + c);
      float hv[4];
      hv[0] = xv[i].x * rstd * sc.x + sh.x;
      hv[1] = xv[i].y * rstd * sc.y + sh.y;
      hv[2] = xv[i].z * rstd * sc.z + sh.z;
      hv[3] = xv[i].w * rstd * sc.w + sh.w;
      u2 o; o.x = pack2(hv[0], hv[1]); o.y = pack2(hv[2], hv[3]);
      *(u2*)(p.h + (size_t)(c >> 9) * 8388608 + (size_t)row * 512 + (c & 511)) = o;
      if (which == 0) {
#pragma unroll
        for (int e = 0; e < 4; ++e) {
          const float4 wa = *(const float4*)(w8 + (c + e) * 8);
          const float4 wb = *(const float4*)(w8 + (c + e) * 8 + 4);
          a8[0] += hv[e] * wa.x; a8[1] += hv[e] * wa.y; a8[2] += hv[e] * wa.z; a8[3] += hv[e] * wa.w;
          a8[4] += hv[e] * wb.x; a8[5] += hv[e] * wb.y; a8[6] += hv[e] * wb.z; a8[7] += hv[e] * wb.w;
        }
      }
    }
    if (which == 0) {
#pragma unroll
      for (int j = 0; j < 8; ++j) a8[j] = wave_sum(a8[j]);
      float mine = 0.f;
#pragma unroll
      for (int j = 0; j < 8; ++j) mine = (lane == j) ? a8[j] : mine;
      if (lane < 4) {
        p.beta[(size_t)row * 4 + lane] = sigmf(mine);
      } else if (lane < 8) {
        const int hh = lane - 4;
        const float xx = mine + p.dn_dt_bias[l * 4 + hh];
        const float sp = xx > 20.f ? xx : log1pf(expf(xx));
        p.glog[(size_t)row * 4 + hh] = -expf(p.dn_a_log[l * 4 + hh]) * sp;
      }
    }
#pragma unroll
    for (int i = 0; i < 4; ++i) xv[i] = xn[i];
  }
}

DEVI int gate_sec(int gs) { return gs < 3 ? gs : (gs == 3 ? 4 : (gs == 4 ? 6 : gs + 2)); }


namespace pg8 {
#define PG8_LAS __attribute__((address_space(3)))
constexpr int BM = 256, BK = 64, HALF = 128, HTB = HALF * BK * 2, STAGE_BYTES = 8 * HTB, NXCD = 8, WGM = 8;
DEVI int lds_byte(int r, int c) { const int st = (r >> 4) * 2 + (c >> 5), rr = r & 15, cc = c & 31, ob = rr * 64 + cc * 2; return st * 1024 + (ob ^ (((ob >> 9) & 1) << 5)); }
DEVI void stage_rc(int b, int& R, int& C) { const int st = b / 1024, sb = b % 1024, swz = sb ^ (((sb >> 9) & 1) << 5); R = (st >> 1) * 16 + swz / 64; C = (st & 1) * 32 + (swz % 64) / 2; }
DEVI int perm32(int rho) { const int n = rho >> 4, i = rho & 15; return 8 * (i >> 2) + 4 * n + (i & 3); }
struct Unit { int pm, pn, br, keep; const u16* A; const u16* Bt; };
struct Gemm { const u16* A; const u16* Bt; int M, N, K; };
struct StaticOrder {
  int nM, nN, nwg, G, c; const u16* gA; const u16* gB;
  DEVI void init(int M, int N, int G_, int c_, const u16* A_, const u16* B_) { nM = M / BM; nN = N / BM; nwg = nM * nN; G = G_; c = c_; gA = A_; gB = B_; }
  DEVI bool next(int i, Unit& u) const {
    const long L = (long)i * G + c; if (L >= nwg) return false;
    int wgid = (int)L; { const int q = nwg / NXCD, r = nwg % NXCD, xcd = wgid % NXCD, off = wgid / NXCD; wgid = (xcd < r ? xcd * (q + 1) : r * (q + 1) + (xcd - r) * q) + off; }
    const int nig = WGM * nN, gid = wgid / nig, fm = gid * WGM, gsz = (nM - fm) < WGM ? (nM - fm) : WGM;
    u.pm = fm + ((wgid % nig) % gsz); u.pn = (wgid % nig) / gsz; u.br = 0; u.keep = 0; u.A = gA; u.Bt = gB; return true;
  }
};
DEVI unsigned cvt_pk_bf16(float lo, float hi) { return pack2(lo, hi); }

template <class Epi, class Sched>
DEVI void gemm_phase(PG8_LAS unsigned char* lds, const Gemm g, const Sched& S, const Epi& E) {
  const int tid = tid_l(), wid = __builtin_amdgcn_readfirstlane(tid >> 6), lane = tid & 63, wr = wid >> 2, wc = wid & 3, fr = lane & 15, fq = lane >> 4;
  const int K = g.K, nt = K / BK;
  unsigned voffA[2], voffB[2];
#pragma unroll
  for (int i = 0; i < 2; ++i) { int R, C; stage_rc(tid * 16 + i * 8192, R, C); const int Rb = Epi::PERM ? ((R & ~31) + perm32(R & 31)) : R;
    voffA[i] = (unsigned)(R * K + C) * 2u; voffB[i] = (unsigned)(Rb * K + C) * 2u; }
  const size_t kstep = (size_t)(BK * 2);
  const size_t hstep = (size_t)HALF * K * 2;
  const size_t tstep = 2 * hstep;
  const unsigned ldsw = (unsigned)wid * 1024u;
  const int aoff = lds_byte(wr * 64 + fr, fq * 8), boff = lds_byte(wc * 32 + fr, fq * 8);
#define PG8_SA(b, h) (((b) * 2 + (h)) * HTB)
#define PG8_SB(b, h) ((4 + (b) * 2 + (h)) * HTB)
#define PG8_STAGE(bufoff, gbase, voff) do { _Pragma("unroll") for (int _i = 0; _i < 2; ++_i) \
    __builtin_amdgcn_global_load_lds((const unsigned*)((const char*)(gbase) + (voff)[_i]), (PG8_LAS unsigned*)(lds + (bufoff) + ldsw + _i * 8192), 16, 0, 0); } while (0)
#define PG8_LDA(dst, b, h) do { _Pragma("unroll") for (int m = 0; m < 4; ++m) _Pragma("unroll") for (int k = 0; k < 2; ++k) dst[m][k] = *(const PG8_LAS bf16x8*)(lds + PG8_SA(b, h) + aoff + m * 2048 + k * 1024); } while (0)
#define PG8_LDB(dst, b, h) do { _Pragma("unroll") for (int n = 0; n < 2; ++n) _Pragma("unroll") for (int k = 0; k < 2; ++k) dst[n][k] = *(const PG8_LAS bf16x8*)(lds + PG8_SB(b, h) + boff + n * 2048 + k * 1024); } while (0)
#define PG8_MMA(ai, bj, At, Bt) do { __builtin_amdgcn_s_setprio(1); _Pragma("unroll") for (int m = 0; m < 4; ++m) _Pragma("unroll") for (int n = 0; n < 2; ++n) _Pragma("unroll") for (int k = 0; k < 2; ++k) \
    acc[ai][bj][m][n] = __builtin_amdgcn_mfma_f32_16x16x32_bf16(Bt[n][k], At[m][k], acc[ai][bj][m][n], 0, 0, 0); __builtin_amdgcn_s_setprio(0); } while (0)
#define PG8_WAIT_V(n) asm volatile("s_waitcnt vmcnt(" #n ")" ::: "memory")
#define PG8_WAIT_L(n) asm volatile("s_waitcnt lgkmcnt(" #n ")" ::: "memory")
#define PG8_BAR __builtin_amdgcn_s_barrier()
#define PG8_SCHED __builtin_amdgcn_sched_barrier(0)
  Unit cur, nxt; int ui = 0;
  if (!S.next(0, cur)) return;
  f32x4 acc[2][2][4][2];
#pragma unroll
  for (int a = 0; a < 2; ++a)
#pragma unroll
    for (int b = 0; b < 2; ++b)
#pragma unroll
      for (int m = 0; m < 4; ++m)
#pragma unroll
        for (int n = 0; n < 2; ++n) acc[a][b][m][n] = (f32x4){0.f, 0.f, 0.f, 0.f};
  bf16x8 At[4][2], B0[2][2], B1[2][2];
  const char* cA = (const char*)cur.A + (size_t)cur.pm * tstep; const char* cB = (const char*)cur.Bt + (size_t)cur.pn * tstep;
  PG8_STAGE(PG8_SB(0, 0), cB, voffB); PG8_STAGE(PG8_SA(0, 0), cA, voffA); PG8_STAGE(PG8_SB(0, 1), cB + hstep, voffB); PG8_STAGE(PG8_SA(0, 1), cA + hstep, voffA);
  if (wr == 1) PG8_BAR;
  PG8_WAIT_V(4); PG8_BAR;
  PG8_STAGE(PG8_SB(1, 0), cB + kstep, voffB); PG8_STAGE(PG8_SA(1, 0), cA + kstep, voffA); PG8_STAGE(PG8_SB(1, 1), cB + hstep + kstep, voffB);
  PG8_WAIT_V(6); PG8_BAR;
  for (;;) {
    const bool has_next = S.next(ui + 1, nxt);
    const char* nA = has_next ? (const char*)nxt.A + (size_t)nxt.pm * tstep : cA; const char* nB = has_next ? (const char*)nxt.Bt + (size_t)nxt.pn * tstep : cB;
    for (int t = 0; t < nt; t += 2) {
      const bool last = (t == nt - 2);
      const char* a1 = cA + (size_t)(t + 1) * kstep;
      const char* a2 = last ? nA : cA + (size_t)(t + 2) * kstep; const char* b2 = last ? nB : cB + (size_t)(t + 2) * kstep;
      const char* a3 = a2 + kstep; const char* b3 = b2 + kstep;
      PG8_LDB(B0, 0, 0); PG8_SCHED; PG8_LDA(At, 0, 0); PG8_STAGE(PG8_SA(1, 1), a1 + hstep, voffA);
      PG8_WAIT_L(8); PG8_BAR; PG8_WAIT_L(0); PG8_MMA(0, 0, At, B0); PG8_BAR; PG8_SCHED;
      PG8_LDB(B1, 0, 1); PG8_STAGE(PG8_SB(0, 0), b2, voffB);
      PG8_BAR; PG8_WAIT_L(0); PG8_MMA(0, 1, At, B1); PG8_BAR;
      PG8_LDA(At, 0, 1); PG8_STAGE(PG8_SA(0, 0), a2, voffA);
      PG8_BAR; PG8_WAIT_L(0); PG8_MMA(1, 0, At, B0); PG8_BAR; PG8_SCHED;
      PG8_STAGE(PG8_SB(0, 1), b2 + hstep, voffB);
      PG8_WAIT_V(6); PG8_BAR; PG8_MMA(1, 1, At, B1); PG8_BAR;
      PG8_LDB(B0, 1, 0); PG8_SCHED; PG8_LDA(At, 1, 0); PG8_STAGE(PG8_SA(0, 1), a2 + hstep, voffA);
      PG8_WAIT_L(8); PG8_BAR; PG8_WAIT_L(0); PG8_MMA(0, 0, At, B0); PG8_BAR; PG8_SCHED;
      PG8_LDB(B1, 1, 1); PG8_STAGE(PG8_SB(1, 0), b3, voffB);
      PG8_BAR; PG8_WAIT_L(0); PG8_MMA(0, 1, At, B1); PG8_BAR;
      PG8_LDA(At, 1, 1); PG8_STAGE(PG8_SA(1, 0), a3, voffA);
      PG8_BAR; PG8_WAIT_L(0); PG8_MMA(1, 0, At, B0); PG8_BAR; PG8_SCHED;
      PG8_STAGE(PG8_SB(1, 1), b3 + hstep, voffB);
      PG8_WAIT_V(6); PG8_BAR; PG8_MMA(1, 1, At, B1); PG8_BAR;
    }
    if (!cur.keep) E(acc, cur, wr, wc, fr, fq);
    if (!has_next) break;
    if (!cur.keep) {
#pragma unroll
      for (int a = 0; a < 2; ++a)
#pragma unroll
        for (int b = 0; b < 2; ++b)
#pragma unroll
          for (int m = 0; m < 4; ++m)
#pragma unroll
            for (int n = 0; n < 2; ++n) acc[a][b][m][n] = (f32x4){0.f, 0.f, 0.f, 0.f};
    }
    cur = nxt; cA = nA; cB = nB; ++ui;
  }
  PG8_WAIT_V(0);
  if (wr == 0) PG8_BAR;
  PG8_BAR;
#undef PG8_SA
#undef PG8_SB
#undef PG8_STAGE
#undef PG8_LDA
#undef PG8_LDB
#undef PG8_MMA
#undef PG8_WAIT_V
#undef PG8_WAIT_L
#undef PG8_BAR
#undef PG8_SCHED
}

DEVI u4 pack8acc(f32x4 v0, f32x4 v1) { u4 o; o.x = cvt_pk_bf16(v0[0], v0[1]); o.y = cvt_pk_bf16(v0[2], v0[3]); o.z = cvt_pk_bf16(v1[0], v1[1]); o.w = cvt_pk_bf16(v1[2], v1[3]); return o; }
struct EpiProj {
  static constexpr bool PERM = true;
  u16* sec; u16* halo;
  DEVI void operator()(const f32x4 (&acc)[2][2][4][2], const Unit& u, int wr, int wc, int fr, int fq) const {
    const int s = u.pn >> 1, cb = (u.pn & 1) * 256 + wc * 32 + 8 * fq;
    u16* dst = sec + (size_t)s * SECE;
#pragma unroll
    for (int ai = 0; ai < 2; ++ai)
#pragma unroll
      for (int m = 0; m < 4; ++m) {
        const int row = u.pm * 256 + ai * 128 + wr * 64 + m * 16 + fr;
        const bool hl = (s < 3) && ((row & 63) >= 61);
#pragma unroll
        for (int bj = 0; bj < 2; ++bj) {
          const u4 o = pack8acc(acc[ai][bj][m][0], acc[ai][bj][m][1]);
          *(u4*)(dst + (size_t)row * 512 + cb + bj * 128) = o;
          if (hl) *(u4*)(halo + ((size_t)(row >> 6) * 3 + ((row & 63) - 61)) * 1536 + s * 512 + cb + bj * 128) = o;
        }
      }
  }
};
struct EpiGates {
  static constexpr bool PERM = true;
  u16* sec;
  DEVI void operator()(const f32x4 (&acc)[2][2][4][2], const Unit& u, int wr, int wc, int fr, int fq) const {
    const int cb = (u.pn & 1) * 256 + wc * 32 + 8 * fq;
    u16* dst = sec + (size_t)gate_sec(u.pn >> 1) * SECE;
#pragma unroll
    for (int ai = 0; ai < 2; ++ai)
#pragma unroll
      for (int m = 0; m < 4; ++m) {
        const int row = u.pm * 256 + ai * 128 + wr * 64 + m * 16 + fr;
#pragma unroll
        for (int bj = 0; bj < 2; ++bj) {
          f32x4 v0 = acc[ai][bj][m][0], v1 = acc[ai][bj][m][1];
#pragma unroll
          for (int e = 0; e < 4; ++e) { v0[e] = __builtin_amdgcn_rcpf(1.f + __expf(-v0[e])); v1[e] = __builtin_amdgcn_rcpf(1.f + __expf(-v1[e])); }
          *(u4*)(dst + (size_t)row * 512 + cb + bj * 128) = pack8acc(v0, v1);
        }
      }
  }
};
struct EpiMlp1 {
  static constexpr bool PERM = true;
  u16* hid; const float* rowss; const float* bias2;
  DEVI void operator()(const f32x4 (&acc)[2][2][4][2], const Unit& u, int wr, int wc, int fr, int fq) const {
    const int cb = u.pn * 256 + wc * 32 + 8 * fq;
    const int b = (u.pm * 256) >> 13;
    const int lane = fq * 16 + fr;
    float rs[2];
#pragma unroll
    for (int ai = 0; ai < 2; ++ai) {
      const float* rp = rowss + (size_t)(u.pm * 256 + ai * 128 + wr * 64 + lane) * 16;
      const f32x4 p0 = *(const f32x4*)rp, p1 = *(const f32x4*)(rp + 4), p2 = *(const f32x4*)(rp + 8), p3 = *(const f32x4*)(rp + 12);
      const float ssum = (p0[0] + p0[1] + p0[2] + p0[3]) + (p1[0] + p1[1] + p1[2] + p1[3]) + (p2[0] + p2[1] + p2[2] + p2[3]) + (p3[0] + p3[1] + p3[2] + p3[3]);
      rs[ai] = rsqrtf(ssum * (1.f / 1024.f) + 1e-6f);
    }
    f32x4 bv[2][2];
#pragma unroll
    for (int bj = 0; bj < 2; ++bj)
#pragma unroll
      for (int n = 0; n < 2; ++n) bv[bj][n] = *(const f32x4*)(bias2 + (size_t)b * 4096 + cb + bj * 128 + 4 * n);
#pragma unroll
    for (int ai = 0; ai < 2; ++ai)
#pragma unroll
      for (int m = 0; m < 4; ++m) {
        const int row = u.pm * 256 + ai * 128 + wr * 64 + m * 16 + fr;
        const float r = __shfl(rs[ai], m * 16 + fr);
#pragma unroll
        for (int bj = 0; bj < 2; ++bj) {
          f32x4 v0 = acc[ai][bj][m][0] * r + bv[bj][0], v1 = acc[ai][bj][m][1] * r + bv[bj][1];
#pragma unroll
          for (int e = 0; e < 4; ++e) { const float a = fmaxf(v0[e], 0.f), c = fmaxf(v1[e], 0.f); v0[e] = a * a; v1[e] = c * c; }
          *(u4*)(hid + (size_t)row * 4096 + cb + bj * 128) = pack8acc(v0, v1);
        }
      }
  }
};
struct EpiResidXs {
  static constexpr bool PERM = false;
  const float* xin; float* out; const float* gate; const float* sc2g; const float* sc2s; u16* xs; float* rowss;
  DEVI void operator()(const f32x4 (&acc)[2][2][4][2], const Unit& u, int wr, int wc, int fr, int fq) const {
    const int b = (u.pm * 256) >> 13;
    const int cb = u.pn * 256 + wc * 32 + 4 * fq;
    f32x4 gv[2][2], sc[2][2];
#pragma unroll
    for (int bj = 0; bj < 2; ++bj)
#pragma unroll
      for (int n = 0; n < 2; ++n) {
        gv[bj][n] = *(const f32x4*)(gate + (size_t)b * 6144 + cb + bj * 128 + n * 16);
        sc[bj][n] = *(const f32x4*)(sc2g + cb + bj * 128 + n * 16) * (*(const f32x4*)(sc2s + (size_t)b * 6144 + cb + bj * 128 + n * 16) + 1.f);
      }
#pragma unroll
    for (int am = 0; am < 8; ++am) {
      const int ai = am >> 2, m = am & 3;
      const int row = u.pm * 256 + ai * 128 + wr * 64 + m * 16 + fr;
      const size_t ro = (size_t)row * 1024 + cb;
      f32x4 xv[2][2];
#pragma unroll
      for (int bj = 0; bj < 2; ++bj)
#pragma unroll
        for (int n = 0; n < 2; ++n) xv[bj][n] = *(const f32x4*)(xin + ro + bj * 128 + n * 16);
      float ssq = 0.f;
#pragma unroll
      for (int bj = 0; bj < 2; ++bj)
#pragma unroll
        for (int n = 0; n < 2; ++n) {
          const f32x4 v = xv[bj][n] + gv[bj][n] * acc[ai][bj][m][n];
          *(f32x4*)(out + ro + bj * 128 + n * 16) = v;
          ssq += v[0] * v[0] + v[1] * v[1] + v[2] * v[2] + v[3] * v[3];
          const f32x4 w = v * sc[bj][n];
          u2 o; o.x = cvt_pk_bf16(w[0], w[1]); o.y = cvt_pk_bf16(w[2], w[3]);
          *(u2*)(xs + ro + bj * 128 + n * 16) = o;
        }
      ssq += __shfl_xor(ssq, 16); ssq += __shfl_xor(ssq, 32);
      if (fq == 0) rowss[(size_t)row * 16 + u.pn * 4 + wc] = ssq;
    }
  }
};
struct EpiResid {
  static constexpr bool PERM = false;
  const float* xin; float* out; const float* gate;
  DEVI void operator()(const f32x4 (&acc)[2][2][4][2], const Unit& u, int wr, int wc, int fr, int fq) const {
    const int b = (u.pm * 256) >> 13;
    const int cb = u.pn * 256 + wc * 32 + 4 * fq;
    f32x4 gv[2][2];
#pragma unroll
    for (int bj = 0; bj < 2; ++bj)
#pragma unroll
      for (int n = 0; n < 2; ++n) gv[bj][n] = *(const f32x4*)(gate + (size_t)b * 6144 + cb + bj * 128 + n * 16);
#pragma unroll
    for (int am = 0; am < 4; ++am) {
      const int ai = am >> 1, m0 = (am & 1) * 2;
      f32x4 xv[2][2][2];
#pragma unroll
      for (int mm = 0; mm < 2; ++mm) {
        const size_t ro = (size_t)(u.pm * 256 + ai * 128 + wr * 64 + (m0 + mm) * 16 + fr) * 1024 + cb;
#pragma unroll
        for (int bj = 0; bj < 2; ++bj)
#pragma unroll
          for (int n = 0; n < 2; ++n) xv[mm][bj][n] = *(const f32x4*)(xin + ro + bj * 128 + n * 16);
      }
#pragma unroll
      for (int mm = 0; mm < 2; ++mm) {
        const size_t ro = (size_t)(u.pm * 256 + ai * 128 + wr * 64 + (m0 + mm) * 16 + fr) * 1024 + cb;
#pragma unroll
        for (int bj = 0; bj < 2; ++bj)
#pragma unroll
          for (int n = 0; n < 2; ++n) *(f32x4*)(out + ro + bj * 128 + n * 16) = xv[mm][bj][n] + gv[bj][n] * acc[ai][bj][m0 + mm][n];
      }
    }
  }
};

struct HalfKOrder {
  StaticOrder base; size_t aPlane, bPlane;
  DEVI bool next(int i, Unit& u) const {
    if (!base.next(i >> 1, u)) return false;
    const int hf = i & 1;
    u.A += (size_t)hf * aPlane; u.Bt += (size_t)hf * bPlane; u.keep = hf == 0;
    return true;
  }
};
struct FusedOrder {
  int G, c; const u16 *y0, *y1, *Wbr, *hA, *Wg;
  static constexpr size_t aPlane = 8388608, bPlane = (size_t)9728 * 512;
  DEVI bool next(int i, Unit& u) const {
    const int tile = c + (i / 12) * G; if (tile >= 256) return false;
    const int sub = i % 12, b = sub / 3, r = sub % 3;
    u.pm = tile >> 2; u.pn = tile & 3;
    if (r < 2) { u.A = hA + (size_t)r * aPlane; u.Bt = Wg + (size_t)r * bPlane + (size_t)b * 1024 * 512; u.keep = r == 0; u.br = b * 2; }
    else {
      const u16* sb = y0; const u16* yb = y1;
      asm volatile("" : "+s"(sb)); asm volatile("" : "+s"(yb));
      const size_t so = b == 0 ? 0 : (b == 2 ? 2 * SECE : 7 * SECE);
      u.A = (b == 1) ? yb : sb + so;
      u.Bt = Wbr + (size_t)b * 1024 * 512; u.keep = 0; u.br = b * 2 + 1;
    }
    return true;
  }
};
struct EpiFused {
  static constexpr bool PERM = true;
  u16* scratch; u16* mg;
  DEVI void operator()(const f32x4 (&acc)[2][2][4][2], const Unit& u, int wr, int wc, int fr_, int fq_) const {
    int ln_ = fq_ * 16 + fr_; asm volatile("" : "+v"(ln_));
    const int fr = ln_ & 15, fq = ln_ >> 4;
    const int tid = (wr * 4 + wc) * 64 + fq * 16 + fr;
    u16* sp = scratch + (size_t)blockIdx.x * 65536 + tid * 8;
    if ((u.br & 1) == 0) {
#pragma unroll
      for (int ai = 0; ai < 2; ++ai)
#pragma unroll
        for (int m = 0; m < 4; ++m)
#pragma unroll
          for (int bj = 0; bj < 2; ++bj) {
            f32x4 v0 = acc[ai][bj][m][0], v1 = acc[ai][bj][m][1];
#pragma unroll
            for (int e2 = 0; e2 < 4; ++e2) { v0[e2] = sigmf(v0[e2]); v1[e2] = sigmf(v1[e2]); }
            *(u4*)(sp + ((ai * 4 + m) * 2 + bj) * 4096) = pack8acc(v0, v1);
          }
    } else {
      const int cg0 = u.pn * 256 + wc * 32 + 8 * fq;
      const bool first = (u.br >> 1) == 0;
#pragma unroll
      for (int am = 0; am < 4; ++am) {
        const int ai = am >> 1, m0 = (am & 1) * 2;
        u4 gq[2][2], hq[2][2];
#pragma unroll
        for (int mm = 0; mm < 2; ++mm) {
          const size_t ro = (size_t)(u.pm * 256 + ai * 128 + wr * 64 + (m0 + mm) * 16 + fr) * 1024 + cg0;
#pragma unroll
          for (int bj = 0; bj < 2; ++bj) {
            gq[mm][bj] = *(const u4*)(sp + ((ai * 4 + m0 + mm) * 2 + bj) * 4096);
            hq[mm][bj] = u4{0, 0, 0, 0};
            if (!first) hq[mm][bj] = *(const u4*)(mg + ro + bj * 128);
          }
        }
#pragma unroll
        for (int mm = 0; mm < 2; ++mm) {
          const int m = m0 + mm;
          const size_t ro = (size_t)(u.pm * 256 + ai * 128 + wr * 64 + m * 16 + fr) * 1024 + cg0;
#pragma unroll
          for (int bj = 0; bj < 2; ++bj) {
            float gv[8], hv[8];
            unpack8(gq[mm][bj], gv); unpack8(hq[mm][bj], hv);
            f32x4 v0 = acc[ai][bj][m][0], v1 = acc[ai][bj][m][1];
#pragma unroll
            for (int e2 = 0; e2 < 4; ++e2) { v0[e2] = hv[e2] + gv[e2] * v0[e2]; v1[e2] = hv[4 + e2] + gv[4 + e2] * v1[e2]; }
            *(u4*)(mg + ro + bj * 128) = pack8acc(v0, v1);
          }
        }
      }
    }
  }
};
struct MergeOrder {
  int G, c; const u16* yA[4]; const u16* Wbr;
  DEVI bool next(int i, Unit& u) const {
    const int tile = c + (i >> 2) * G; if (tile >= 256) return false;
    const int b = i & 3;
    u.pm = tile >> 2; u.pn = tile & 3; u.br = b; u.keep = 0;
    u.A = b == 0 ? yA[0] : (b == 1 ? yA[1] : (b == 2 ? yA[2] : yA[3]));
    u.Bt = Wbr + (size_t)b * 1024 * 512;
    return true;
  }
};
struct EpiMerge {
  static constexpr bool PERM = true;
  const u16* sec; u16* hb;
  DEVI void operator()(const f32x4 (&acc)[2][2][4][2], const Unit& u, int wr, int wc, int fr, int fq) const {
    const int cg0 = u.pn * 256 + wc * 32 + 8 * fq;
    const u16* gs = sec + (size_t)gate_sec(u.br * 2 + (cg0 >> 9)) * SECE + (cg0 & 511);
    const bool first = (u.br == 0);
#pragma unroll
    for (int am = 0; am < 4; ++am) {
      const int ai = am >> 1, m0 = (am & 1) * 2;
      u4 gq[2][2], hq[2][2];
#pragma unroll
      for (int mm = 0; mm < 2; ++mm) {
        const int row = u.pm * 256 + ai * 128 + wr * 64 + (m0 + mm) * 16 + fr;
#pragma unroll
        for (int bj = 0; bj < 2; ++bj) {
          gq[mm][bj] = *(const u4*)(gs + (size_t)row * 512 + bj * 128);
          hq[mm][bj] = u4{0, 0, 0, 0};
          if (!first) hq[mm][bj] = *(const u4*)(hb + (size_t)row * 1024 + cg0 + bj * 128);
        }
      }
#pragma unroll
      for (int mm = 0; mm < 2; ++mm) {
        const int m = m0 + mm;
        const int row = u.pm * 256 + ai * 128 + wr * 64 + m * 16 + fr;
#pragma unroll
        for (int bj = 0; bj < 2; ++bj) {
          float gv[8], hv[8];
          unpack8(gq[mm][bj], gv); unpack8(hq[mm][bj], hv);
          f32x4 v0 = acc[ai][bj][m][0], v1 = acc[ai][bj][m][1];
#pragma unroll
          for (int e = 0; e < 4; ++e) { v0[e] = hv[e] + gv[e] * v0[e]; v1[e] = hv[4 + e] + gv[4 + e] * v1[e]; }
          *(u4*)(hb + (size_t)row * 1024 + cg0 + bj * 128) = pack8acc(v0, v1);
        }
      }
    }
  }
};
}

DEVI void proj_phase(const P& p, unsigned char* smem) {
  pg8::HalfKOrder S; S.base.init(16384, 5632, gridDim.x, blockIdx.x, p.h, p.WinT); S.aPlane = 8388608; S.bPlane = (size_t)9728 * 512;
  const pg8::Gemm g{p.h, p.WinT, 16384, 5632, 512};
  const pg8::EpiProj E{p.sec, p.halo};
  pg8::gemm_phase((PG8_LAS unsigned char*)smem, g, S, E);
}
DEVI void gates_phase(const P& p, unsigned char* smem) {
  pg8::StaticOrder S; S.init(16384, 4096, gridDim.x, blockIdx.x, p.h, p.WinT + (size_t)5632 * 1024);
  const pg8::Gemm g{p.h, p.WinT + (size_t)5632 * 1024, 16384, 4096, 1024};
  const pg8::EpiGates E{p.sec};
  pg8::gemm_phase((PG8_LAS unsigned char*)smem, g, S, E);
}
DEVI void merge_phase(const P& p, unsigned char* smem) {
  pg8::FusedOrder S;
  S.G = gridDim.x; S.c = blockIdx.x; S.y0 = p.sec + 3 * SECE; S.y1 = p.YB; S.Wbr = p.WbrT;
  S.hA = p.h; S.Wg = p.WinT + (size_t)5632 * 512;
  const pg8::Gemm g{p.YB, p.WbrT, 16384, 1024, 512};
  const pg8::EpiFused E{p.sec + 6 * SECE, p.sec};
  pg8::gemm_phase((PG8_LAS unsigned char*)smem, g, S, E);
}
DEVI void resid_gemm_phase(const P& p, int l, int which, unsigned char* smem) {
  pg8::StaticOrder S; S.init(16384, 1024, gridDim.x, blockIdx.x, p.sec, which == 0 ? p.WoutT : p.W2T);
  const pg8::Gemm g{p.sec, which == 0 ? p.WoutT : p.W2T, 16384, 1024, which == 0 ? 1024 : 4096};
  const float* modl = p.modp + (size_t)l * 2 * 6144;
  if (which == 0) {
    const pg8::EpiResidXs E{l == 0 ? p.x : p.out, p.out, modl + 2 * 1024, p.norm2_g + l * 1024, modl + 4 * 1024, p.sec + 8 * SECE, p.rowss};
    pg8::gemm_phase((PG8_LAS unsigned char*)smem, g, S, E);
  } else {
    const pg8::EpiResid E{p.out, p.out, modl + 5 * 1024};
    pg8::gemm_phase((PG8_LAS unsigned char*)smem, g, S, E);
  }
}
DEVI void mlp1_phase(const P& p, unsigned char* smem) {
  pg8::StaticOrder S; S.init(16384, 4096, gridDim.x, blockIdx.x, p.sec + 8 * SECE, p.W1T);
  const pg8::Gemm g{p.sec + 8 * SECE, p.W1T, 16384, 4096, 1024};
  const pg8::EpiMlp1 E{p.sec, p.rowss, p.modp + 32768};
  pg8::gemm_phase((PG8_LAS unsigned char*)smem, g, S, E);
}
DEVI void bias2_unit(const P& p, int l, int u) {
  const int t = tid_l(), lane = t & 63, wid = t >> 6;
  float sh0[16], sh1[16];
#pragma unroll
  for (int j = 0; j < 16; ++j) { sh0[j] = modval(p, l, 0, 3 * 1024 + lane * 16 + j); sh1[j] = modval(p, l, 1, 3 * 1024 + lane * 16 + j); }
#pragma unroll 1
  for (int c = 0; c < 8; ++c) {
    const int n = u * 64 + wid * 8 + c;
    float w[16];
    const u16* wp = p.W1T + (size_t)n * 1024 + lane * 16;
    unpack8(*(const u4*)wp, w); unpack8(*(const u4*)(wp + 8), w + 8);
    float a0 = 0.f, a1 = 0.f;
#pragma unroll
    for (int j = 0; j < 16; ++j) { a0 += sh0[j] * w[j]; a1 += sh1[j] * w[j]; }
    a0 = wave_sum(a0); a1 = wave_sum(a1);
    if (lane == 0) { p.modp[32768 + n] = a0; p.modp[32768 + 4096 + n] = a1; }
  }
}

DEVI bf16x8 acc2frag(f32x4 t0, f32x4 t1, float sgn) {
  u4 o; o.x = pack2(sgn * t0[0], sgn * t0[1]); o.y = pack2(sgn * t0[2], sgn * t0[3]); o.z = pack2(sgn * t1[0], sgn * t1[1]); o.w = pack2(sgn * t1[2], sgn * t1[3]);
  return *(bf16x8*)&o;
}
DEVI void dn_prep_unit(const P& p, int l, int u, unsigned char* smem) {
  const int t = tid_l(), lane = t & 63, wid = t >> 6, mr = lane & 15, g = lane >> 4;
  const int h = u & 3, n = (u >> 2) & 127, b = u >> 9;
  const int r0 = b * SEQ + n * 64;
  float* Lm = (float*)smem;
  float* cw = Lm + 64 * 64;
  float* gcs = cw + 1536;
  u16* Qs = (u16*)(gcs + 128);
  u16* Ks = Qs + 64 * 136;
  u16* KTl = Ks + 64 * 136;
  u16* VTl = KTl + 128 * 72;
  u16* TB = VTl + 128 * 72;
  u16* TBe = TB + 64 * 72;
  float* bs = gcs + 64;
  for (int i = t; i < 1536; i += NT) {
    const int s = i >> 9, j = (i >> 7) & 3, c = i & 127;
    cw[i] = p.dn_conv_w[(size_t)(l * 4 + j) * 1536 + s * 512 + h * 128 + c];
  }
  if (wid == 0) {
    float gg = p.glog[(size_t)(r0 + lane) * 4 + h];
#pragma unroll
    for (int o = 1; o < 64; o <<= 1) {
      const float v = __shfl_up(gg, o);
      if (lane >= o) gg += v;
    }
    gcs[lane] = gg;
    bs[lane] = p.beta[(size_t)(r0 + lane) * 4 + h];
  }
  __syncthreads();
  const int row = t >> 3, c0 = (t & 7) * 16;
#pragma unroll
  for (int s = 0; s < 3; ++s) {
    const u16* sp = p.sec + (size_t)s * SECE;
    float y[16];
#pragma unroll
    for (int c = 0; c < 16; ++c) y[c] = 0.f;
#pragma unroll
    for (int j = 0; j < 4; ++j) {
      const int tt = row - 3 + j;
      u4 v0 = {0, 0, 0, 0}, v1 = {0, 0, 0, 0};
      if (tt >= 0) {
        const u16* src = sp + (size_t)(r0 + tt) * 512 + h * 128 + c0;
        v0 = *(const u4*)src; v1 = *(const u4*)(src + 8);
      } else if (n > 0) {
        const u16* src = p.halo + ((size_t)((r0 >> 6) - 1) * 3 + (tt + 3)) * 1536 + s * 512 + h * 128 + c0;
        v0 = *(const u4*)src; v1 = *(const u4*)(src + 8);
      }
      float f[16];
      unpack8(v0, f); unpack8(v1, f + 8);
#pragma unroll
      for (int c = 0; c < 16; ++c) y[c] += cw[(s * 4 + j) * 128 + c0 + c] * f[c];
    }
    float ss = 0.f;
#pragma unroll
    for (int c = 0; c < 16; ++c) { y[c] = siluf(y[c]); ss += y[c] * y[c]; }
    if (s < 2) {
      ss += __shfl_xor(ss, 1); ss += __shfl_xor(ss, 2); ss += __shfl_xor(ss, 4);
      const float sc = rsqrtf(ss + 1e-6f) * (s == 0 ? 0.08838834764831845f : 1.f);
#pragma unroll
      for (int c = 0; c < 16; ++c) y[c] *= sc;
    }
    if (s < 2) {
      u16* dl = (s == 0 ? Qs : Ks) + row * 136 + c0;
      *(u4*)dl = pack8(y); *(u4*)(dl + 8) = pack8(y + 8);
    }
    if (s >= 1) {
      u16* dT = (s == 1 ? KTl : VTl);
#pragma unroll
      for (int c = 0; c < 16; ++c) dT[(c0 + c) * 72 + row] = f2bf(y[c]);
    }
  }
  __syncthreads();
#pragma unroll 1
  for (int idx = wid; idx < 10; idx += 8) {
    const int ti = idx >= 6 ? 3 : (idx >= 3 ? 2 : (idx >= 1 ? 1 : 0)), tj = idx - ti * (ti + 1) / 2;
    f32x4 akk = {0.f, 0.f, 0.f, 0.f};
#pragma unroll
    for (int k0 = 0; k0 < 128; k0 += 32) akk = mfma16(frag(Ks, 136, ti * 16, k0, lane), frag(Ks, 136, tj * 16, k0, lane), akk);
    const int j = tj * 16 + mr;
#pragma unroll
    for (int r = 0; r < 4; ++r) {
      const int i = ti * 16 + g * 4 + r;
      Lm[i * 64 + j] = (i > j) ? bs[i] * akk[r] * __expf(gcs[i] - gcs[j]) : 0.f;
    }
  }
  if (wid < 6) {
    const int m = wid < 2 ? wid : (wid < 4 ? 2 : 3), ks2 = wid < 2 ? 0 : ((wid - 2) & 1);
    f32x4 t0 = {0.f, 0.f, 0.f, 0.f}, t1 = {0.f, 0.f, 0.f, 0.f};
#pragma unroll
    for (int k0 = 0; k0 < 128; k0 += 32) {
      const bf16x8 bq = frag(Qs, 136, m * 16, k0, lane);
      t0 = mfma16(frag(Ks, 136, (2 * ks2) * 16, k0, lane), bq, t0);
      t1 = mfma16(frag(Ks, 136, (2 * ks2 + 1) * 16, k0, lane), bq, t1);
    }
    const int i = m * 16 + mr;
    const float gi = gcs[i];
#pragma unroll
    for (int r = 0; r < 4; ++r) {
      const int j0 = 32 * ks2 + 4 * g + r, j1 = j0 + 16;
      t0[r] = (i >= j0) ? t0[r] * __expf(gi - gcs[j0]) : 0.f;
      t1[r] = (i >= j1) ? t1[r] * __expf(gi - gcs[j1]) : 0.f;
    }
    *(bf16x8*)(p.QKF + (size_t)u * 3072 + wid * 512 + lane * 8) = acc2frag(t0, t1, 1.f);
  }
  __syncthreads();
  {
    typedef float f32x16 __attribute__((ext_vector_type(16)));
    float* Tf = (float*)(TBe + 64 * 72);
    float* Xf = Tf + 2048;
    if (wid < 2 && lane < 32) {
      const int o = wid * 32;
      float T[32];
#pragma unroll
      for (int i = 0; i < 32; ++i) {
        float sv = (i == lane) ? 1.f : 0.f;
#pragma unroll
        for (int j = 0; j < i; ++j) sv -= Lm[(o + i) * 64 + o + j] * T[j];
        T[i] = sv;
      }
#pragma unroll
      for (int i = 0; i < 32; ++i) Tf[wid * 1024 + i * 32 + lane] = T[i];
    }
    __syncthreads();
    if (wid == 0) {
      const int li = lane & 31, lh = lane >> 5;
      f32x16 acc;
#pragma unroll
      for (int r = 0; r < 16; ++r) acc[r] = 0.f;
#pragma unroll
      for (int kk = 0; kk < 16; ++kk)
        acc = __builtin_amdgcn_mfma_f32_32x32x2f32(Lm[(32 + li) * 64 + 2 * kk + lh], Tf[(2 * kk + lh) * 32 + li], acc, 0, 0, 0);
#pragma unroll
      for (int r = 0; r < 16; ++r) Xf[((r & 3) + 8 * (r >> 2) + 4 * lh) * 32 + li] = acc[r];
      asm volatile("s_waitcnt lgkmcnt(0)" ::: "memory");
      f32x16 acc2;
#pragma unroll
      for (int r = 0; r < 16; ++r) acc2[r] = 0.f;
#pragma unroll
      for (int kk = 0; kk < 16; ++kk)
        acc2 = __builtin_amdgcn_mfma_f32_32x32x2f32(Tf[1024 + li * 32 + 2 * kk + lh], Xf[(2 * kk + lh) * 32 + li], acc2, 0, 0, 0);
#pragma unroll
      for (int r = 0; r < 16; ++r) Lm[(32 + (r & 3) + 8 * (r >> 2) + 4 * lh) * 64 + li] = -acc2[r];
    }
    __syncthreads();
#pragma unroll
    for (int q = 0; q < 8; ++q) {
      const int idx = t + q * NT, i = idx >> 6, j = idx & 63;
      float val = 0.f;
      if (i < 32) { if (j < 32) val = Tf[i * 32 + j]; }
      else if (j >= 32) val = Tf[1024 + (i - 32) * 32 + (j - 32)];
      else val = Lm[i * 64 + j];
      const float bl = bs[j];
      TB[i * 72 + j] = f2bf(val * bl);
      TBe[i * 72 + j] = f2bf(val * bl * __expf(gcs[j]));
    }
  }
  __syncthreads();
  const size_t rbase = (size_t)r0 * 512 + h * 128;
  u16* secQ = p.sec + rbase;
  u16* secW = p.sec + SECE + rbase;
  u16* secK = p.sec + 2 * SECE + rbase;
  const size_t fo = (size_t)(lane >> 4) * 512 + (lane & 15) * 8;
#pragma unroll
  for (int rep = 0; rep < 2; ++rep) {
    const int f = wid + rep * 8;
    {
      const int m = f >> 2, ks = f & 3;
      f32x4 t0 = {0.f, 0.f, 0.f, 0.f}, t1 = {0.f, 0.f, 0.f, 0.f};
#pragma unroll
      for (int k0 = 0; k0 < 64; k0 += 32) {
        const bf16x8 bt = frag(TBe, 72, m * 16, k0, lane);
        t0 = mfma16(frag(KTl, 72, (2 * ks) * 16, k0, lane), bt, t0);
        t1 = mfma16(frag(KTl, 72, (2 * ks + 1) * 16, k0, lane), bt, t1);
      }
      *(bf16x8*)(secW + (size_t)(4 * f) * 512 + fo) = acc2frag(t0, t1, -1.f);
    }
    {
      const int m = f >> 2, ks = f & 3, pos = m * 16 + mr;
      const float eg = __expf(gcs[pos]);
      const u2 a = *(const u2*)(Qs + pos * 136 + 32 * ks + 4 * g), c = *(const u2*)(Qs + pos * 136 + 32 * ks + 16 + 4 * g);
      u4 o;
      o.x = pack2(eg * lo2f(a.x), eg * hi2f(a.x)); o.y = pack2(eg * lo2f(a.y), eg * hi2f(a.y));
      o.z = pack2(eg * lo2f(c.x), eg * hi2f(c.x)); o.w = pack2(eg * lo2f(c.y), eg * hi2f(c.y));
      *(u4*)(secQ + (size_t)(4 * f) * 512 + fo) = o;
    }
    {
      const int d = f >> 1, ks2 = f & 1, dk = d * 16 + mr;
      const float G = gcs[63];
      const u2 a = *(const u2*)(KTl + dk * 72 + 32 * ks2 + 4 * g), c = *(const u2*)(KTl + dk * 72 + 32 * ks2 + 16 + 4 * g);
      const int p0 = 32 * ks2 + 4 * g, p1 = p0 + 16;
      u4 o;
      o.x = pack2(__expf(G - gcs[p0]) * lo2f(a.x), __expf(G - gcs[p0 + 1]) * hi2f(a.x));
      o.y = pack2(__expf(G - gcs[p0 + 2]) * lo2f(a.y), __expf(G - gcs[p0 + 3]) * hi2f(a.y));
      o.z = pack2(__expf(G - gcs[p1]) * lo2f(c.x), __expf(G - gcs[p1 + 1]) * hi2f(c.x));
      o.w = pack2(__expf(G - gcs[p1 + 2]) * lo2f(c.y), __expf(G - gcs[p1 + 3]) * hi2f(c.y));
      *(u4*)(secK + (size_t)(4 * f) * 512 + fo) = o;
    }
  }
  {
    u16* ud = p.TQ + (size_t)u * 8192 + wid * 1024 + lane * 16;
#pragma unroll
    for (int m = 0; m < 4; ++m) {
      f32x4 a = {0.f, 0.f, 0.f, 0.f};
#pragma unroll
      for (int k0 = 0; k0 < 64; k0 += 32) a = mfma16(frag(TB, 72, m * 16, k0, lane), frag(VTl, 72, wid * 16, k0, lane), a);
      *(u2*)(ud + m * 4) = pack4v(a);
    }
  }
  if (t == 0) p.EG[u] = __expf(gcs[63]);
  __syncthreads();
}

DEVI void dn_chain(const P& p, int l, int bh, int half, unsigned char* smem) {
  constexpr int NQ = 1;
  const int t = tid_l(), lane = t & 63, wid = __builtin_amdgcn_readfirstlane(t >> 6);
  const int h = bh & 3, b = bh >> 2;
  typedef __attribute__((address_space(3))) unsigned char* LP_;
  LP_ lds = (LP_)smem;
  constexpr int BUFB = 55296;
  const size_t lo = (size_t)(lane >> 4) * 512 + (lane & 15) * 8;
  auto issue = [&](int n, int bi) __attribute__((always_inline)) {
    if (wid >= 4) {
      const int w4 = wid - 4;
      const size_t rbase = ((size_t)b * SEQ + (size_t)n * 64) * 512 + h * 128;
      const size_t unit = ((size_t)b * 128 + n) * 4 + h;
#pragma unroll
      for (int rep = 0; rep < 4; ++rep) {
        const int f = w4 + rep * 4;
        const size_t go = rbase + (size_t)(4 * f) * 512 + lo;
        __builtin_amdgcn_global_load_lds((const unsigned*)(p.sec + SECE + go), (__attribute__((address_space(3))) unsigned*)(lds + bi * BUFB + f * 1024), 16, 0, 0);
        __builtin_amdgcn_global_load_lds((const unsigned*)(p.sec + go), (__attribute__((address_space(3))) unsigned*)(lds + bi * BUFB + 16384 + f * 1024), 16, 0, 0);
        __builtin_amdgcn_global_load_lds((const unsigned*)(p.sec + 2 * SECE + go), (__attribute__((address_space(3))) unsigned*)(lds + bi * BUFB + 32768 + f * 1024), 16, 0, 0);
      }
#pragma unroll
      for (int rep = 0; rep < 2; ++rep) {
        const int f = w4 + rep * 4;
        if (f < 6)
          __builtin_amdgcn_global_load_lds((const unsigned*)(p.QKF + unit * 3072 + f * 512 + lane * 8), (__attribute__((address_space(3))) unsigned*)(lds + bi * BUFB + 49152 + f * 1024), 16, 0, 0);
      }
    }
  };
  const bool cw_ = wid < 4;
  f32x4 Sacc[2][8];
#pragma unroll
  for (int q = 0; q < NQ; ++q)
#pragma unroll
    for (int j = 0; j < 8; ++j) Sacc[q][j] = f32x4{0.f, 0.f, 0.f, 0.f};
  u4 ur[2][2];
  u4 op[2][2];
  float eGn;
  {
    const size_t unit = ((size_t)b * 128) * 4 + h;
    issue(0, 0);
    if (cw_) {
#pragma unroll
      for (int q = 0; q < NQ; ++q) {
        const u16* us = p.TQ + unit * 8192 + (half * 4 + wid * NQ + q) * 1024 + lane * 16;
        ur[q][0] = *(const u4*)us; ur[q][1] = *(const u4*)(us + 8);
      }
    }
    eGn = p.EG[unit];
  }
#pragma unroll 1
  for (int n = 0; n < 128; ++n) {
    asm volatile("s_waitcnt vmcnt(0)" ::: "memory");
    __syncthreads();
    if (t == 256 && (n & 3) == 0) {
      __builtin_amdgcn_fence(__ATOMIC_RELEASE, "agent");
      asm volatile("s_waitcnt vmcnt(0)" ::: "memory");
      __hip_atomic_store(p.prog + (bh * 2 + half) * 16, (unsigned)(n > 0 ? n - 1 : 0), __ATOMIC_RELAXED, __HIP_MEMORY_SCOPE_AGENT);
    }
    if (cw_ && n > 0) {
      const size_t pu = ((size_t)b * 128 + (n - 1)) * 4 + h;
#pragma unroll
      for (int q = 0; q < NQ; ++q) {
        u16* od = p.TQ + pu * 8192 + (half * 4 + wid * NQ + q) * 1024 + lane * 16;
        *(u4*)od = op[q][0]; *(u4*)(od + 8) = op[q][1];
      }
    }
    u4 uc[2][2];
#pragma unroll
    for (int q = 0; q < NQ; ++q) { uc[q][0] = ur[q][0]; uc[q][1] = ur[q][1]; }
    const float eG = eGn;
    const size_t unit = ((size_t)b * 128 + n) * 4 + h;
    if (n + 1 < 128) {
      issue(n + 1, (n + 1) & 1);
      if (cw_) {
#pragma unroll
        for (int q = 0; q < NQ; ++q) {
          const u16* us = p.TQ + (unit + 4) * 8192 + (half * 4 + wid * NQ + q) * 1024 + lane * 16;
          ur[q][0] = *(const u4*)us; ur[q][1] = *(const u4*)(us + 8);
        }
      }
      eGn = p.EG[unit + 4];
    }
    if (cw_) {
      const __attribute__((address_space(3))) unsigned char* bb = lds + (n & 1) * BUFB + lane * 16;
#define LFRAG(off) (*(const __attribute__((address_space(3))) bf16x8*)(bb + (off)))
      bf16x8 Sb[2][4];
#pragma unroll
      for (int q = 0; q < NQ; ++q)
#pragma unroll
        for (int ks = 0; ks < 4; ++ks) Sb[q][ks] = acc2frag(Sacc[q][2 * ks], Sacc[q][2 * ks + 1], 1.f);
      f32x4 accV[2][4], accO[2][4];
#pragma unroll
      for (int q = 0; q < NQ; ++q) {
        accV[q][0] = f32x4{lo2f(uc[q][0].x), hi2f(uc[q][0].x), lo2f(uc[q][0].y), hi2f(uc[q][0].y)};
        accV[q][1] = f32x4{lo2f(uc[q][0].z), hi2f(uc[q][0].z), lo2f(uc[q][0].w), hi2f(uc[q][0].w)};
        accV[q][2] = f32x4{lo2f(uc[q][1].x), hi2f(uc[q][1].x), lo2f(uc[q][1].y), hi2f(uc[q][1].y)};
        accV[q][3] = f32x4{lo2f(uc[q][1].z), hi2f(uc[q][1].z), lo2f(uc[q][1].w), hi2f(uc[q][1].w)};
#pragma unroll
        for (int m = 0; m < 4; ++m) accO[q][m] = f32x4{0.f, 0.f, 0.f, 0.f};
      }
      constexpr int RING = 24;
      bf16x8 R[RING];
      bf16x8 Vb[2][2];
#define FOFF(i) ((i) < 16 ? (((i) & 3) * 4 + ((i) >> 2)) * 1024 : (i) < 32 ? 16384 + ((((i) - 16) & 3) * 4 + (((i) - 16) >> 2)) * 1024 : (i) < 38 ? 49152 + ((i) - 32) * 1024 : 32768 + ((i) - 38) * 1024)
#pragma unroll
      for (int i = 0; i < RING; ++i) R[i] = LFRAG(FOFF(i));
#pragma unroll
      for (int i = 0; i < 54; ++i) {
        const bf16x8 fr = R[i % RING];
        if (i < 16) {
          const int ks = i >> 2, m = i & 3;
#pragma unroll
          for (int q = 0; q < NQ; ++q) accV[q][m] = mfma16(fr, Sb[q][ks], accV[q][m]);
        } else if (i < 32) {
          const int ks = (i - 16) >> 2, m = (i - 16) & 3;
#pragma unroll
          for (int q = 0; q < NQ; ++q) accO[q][m] = mfma16(fr, Sb[q][ks], accO[q][m]);
        } else if (i < 38) {
          const int f = i - 32;
          const int m = f < 2 ? f : (f < 4 ? 2 : 3), k2 = f < 2 ? 0 : ((f - 2) & 1);
#pragma unroll
          for (int q = 0; q < NQ; ++q) accO[q][m] = mfma16(fr, Vb[q][k2], accO[q][m]);
        } else {
          const int j = i - 38, d = j >> 1, k2 = j & 1;
#pragma unroll
          for (int q = 0; q < NQ; ++q) {
            if (k2 == 0) Sacc[q][d] *= eG;
            Sacc[q][d] = mfma16(fr, Vb[q][k2], Sacc[q][d]);
          }
        }
        if (i == 15) {
#pragma unroll
          for (int q = 0; q < NQ; ++q) { Vb[q][0] = acc2frag(accV[q][0], accV[q][1], 1.f); Vb[q][1] = acc2frag(accV[q][2], accV[q][3], 1.f); }
        }
        if (i + RING < 54) R[i % RING] = LFRAG(FOFF(i + RING));
        __builtin_amdgcn_sched_barrier(0);
      }
#undef FOFF
#undef LFRAG
#pragma unroll
      for (int q = 0; q < NQ; ++q) {
        u4 o0, o1;
        o0.x = pack2(accO[q][0][0], accO[q][0][1]); o0.y = pack2(accO[q][0][2], accO[q][0][3]); o0.z = pack2(accO[q][1][0], accO[q][1][1]); o0.w = pack2(accO[q][1][2], accO[q][1][3]);
        o1.x = pack2(accO[q][2][0], accO[q][2][1]); o1.y = pack2(accO[q][2][2], accO[q][2][3]); o1.z = pack2(accO[q][3][0], accO[q][3][1]); o1.w = pack2(accO[q][3][2], accO[q][3][3]);
        op[q][0] = o0; op[q][1] = o1;
      }
    }
  }
  if (cw_) {
    const size_t pu = ((size_t)b * 128 + 127) * 4 + h;
#pragma unroll
    for (int q = 0; q < NQ; ++q) {
      u16* od = p.TQ + pu * 8192 + (half * 4 + wid * NQ + q) * 1024 + lane * 16;
      *(u4*)od = op[q][0]; *(u4*)(od + 8) = op[q][1];
    }
  }
  asm volatile("s_waitcnt vmcnt(0)" ::: "memory");
  __syncthreads();
  if (t == 256) {
    __builtin_amdgcn_fence(__ATOMIC_RELEASE, "agent");
    asm volatile("s_waitcnt vmcnt(0)" ::: "memory");
    __hip_atomic_store(p.prog + (bh * 2 + half) * 16, 128u, __ATOMIC_RELAXED, __HIP_MEMORY_SCOPE_AGENT);
  }
  __syncthreads();
}

DEVI void dn_chain_helper(const P& p, int bh, unsigned char* smem) {
  const int t = tid_l();
  const int h = bh & 3, b = bh >> 2;
  unsigned acc = 0;
#pragma unroll 1
  for (int n = 1; n < 128; ++n) {
    if (t == 0) {
      unsigned polls = 0;
      while ((int)__hip_atomic_load(p.prog + (bh * 2) * 16, __ATOMIC_RELAXED, __HIP_MEMORY_SCOPE_AGENT) + 4 < n && polls < 200000u) { __builtin_amdgcn_s_sleep(4); ++polls; }
    }
    __syncthreads();
    const size_t r0 = (size_t)b * SEQ + (size_t)n * 64;
    const size_t unit = ((size_t)b * 128 + n) * 4 + h;
    const size_t ro = (r0 + (t >> 3)) * 512 + h * 128 + (t & 7) * 16;
#pragma unroll
    for (int s3 = 0; s3 < 3; ++s3) {
      const u4 a = *(const u4*)(p.sec + (size_t)s3 * SECE + ro), c = *(const u4*)(p.sec + (size_t)s3 * SECE + ro + 8);
      acc ^= a.x ^ a.y ^ a.z ^ a.w ^ c.x ^ c.y ^ c.z ^ c.w;
    }
    {
      const u4 a = *(const u4*)(p.TQ + unit * 8192 + (size_t)t * 16), c = *(const u4*)(p.TQ + unit * 8192 + (size_t)t * 16 + 8);
      acc ^= a.x ^ a.y ^ a.z ^ a.w ^ c.x ^ c.y ^ c.z ^ c.w;
      if (t < 384) { const u4 q = *(const u4*)(p.QKF + unit * 3072 + (size_t)t * 8); acc ^= q.x ^ q.y ^ q.z ^ q.w; }
    }
  }
  if (acc == 0x9e3779b9u) p.prog[1024 - 1] = acc;
  __syncthreads();
}

DEVI void ya_unit(const P& p, int l, int u, unsigned char* smem) {
  const int t = tid_l(), lane = t & 63, wid = t >> 6, c = lane & 15, g = lane >> 4;
  const int h = u & 3, n = (u >> 2) & 127, b = u >> 9;
  const int r0 = b * SEQ + n * 64;
  float* part = (float*)smem;
  const u16* os = p.TQ + (size_t)u * 8192 + wid * 1024 + lane * 16;
  float o[16];
  unpack8(*(const u4*)os, o); unpack8(*(const u4*)(os + 8), o + 8);
#pragma unroll
  for (int i = 0; i < 16; ++i) {
    float s = o[i] * o[i];
    s += __shfl_xor(s, 1); s += __shfl_xor(s, 2); s += __shfl_xor(s, 4); s += __shfl_xor(s, 8);
    if (c == 0) part[wid * 64 + (i >> 2) * 16 + g * 4 + (i & 3)] = s;
  }
  __syncthreads();
  const int dv = wid * 16 + c;
  const float ng = p.dn_norm_g[l * 128 + dv];
  u16* zs = p.sec + 3 * SECE + (size_t)r0 * 512 + h * 128 + dv;
  u16 zv[16];
#pragma unroll
  for (int i = 0; i < 16; ++i) zv[i] = zs[(size_t)((i >> 2) * 16 + g * 4 + (i & 3)) * 512];
#pragma unroll
  for (int i = 0; i < 16; ++i) {
    const int pos = (i >> 2) * 16 + g * 4 + (i & 3);
    float ss = 0.f;
#pragma unroll
    for (int w = 0; w < 8; ++w) ss += part[w * 64 + pos];
    const float rs = rsqrtf(ss * (1.f / 128.f) + 1e-6f);
    zs[(size_t)pos * 512] = f2bf(o[i] * rs * ng * siluf(bf2f(zv[i])));
  }
  __syncthreads();
}

DEVI float ret_log2gamma(int h) { return log2f(1.f - exp2f(-5.f - (float)h)); }
DEVI void load_rope_tile(const P& p, const u16* secp, int r0, int h, float scale, u16* dst, u16* dstT, float l2g) {
  const int t = tid_l();
  const int row = t >> 2, j0 = (t & 3) * 16;
  const u16* src = secp + (size_t)(r0 + row) * 512 + h * 128;
  float x1[16], x2[16];
  unpack8(*(const u4*)(src + j0), x1); unpack8(*(const u4*)(src + j0 + 8), x1 + 8);
  unpack8(*(const u4*)(src + 64 + j0), x2); unpack8(*(const u4*)(src + 64 + j0 + 8), x2 + 8);
  const float* cs = p.ropecs + ((size_t)(r0 + row) * 64 + j0) * 2;
  float o1[16], o2[16];
#pragma unroll
  for (int j = 0; j < 16; j += 2) {
    const float4 c4 = *(const float4*)(cs + j * 2);
    o1[j] = (x1[j] * c4.x - x2[j] * c4.y) * scale;
    o2[j] = (x1[j] * c4.y + x2[j] * c4.x) * scale;
    o1[j + 1] = (x1[j + 1] * c4.z - x2[j + 1] * c4.w) * scale;
    o2[j + 1] = (x1[j + 1] * c4.w + x2[j + 1] * c4.z) * scale;
  }
  *(u4*)(dst + row * 136 + j0) = pack8(o1); *(u4*)(dst + row * 136 + j0 + 8) = pack8(o1 + 8);
  *(u4*)(dst + row * 136 + 64 + j0) = pack8(o2); *(u4*)(dst + row * 136 + 64 + j0 + 8) = pack8(o2 + 8);
  if (dstT) {
    const float z = exp2f(l2g * (float)(127 - row));
#pragma unroll
    for (int j = 0; j < 16; ++j) {
      dstT[(j0 + j) * 136 + row] = f2bf(o1[j] * z);
      dstT[(64 + j0 + j) * 136 + row] = f2bf(o2[j] * z);
    }
  }
}
DEVI void ret_d1_unit(const P& p, int u, unsigned char* smem) {
  const int t = tid_l(), lane = t & 63, wid = t >> 6;
  const int h = u & 3, n = (u >> 2) & 63, b = u >> 8;
  const int r0 = b * SEQ + n * 128;
  const float l2g = ret_log2gamma(h);
  u16* Qs = (u16*)smem;
  u16* Ks = Qs + 128 * 136;
  u16* KTz = Ks + 128 * 136;
  u16* VT = KTz + 128 * 136;
  load_rope_tile(p, p.sec + 7 * SECE, r0, h, 1.f, Qs, nullptr, 0.f);
  load_rope_tile(p, p.sec + 8 * SECE, r0, h, 0.08838834764831845f, Ks, KTz, l2g);
  {
    const int row = t >> 2, c0 = (t & 3) * 32;
    const u16* src = p.sec + 9 * SECE + (size_t)(r0 + row) * 512 + h * 128 + c0;
#pragma unroll
    for (int q = 0; q < 4; ++q) {
      const u4 v = *(const u4*)(src + q * 8);
      const u16* e = (const u16*)&v;
#pragma unroll
      for (int j = 0; j < 8; ++j) VT[(c0 + q * 8 + j) * 136 + row] = e[j];
    }
  }
  __syncthreads();
  f32x4 sacc[8];
#pragma unroll
  for (int ii = 0; ii < 8; ++ii) sacc[ii] = f32x4{0.f, 0.f, 0.f, 0.f};
#pragma unroll
  for (int k0 = 0; k0 < 128; k0 += 32) {
    const bf16x8 a = frag(Ks, 136, wid * 16, k0, lane);
#pragma unroll
    for (int ii = 0; ii < 8; ++ii) sacc[ii] = mfma16(a, frag(Qs, 136, ii * 16, k0, lane), sacc[ii]);
  }
  __syncthreads();
#pragma unroll
  for (int ii = 0; ii < 8; ++ii) {
    const int i = ii * 16 + (lane & 15), j0 = wid * 16 + (lane >> 4) * 4;
    f32x4 v;
#pragma unroll
    for (int r = 0; r < 4; ++r) v[r] = (i >= j0 + r) ? sacc[ii][r] * exp2f(l2g * (float)(i - j0 - r)) : 0.f;
    *(u2*)(Qs + i * 136 + j0) = pack4v(v);
  }
  __syncthreads();
  f32x4 oacc[8], kacc[8];
#pragma unroll
  for (int ii = 0; ii < 8; ++ii) { oacc[ii] = f32x4{0.f, 0.f, 0.f, 0.f}; kacc[ii] = f32x4{0.f, 0.f, 0.f, 0.f}; }
#pragma unroll
  for (int k0 = 0; k0 < 128; k0 += 32) {
    const bf16x8 a1 = frag(Qs, 136, wid * 16, k0, lane), a2 = frag(KTz, 136, wid * 16, k0, lane);
#pragma unroll
    for (int ii = 0; ii < 8; ++ii) {
      const bf16x8 bb = frag(VT, 136, ii * 16, k0, lane);
      oacc[ii] = mfma16(a1, bb, oacc[ii]);
      kacc[ii] = mfma16(a2, bb, kacc[ii]);
    }
  }
  u16* od = p.sec + 8 * SECE;
  u16* kd = p.sec + 9 * SECE;
#pragma unroll
  for (int ii = 0; ii < 8; ++ii) {
    const int e = ii * 16 + (lane & 15);
#pragma unroll
    for (int r = 0; r < 4; ++r) {
      const size_t o = (size_t)(r0 + wid * 16 + (lane >> 4) * 4 + r) * 512 + h * 128 + e;
      od[o] = f2bf(oacc[ii][r]);
      kd[o] = f2bf(kacc[ii][r]);
    }
  }
  __syncthreads();
}
DEVI void ret_d2_unit(const P& p, int l, int b, int h, int n, float (&acc)[32], bool carry, unsigned char* smem) {
  const int t = tid_l(), lane = t & 63, wid = t >> 6;
  const int r0 = b * SEQ + n * 128;
  const float l2g = ret_log2gamma(h);
  u16* Qs = (u16*)smem;
  u16* PT = Qs + 128 * 136;
  load_rope_tile(p, p.sec + 7 * SECE, r0, h, 1.f, Qs, nullptr, 0.f);
  {
    const int d = t >> 2, e0 = (t & 3) * 32;
    const float G = exp2f(l2g * 128.f);
    const u16* src = p.sec + 9 * SECE + ((size_t)b * SEQ + d) * 512 + h * 128 + e0;
    int m = 0;
    if (carry) m = n - 1;
    else {
#pragma unroll
      for (int j = 0; j < 32; ++j) acc[j] = 0.f;
    }
#pragma unroll 1
    for (; m + 4 <= n; m += 4) {
      u4 v[4][4];
#pragma unroll
      for (int mm = 0; mm < 4; ++mm)
#pragma unroll
        for (int q = 0; q < 4; ++q) v[mm][q] = *(const u4*)(src + (size_t)(m + mm) * 128 * 512 + q * 8);
#pragma unroll
      for (int mm = 0; mm < 4; ++mm)
#pragma unroll
        for (int q = 0; q < 4; ++q) {
          float f[8];
          unpack8(v[mm][q], f);
#pragma unroll
          for (int j = 0; j < 8; ++j) acc[q * 8 + j] = acc[q * 8 + j] * G + f[j];
        }
    }
#pragma unroll 1
    for (; m < n; ++m) {
      const u16* s = src + (size_t)m * 128 * 512;
#pragma unroll
      for (int q = 0; q < 4; ++q) {
        float f[8];
        unpack8(*(const u4*)(s + q * 8), f);
#pragma unroll
        for (int j = 0; j < 8; ++j) acc[q * 8 + j] = acc[q * 8 + j] * G + f[j];
      }
    }
#pragma unroll
    for (int j = 0; j < 32; ++j) PT[(e0 + j) * 136 + d] = f2bf(acc[j]);
  }
  __syncthreads();
  f32x4 oacc[8];
#pragma unroll
  for (int ii = 0; ii < 8; ++ii) oacc[ii] = f32x4{0.f, 0.f, 0.f, 0.f};
#pragma unroll
  for (int k0 = 0; k0 < 128; k0 += 32) {
    const bf16x8 a = frag(Qs, 136, wid * 16, k0, lane);
#pragma unroll
    for (int ii = 0; ii < 8; ++ii) oacc[ii] = mfma16(a, frag(PT, 136, ii * 16, k0, lane), oacc[ii]);
  }
  const u16* oin = p.sec + 8 * SECE;
  u16* gd = p.sec + 10 * SECE;
  const int i0 = wid * 16 + (lane >> 4) * 4;
  float s1[4] = {0.f, 0.f, 0.f, 0.f}, s2[4] = {0.f, 0.f, 0.f, 0.f};
#pragma unroll
  for (int ii = 0; ii < 8; ++ii) {
    const int e = ii * 16 + (lane & 15);
#pragma unroll
    for (int r = 0; r < 4; ++r) {
      const float xi = exp2f(l2g * (float)(i0 + r + 1));
      const float o = bf2f(oin[(size_t)(r0 + i0 + r) * 512 + h * 128 + e]) + xi * oacc[ii][r];
      oacc[ii][r] = o;
      s1[r] += o; s2[r] += o * o;
    }
  }
#pragma unroll
  for (int r = 0; r < 4; ++r) {
#pragma unroll
    for (int o = 1; o < 16; o <<= 1) { s1[r] += __shfl_xor(s1[r], o); s2[r] += __shfl_xor(s2[r], o); }
  }
#pragma unroll
  for (int ii = 0; ii < 8; ++ii) {
    const int e = ii * 16 + (lane & 15);
    const float gg = p.ret_gn_g[l * 512 + h * 128 + e];
#pragma unroll
    for (int r = 0; r < 4; ++r) {
      const float mu = s1[r] * (1.f / 128.f);
      const float var = fmaxf(s2[r] * (1.f / 128.f) - mu * mu, 0.f);
      u16* gp = gd + (size_t)(r0 + i0 + r) * 512 + h * 128 + e;
      const float g = bf2f(*gp);
      *gp = f2bf(siluf(g) * (oacc[ii][r] - mu) * rsqrtf(var + 1e-6f) * gg);
    }
  }
  __syncthreads();
}

DEVI void pool_unit(const P& p, int l, int u, unsigned char* smem) {
  const int t = tid_l(), lane = t & 63, wid = t >> 6;
  const int g = u & 3, rt = u >> 2;
  const int r0 = rt * 64, spos0 = r0 & (SEQ - 1);
  const int win = 2 << g;
  u16* Al = (u16*)smem;
  u16* Wl = Al + 64 * 136;
  {
    const int row = t >> 3, c0 = (t & 7) * 16;
    const u16* base = p.sec + 4 * SECE + g * 128 + c0;
    float sum[16], own[16];
#pragma unroll
    for (int c = 0; c < 16; ++c) sum[c] = 0.f;
    const int sp = spos0 + row;
    const int cnt = min(sp + 1, win);
    for (int j = 0; j < cnt; ++j) {
      const u16* src = base + (size_t)(r0 + row - j) * 512;
      float f[16];
      unpack8(*(const u4*)src, f); unpack8(*(const u4*)(src + 8), f + 8);
#pragma unroll
      for (int c = 0; c < 16; ++c) { sum[c] += f[c]; if (j == 0) own[c] = f[c]; }
    }
    const float ic = 1.f / (float)cnt;
#pragma unroll
    for (int c = 0; c < 16; ++c) sum[c] = sum[c] * ic - own[c];
    *(u4*)(Al + row * 136 + c0) = pack8(sum); *(u4*)(Al + row * 136 + c0 + 8) = pack8(sum + 8);
    const u16* wsrc = p.PoolWT + (size_t)g * 16384;
#pragma unroll
    for (int q = 0; q < 4; ++q) {
      const int idx = t + q * 512;
      const int d = idx >> 4, cc = (idx & 15) * 8;
      *(u4*)(Wl + d * 136 + cc) = *(const u4*)(wsrc + d * 128 + cc);
    }
  }
  __syncthreads();
  const int pt = wid & 3, dh = wid >> 2;
  f32x4 acc[4];
#pragma unroll
  for (int ni = 0; ni < 4; ++ni) acc[ni] = f32x4{0.f, 0.f, 0.f, 0.f};
#pragma unroll
  for (int k0 = 0; k0 < 128; k0 += 32) {
    const bf16x8 a = frag(Al, 136, pt * 16, k0, lane);
#pragma unroll
    for (int ni = 0; ni < 4; ++ni) acc[ni] = mfma16(a, frag(Wl, 136, (dh * 4 + ni) * 16, k0, lane), acc[ni]);
  }
#pragma unroll
  for (int ni = 0; ni < 4; ++ni) {
    const int d = (dh * 4 + ni) * 16 + (lane & 15);
    const float sc = p.pool_scale[l * 512 + g * 128 + d];
#pragma unroll
    for (int r = 0; r < 4; ++r)
      p.YB[(size_t)(r0 + pt * 16 + (lane >> 4) * 4 + r) * 512 + g * 128 + d] = f2bf(acc[ni][r] * sc);
  }
  __syncthreads();
}

DEVI void sg_unit(const P& p, int l, int u, unsigned char* smem) {
  const int t = tid_l(), lane = t & 63, wid = t >> 6;
  const int g = u & 3, ch = u >> 2;
  const int r0 = ch * 128;
  u16* VT = (u16*)smem;
  u16* Ul = VT + 128 * 136;
  u16* Wl = Ul + 128 * 136;
  {
    const int row = t >> 2, q = t & 3;
    const u16* svr = p.sec + 6 * SECE + (size_t)(r0 + row) * 512;
    float s1 = 0.f, s2 = 0.f;
#pragma unroll 4
    for (int i = 0; i < 16; ++i) {
      float f[8];
      unpack8(*(const u4*)(svr + q * 128 + i * 8), f);
#pragma unroll
      for (int j = 0; j < 8; ++j) { const float gv = geluf(f[j]); s1 += gv; s2 += gv * gv; }
    }
    s1 += __shfl_xor(s1, 1); s2 += __shfl_xor(s2, 1);
    s1 += __shfl_xor(s1, 2); s2 += __shfl_xor(s2, 2);
    const float mu = s1 * (1.f / 512.f);
    const float rstd = rsqrtf(fmaxf(s2 * (1.f / 512.f) - mu * mu, 0.f) + 1e-6f);
    const int c0 = q * 32;
    const u16* sur = p.sec + 5 * SECE + (size_t)(r0 + row) * 512 + g * 128 + c0;
#pragma unroll
    for (int i = 0; i < 4; ++i) {
      float f[8], uu[8];
      unpack8(*(const u4*)(svr + g * 128 + c0 + i * 8), f);
      unpack8(*(const u4*)(sur + i * 8), uu);
#pragma unroll
      for (int j = 0; j < 8; ++j) {
        const int c = g * 128 + c0 + i * 8 + j;
        const float vv = (geluf(f[j]) - mu) * rstd * p.sg_ln_g[l * 512 + c] + p.sg_ln_b[l * 512 + c];
        VT[(c0 + i * 8 + j) * 136 + row] = f2bf(vv);
        uu[j] = geluf(uu[j]);
      }
      *(u4*)(Ul + row * 136 + c0 + i * 8) = pack8(uu);
    }
    const float* wsrc = p.sg_w + ((size_t)(l * 4 + g) * 128 + row) * 128 + c0;
#pragma unroll
    for (int i = 0; i < 4; ++i) {
      const float4 a = *(const float4*)(wsrc + i * 8), bq = *(const float4*)(wsrc + i * 8 + 4);
      float f[8] = {a.x, a.y, a.z, a.w, bq.x, bq.y, bq.z, bq.w};
#pragma unroll
      for (int j = 0; j < 8; ++j) f[j] = (c0 + i * 8 + j <= row) ? f[j] : 0.f;
      *(u4*)(Wl + row * 136 + c0 + i * 8) = pack8(f);
    }
  }
  __syncthreads();
  f32x4 acc[8];
#pragma unroll
  for (int ii = 0; ii < 8; ++ii) acc[ii] = f32x4{0.f, 0.f, 0.f, 0.f};
#pragma unroll
  for (int k0 = 0; k0 < 128; k0 += 32) {
    if (k0 <= wid * 16 + 15) {
      const bf16x8 a = frag(Wl, 136, wid * 16, k0, lane);
#pragma unroll
      for (int ii = 0; ii < 8; ++ii) acc[ii] = mfma16(a, frag(VT, 136, ii * 16, k0, lane), acc[ii]);
    }
  }
  u16* dst = p.sec + 5 * SECE;
  const int t0 = wid * 16 + (lane >> 4) * 4;
#pragma unroll
  for (int r = 0; r < 4; ++r) {
    const float bias = p.sg_b[(l * 4 + g) * 128 + t0 + r];
#pragma unroll
    for (int ii = 0; ii < 8; ++ii) {
      const int c = ii * 16 + (lane & 15);
      dst[(size_t)(r0 + t0 + r) * 512 + g * 128 + c] = f2bf(bf2f(Ul[(t0 + r) * 136 + c]) * (acc[ii][r] + bias));
    }
  }
  __syncthreads();
}

DEVI void final_norm_phase(const P& p) {
  const int t = tid_l(), lane = t & 63, wid = t >> 6;
  for (int u = blockIdx.x; u < 2048; u += gridDim.x) {
    const int row = u * 8 + wid;
    float* xr = p.out + (size_t)row * 1024;
    float4 xv[4];
    float ss = 0.f;
#pragma unroll
    for (int i = 0; i < 4; ++i) {
      xv[i] = *(const float4*)(xr + i * 256 + lane * 4);
      ss += xv[i].x * xv[i].x + xv[i].y * xv[i].y + xv[i].z * xv[i].z + xv[i].w * xv[i].w;
    }
    ss = wave_sum(ss);
    const float rstd = rsqrtf(ss * (1.f / 1024.f) + 1e-6f);
#pragma unroll
    for (int i = 0; i < 4; ++i) {
      const float4 g = *(const float4*)(p.final_g + i * 256 + lane * 4);
      float4 o;
      o.x = xv[i].x * rstd * g.x; o.y = xv[i].y * rstd * g.y; o.z = xv[i].z * rstd * g.z; o.w = xv[i].w * rstd * g.w;
      *(float4*)(xr + i * 256 + lane * 4) = o;
    }
  }
}


#define XB_TMO      128
#define XB_XCNT(j)  (256  + 64 * (j))
#define XB_XSUB(j)  (1280 + 64 * (j))
#define XB_XGEN(j)  (2304 + 64 * (j))
#define XB_TOP      3328
#define XB_TOPGEN   3392
#define XCD_BAR_WORDS 3456
#define XB_SPIN_CAP (1u << 20)
#define XLAS __attribute__((address_space(3)))
DEVI unsigned xb_ld(unsigned* p) { return __hip_atomic_load(p, __ATOMIC_RELAXED, __HIP_MEMORY_SCOPE_AGENT); }
DEVI unsigned xb_add(unsigned* p, unsigned v) { return __hip_atomic_fetch_add(p, v, __ATOMIC_RELAXED, __HIP_MEMORY_SCOPE_AGENT); }
DEVI unsigned xb_xcc_id() { return (unsigned)__builtin_amdgcn_s_getreg((3 << 11) | 20) & 0xFu; }
#define XB_SPIN(cond, bar) do { unsigned _sp = 0; while (cond) { __builtin_amdgcn_s_sleep(1); \
    if ((++_sp & 255u) == 0u) { if (xb_ld(&(bar)[XB_TMO])) break; if (_sp > XB_SPIN_CAP) { atomicAdd(&(bar)[XB_TMO], 1u); break; } } } } while (0)
struct XcdBarrier { unsigned* bar; unsigned x; volatile XLAS unsigned* st; };
DEVI XcdBarrier xcd_barrier_post(unsigned* bar, volatile XLAS unsigned* st) {
  XcdBarrier b; b.bar = bar; b.x = xb_xcc_id(); b.st = st;
  if (threadIdx.x == 0) (void)xb_add(&bar[XB_XCNT(b.x)], 1u);
  return b;
}
DEVI void xcd_barrier_complete(unsigned* bar, unsigned x, unsigned& nloc, unsigned& nx) {
  const unsigned G = gridDim.x * gridDim.y * gridDim.z;
  unsigned sum, cnt, mine, sp = 0u;
  for (;;) {
    sum = 0u; cnt = 0u; mine = 0u;
#pragma unroll
    for (unsigned j = 0; j < 16; ++j) { const unsigned c = xb_ld(&bar[XB_XCNT(j)]); sum += c; cnt += (c > 0u) ? 1u : 0u; mine = (j == x) ? c : mine; }
    if (sum == G) break;
    __builtin_amdgcn_s_sleep(1);
    if ((++sp & 255u) == 0u) { if (xb_ld(&bar[XB_TMO])) break; if (sp > XB_SPIN_CAP) { atomicAdd(&bar[XB_TMO], 1u); break; } }
  }
  nloc = mine > 0u ? mine : 1u; nx = cnt > 0u ? cnt : 1u;
}
DEVI void xcd_barrier(const XcdBarrier& b) {
  asm volatile("s_waitcnt vmcnt(0)" ::: "memory");
  __syncthreads();
  if (threadIdx.x == 0) {
    unsigned* bar = b.bar;
    __builtin_amdgcn_s_waitcnt(0);
    unsigned nloc = b.st[0], nx = b.st[1];
    if (nloc == 0u) { xcd_barrier_complete(bar, b.x, nloc, nx); b.st[0] = nloc; b.st[1] = nx; }
    const unsigned old = xb_add(&bar[XB_XSUB(b.x)], 1u);
    const unsigned gen = old / nloc;
    if (old + 1u == (gen + 1u) * nloc) {
      __builtin_amdgcn_fence(__ATOMIC_RELEASE, "agent");
      asm volatile("s_waitcnt vmcnt(0)" ::: "memory");
      const unsigned og = xb_add(&bar[XB_TOP], 1u);
      const unsigned tg = og / nx;
      if (og + 1u == (tg + 1u) * nx) xb_add(&bar[XB_TOPGEN], 1u);
      else XB_SPIN(xb_ld(&bar[XB_TOPGEN]) == tg, bar);
      __builtin_amdgcn_fence(__ATOMIC_ACQUIRE, "agent");
      xb_add(&bar[XB_XGEN(b.x)], 1u);
      asm volatile("s_waitcnt vmcnt(0)" ::: "memory");
    } else {
      XB_SPIN(xb_ld(&bar[XB_XGEN(b.x)]) == gen, bar);
      __builtin_amdgcn_fence(__ATOMIC_ACQUIRE, "agent");
      asm volatile("s_waitcnt vmcnt(0)" ::: "memory");
    }
  }
  __syncthreads();
}

#ifndef PHMASK
#define PHMASK 0xffffffffu
#endif
#define EN(x) (((PHMASK) >> (x)) & 1u)
typedef const __attribute__((address_space(4))) P* KP;
DEVI P load_params(KP vp) {
  const __attribute__((address_space(4))) P& v = *vp;
  P q;
  q.x = v.x; q.c = v.c; q.pos = v.pos; q.norm1_g = v.norm1_g; q.norm2_g = v.norm2_g; q.ada_w = v.ada_w; q.ada_b = v.ada_b;
  q.w_in = v.w_in; q.dn_conv_w = v.dn_conv_w; q.dn_a_log = v.dn_a_log; q.dn_dt_bias = v.dn_dt_bias; q.dn_norm_g = v.dn_norm_g;
  q.pool_w = v.pool_w; q.pool_scale = v.pool_scale; q.sg_ln_g = v.sg_ln_g; q.sg_ln_b = v.sg_ln_b; q.sg_w = v.sg_w; q.sg_b = v.sg_b;
  q.ret_gn_g = v.ret_gn_g; q.w_br0 = v.w_br0; q.w_br1 = v.w_br1; q.w_br2 = v.w_br2; q.w_br3 = v.w_br3;
  q.w_out = v.w_out; q.mlp_w1 = v.mlp_w1; q.mlp_w2 = v.mlp_w2; q.final_g = v.final_g; q.out = v.out;
  q.WinT = v.WinT; q.WbrT = v.WbrT; q.WoutT = v.WoutT; q.W1T = v.W1T; q.W2T = v.W2T; q.PoolWT = v.PoolWT; q.h = v.h; q.sec = v.sec;
  q.TQ = v.TQ; q.YB = v.YB; q.halo = v.halo; q.QKF = v.QKF; q.modp = v.modp; q.beta = v.beta; q.glog = v.glog; q.EG = v.EG; q.ropecs = v.ropecs; q.prog = v.prog; q.rowss = v.rowss; q.xbar = v.xbar;
  q.phase_lo = 0; q.phase_hi = 0;
  return q;
}
#define LP() KP k2_ = kp; asm volatile("" : "+s"(k2_)); const P p = load_params(k2_)
DEVI void run_phase(int ph, unsigned char* smem) {
  KP kp = (KP)__builtin_amdgcn_kernarg_segment_ptr();
  int bid = blockIdx.x; asm volatile("" : "+s"(bid));
  const int nb = gridDim.x;
  if (ph == 0) {
    for (int u = bid; u < 96 + 2048 + NWCONV; u += nb) {
      if (u < 96) { if (EN(0)) { LP(); mod_unit(p, u, smem); } }
      else if (u < 96 + 2048) { if (EN(1)) { LP(); rope_unit(p, u - 96); } }
      else { if (EN(2)) { LP(); wconv_unit(p, 0, u - 96 - 2048, smem); } }
    }
    return;
  }
  if (ph == NPHASE - 1) { if (EN(15)) { LP(); final_norm_phase(p); } return; }
  const int l = (ph - 1) / 10, s = (ph - 1) % 10;
  switch (s) {
    case 0:
      if (l == 1 && EN(2)) for (int u = bid; u < NWCONV; u += nb) { LP(); wconv_unit(p, 1, u, smem); }
      __syncthreads();
      if (EN(3)) { LP(); norm_phase(p, l, 0, smem); }
      break;
    case 1:
      if (EN(3)) for (int u = bid; u < 64; u += nb) { LP(); bias2_unit(p, l, u); }
      if (EN(4)) { LP(); proj_phase(p, smem); }
      break;
    case 2:
      if (bid == 0 && threadIdx.x < 17) { LP(); p.prog[threadIdx.x * 16] = 0u; }
      for (int u = bid; u < 1024; u += nb) { if (EN(5)) { LP(); dn_prep_unit(p, l, u, smem); } }
      break;
    case 3:
      if (bid < 16) { if (EN(9)) { LP(); dn_chain(p, l, bid & 7, bid >> 3, smem); } }
      else {
        const int nw = nb - 16, wb = bid - 16;
        for (int u = wb; u < 512 + 512 + 1024; u += nw) {
          if (u < 512) { if (EN(7)) { LP(); sg_unit(p, l, u, smem); } }
          else if (u < 1024) { if (EN(6)) { LP(); ret_d1_unit(p, u - 512, smem); } }
          else { if (EN(8)) { LP(); pool_unit(p, l, u - 1024, smem); } }
        }
        {
          LP();
          unsigned* cnt = p.prog + 16 * 16;
          asm volatile("s_waitcnt vmcnt(0)" ::: "memory");
          __syncthreads();
          if (threadIdx.x == 0) {
            __builtin_amdgcn_fence(__ATOMIC_RELEASE, "agent");
            asm volatile("s_waitcnt vmcnt(0)" ::: "memory");
            __hip_atomic_fetch_add(cnt, 1u, __ATOMIC_RELAXED, __HIP_MEMORY_SCOPE_AGENT);
            unsigned polls = 0;
            while (__hip_atomic_load(cnt, __ATOMIC_RELAXED, __HIP_MEMORY_SCOPE_AGENT) < (unsigned)nw && polls < 4000000u) { __builtin_amdgcn_s_sleep(2); ++polls; }
            __builtin_amdgcn_fence(__ATOMIC_ACQUIRE, "agent");
            asm volatile("s_waitcnt vmcnt(0)" ::: "memory");
          }
          __syncthreads();
        }
        if (EN(10)) {
          LP();
          const int k0 = (wb * 512) / nw, k1 = ((wb + 1) * 512) / nw;
          float racc[32];
#pragma unroll
          for (int j = 0; j < 32; ++j) racc[j] = 0.f;
          int pbh = -1;
#pragma unroll 1
          for (int k = k0; k < k1; ++k) {
            const int bh = k >> 6, n = k & 63;
            ret_d2_unit(p, l, bh >> 2, bh & 3, n, racc, bh == pbh, smem);
            pbh = bh;
          }
        }
        if (EN(9)) for (int k = wb; k < 1024; k += nw) {
          LP();
          const int n = k >> 3, bh = k & 7;
          if (threadIdx.x == 0) {
            unsigned polls = 0;
            while ((__hip_atomic_load(p.prog + (bh * 2) * 16, __ATOMIC_RELAXED, __HIP_MEMORY_SCOPE_AGENT) <= (unsigned)n ||
                    __hip_atomic_load(p.prog + (bh * 2 + 1) * 16, __ATOMIC_RELAXED, __HIP_MEMORY_SCOPE_AGENT) <= (unsigned)n) && polls < 8000000u) { __builtin_amdgcn_s_sleep(8); ++polls; }
            __builtin_amdgcn_fence(__ATOMIC_ACQUIRE, "agent");
            asm volatile("s_waitcnt vmcnt(0)" ::: "memory");
          }
          __syncthreads();
          ya_unit(p, l, (((bh >> 2) * 128 + n) << 2) | (bh & 3), smem);
        }
      }
      break;
    case 4: break;
    case 5: if (EN(12)) { LP(); merge_phase(p, smem); } break;
    case 6: if (EN(13)) { LP(); resid_gemm_phase(p, l, 0, smem); } break;
    case 7: break;
    case 8: if (EN(14)) { LP(); mlp1_phase(p, smem); } break;
    case 9: if (EN(13)) { LP(); resid_gemm_phase(p, l, 1, smem); } break;
  }
}

__global__ void __launch_bounds__(NT) mega(P p) {
  extern __shared__ __attribute__((aligned(16))) unsigned char smem[];
#ifdef PROBE_A
  unsigned long long* stamps = (unsigned long long*)(smem + 159000);
  if (threadIdx.x == 0) { stamps[0] = __builtin_amdgcn_s_memrealtime(); stamps[23] = 0; }
#endif
  volatile XLAS unsigned* xst = (volatile XLAS unsigned*)((XLAS unsigned char*)smem + (SMEM_BYTES - 16));
  if (threadIdx.x == 0) { xst[0] = 0u; xst[1] = 0u; }
  __syncthreads();
  const XcdBarrier xb = xcd_barrier_post(p.xbar, xst);
  for (int ph = p.phase_lo; ph < p.phase_hi; ++ph) {
    if (ph > 0 && ph < NPHASE - 1 && ((ph - 1) % 10 == 7 || (ph - 1) % 10 == 4)) continue;
    run_phase(ph, smem);
    if (ph + 1 < p.phase_hi) {
      if (ph == 0) cg::this_grid().sync();
      else xcd_barrier(xb);
    }
  }
#ifdef PROBE_A
  cg::this_grid().sync();
  if (blockIdx.x == 0) {
    __syncthreads();
    auto dur = [&](int code) -> unsigned long long {
      if (code == 100) return stamps[1] - stamps[0];
      if (code == 101) return stamps[23];
      if (code == 102) return stamps[NPHASE - 1] - stamps[0];
      return (stamps[1 + code + 1] - stamps[1 + code]) + (stamps[11 + code + 1] - stamps[11 + code]);
    };
    const unsigned N = (unsigned)(dur(PROBE_A) * 4096ull / 100ull);
    for (unsigned i = threadIdx.x; i < N && i < 16384u * 1024u; i += NT) p.out[i] += 0.0078125f;
  }
#endif
}

extern "C" void kernel_launch(void* const* d_in, const int* in_sizes, int n_in, void* d_out, int out_size, void* d_ws,
                              size_t ws_size, hipStream_t stream) {
  static int grid = 0;
  constexpr size_t MiB = 1024 * 1024;
  constexpr size_t WS_NEED = 304 * MiB;
  if (grid == 0) {
    if (ws_size < WS_NEED || n_in != 27) {
      fprintf(stderr, "kernel_launch: ws_size %zu < %zu or n_in %d != 27\n", ws_size, WS_NEED, n_in);
      grid = -1;
      return;
    }
    int dev = 0, cus = 0, per_cu = 0;
    hipGetDevice(&dev);
    hipDeviceGetAttribute(&cus, hipDeviceAttributeMultiprocessorCount, dev);
    hipFuncSetAttribute((const void*)mega, hipFuncAttributeMaxDynamicSharedMemorySize, SMEM_BYTES);
    hipOccupancyMaxActiveBlocksPerMultiprocessor(&per_cu, (const void*)mega, NT, SMEM_BYTES);
    if (per_cu < 1) per_cu = 1;
    grid = cus * per_cu;
    (void)hipGetLastError();
  }
  if (grid < 0) return;
  P p{};
  p.x = (const float*)d_in[0]; p.c = (const float*)d_in[1]; p.pos = (const int*)d_in[2];
  p.norm1_g = (const float*)d_in[3]; p.norm2_g = (const float*)d_in[4];
  p.ada_w = (const float*)d_in[5]; p.ada_b = (const float*)d_in[6]; p.w_in = (const float*)d_in[7];
  p.dn_conv_w = (const float*)d_in[8]; p.dn_a_log = (const float*)d_in[9]; p.dn_dt_bias = (const float*)d_in[10];
  p.dn_norm_g = (const float*)d_in[11]; p.pool_w = (const float*)d_in[12]; p.pool_scale = (const float*)d_in[13];
  p.sg_ln_g = (const float*)d_in[14]; p.sg_ln_b = (const float*)d_in[15]; p.sg_w = (const float*)d_in[16];
  p.sg_b = (const float*)d_in[17]; p.ret_gn_g = (const float*)d_in[18];
  p.w_br0 = (const float*)d_in[19]; p.w_br1 = (const float*)d_in[20]; p.w_br2 = (const float*)d_in[21];
  p.w_br3 = (const float*)d_in[22];
  p.w_out = (const float*)d_in[23]; p.mlp_w1 = (const float*)d_in[24]; p.mlp_w2 = (const float*)d_in[25];
  p.final_g = (const float*)d_in[26];
  p.out = (float*)d_out;
  unsigned char* ws = (unsigned char*)d_ws;
  size_t o = 0;
  p.WinT = (u16*)(ws + o); o += (size_t)9728 * 1024 * 2;
  p.WbrT = (u16*)(ws + o); o += (size_t)4 * 1024 * 512 * 2;
  p.WoutT = (u16*)(ws + o); o += (size_t)1024 * 1024 * 2;
  p.W1T = (u16*)(ws + o); o += (size_t)4096 * 1024 * 2;
  p.W2T = (u16*)(ws + o); o += (size_t)4096 * 1024 * 2;
  p.PoolWT = (u16*)(ws + o); o += (size_t)4 * 128 * 128 * 2;
  o = 44 * MiB;
  p.h = (u16*)(ws + o); o += 32 * MiB;
  p.sec = (u16*)(ws + o); o += 176 * MiB;
  p.TQ = (u16*)(ws + o); o += 16 * MiB;
  p.YB = (u16*)(ws + o); o += 16 * MiB;
  p.halo = (u16*)(ws + o); o += 3 * MiB;
  p.modp = (float*)(ws + o); o += 1 * MiB;
  p.beta = (float*)(ws + o); o += 262144;
  p.glog = (float*)(ws + o); o += 262144;
  p.EG = (float*)(ws + o); o += 262144;
  p.ropecs = (float*)(ws + o); o += 8 * MiB;
  p.QKF = (u16*)(ws + o); o += (size_t)1024 * 3072 * 2;
  p.prog = (unsigned*)(ws + o); o += 4096;
  p.rowss = (float*)(ws + o); o += (size_t)16384 * 16 * 4;
  p.xbar = (unsigned*)(ws + o); o += 16384;
#if COOP
  (void)hipMemsetAsync(p.xbar, 0, 16384, stream);
  p.phase_lo = 0; p.phase_hi = NPHASE;
  void* args[] = {&p};
  hipError_t e = hipLaunchCooperativeKernel((const void*)mega, dim3(grid), dim3(NT), args, SMEM_BYTES, stream);
  if (e != hipSuccess) fprintf(stderr, "cooperative launch failed: %s (grid %d)\n", hipGetErrorString(e), grid);
#else
  for (int ph = 0; ph < NPHASE; ++ph) {
    p.phase_lo = ph; p.phase_hi = ph + 1;
    hipLaunchKernelGGL(mega, dim3(grid), dim3(NT), SMEM_BYTES, stream, p);
  }
#endif
}
```
